# Optimizing an MI355X kernel written in HIP

```python
import math
import jax, jax.numpy as jnp
from jax import lax
import numpy as np

D_MODEL = 1024
BATCH = 8
SEQ = 2048
DEPTH = 1
DEC_BATCH = 128
DEC_SEQ = 8
PAST_LEN = 16384
PAGE_SIZE = 128

GMLP_W = D_MODEL
GMLP_GROUPS = 4
GMLP_GROUP_DIM = GMLP_W // GMLP_GROUPS
GMLP_CHUNK = 128
MLSTM_W = D_MODEL
MLSTM_HEADS = 4
MLSTM_HEAD_DIM = MLSTM_W // MLSTM_HEADS
MLSTM_CHUNK = 128
CONV_W = 4
D_FF = 2816
N_ADA = 9
EPS = 1e-6
IN_COLS = 2 * GMLP_W + 4 * MLSTM_W + 2 * MLSTM_HEADS + 2 * D_MODEL

kernel_name = 'gated_gmlp_mlstm_macaron_adaln_decoder_step'


def rmsnorm(x, g):
    xf = x.astype(jnp.float32)
    y = xf * lax.rsqrt(jnp.mean(xf * xf, axis=-1, keepdims=True) + EPS)
    return (y * g.astype(jnp.float32)).astype(x.dtype)


def layernorm(x, g, b):
    xf = x.astype(jnp.float32)
    mu = jnp.mean(xf, axis=-1, keepdims=True)
    var = jnp.mean(jnp.square(xf - mu), axis=-1, keepdims=True)
    y = (xf - mu) * lax.rsqrt(var + EPS) * g.astype(jnp.float32) + b.astype(jnp.float32)
    return y.astype(x.dtype)


def modulate(h, shift, scale):
    return h * (1 + scale[:, None, :]) + shift[:, None, :]


def swiglu(h, w_in, w_out):
    a, b = jnp.split(h @ w_in, 2, axis=-1)
    return (jax.nn.silu(a) * b) @ w_out


def causal_conv(x, buf, w, b):
    T = x.shape[1]
    xp = jnp.concatenate([buf.astype(x.dtype), x], axis=1)
    y = b
    for j in range(CONV_W):
        y = y + xp[:, j:j + T] * w[j]
    return y, xp[:, T:]


def gmlp_spatial(u, v, ws, bs):
    B, T, _ = v.shape
    L = min(T, GMLP_CHUNK)
    NC = T // L
    w = jnp.tril(ws[:, :L, :L])
    vg = v.reshape(B, NC, L, GMLP_GROUPS, GMLP_GROUP_DIM)
    bias = jnp.swapaxes(bs[:, :L], 0, 1)[None, None, :, :, None]
    mixed = jnp.einsum('gts,bcsgd->bctgd', w, vg) + bias
    return u * mixed.reshape(B, T, GMLP_W)


def mlstm_chunked(q, k, v, i_pre, f_pre, C0, n0, m0):
    B, T, H, DH = q.shape
    L = math.gcd(T, MLSTM_CHUNK)
    NC = T // L

    def to_chunks(a):
        return jnp.moveaxis(a.reshape(B, NC, L, *a.shape[2:]), 1, 0)

    xs = (to_chunks(q), to_chunks(k), to_chunks(v), to_chunks(i_pre),
          to_chunks(jax.nn.log_sigmoid(f_pre)))
    causal = jnp.tril(jnp.ones((L, L), dtype=bool))

    def step(carry, inp):
        C, n, m = carry
        qb, kb, vb, ib, lfb = inp
        b = jnp.swapaxes(jnp.cumsum(lfb, axis=1), 1, 2)
        ih = jnp.swapaxes(ib, 1, 2)
        inter = b + m[..., None]
        Dm = b[..., :, None] - b[..., None, :] + ih[..., None, :]
        Dm = jnp.where(causal, Dm, -jnp.inf)
        m_t = jnp.maximum(inter, jnp.max(Dm, axis=-1))
        w_inter = jnp.exp(inter - m_t)
        s = jnp.einsum('blhd,bshd->bhls', qb, kb) * jnp.exp(Dm - m_t[..., None])
        num = (w_inter[..., None] * jnp.einsum('blhd,bhde->bhle', qb, C)
               + jnp.einsum('bhls,bshe->bhle', s, vb))
        den = w_inter * jnp.einsum('blhd,bhd->bhl', qb, n) + jnp.sum(s, axis=-1)
        h = num / jnp.maximum(jnp.abs(den), jnp.exp(-m_t))[..., None]
        bL = b[..., -1]
        g = bL[..., None] - b + ih
        m_new = jnp.maximum(bL + m, jnp.max(g, axis=-1))
        a_prev = jnp.exp(bL + m - m_new)
        kw = kb * jnp.swapaxes(jnp.exp(g - m_new[..., None]), 1, 2)[..., None]
        C_new = a_prev[..., None, None] * C + jnp.einsum('bshd,bshe->bhde', kw, vb)
        n_new = a_prev[..., None] * n + jnp.sum(kw, axis=1)
        return (C_new, n_new, m_new), jnp.swapaxes(h, 1, 2)

    (C, n, m), hs = lax.scan(step, (C0, n0, m0), xs)
    return jnp.moveaxis(hs, 0, 1).reshape(B, T, H, DH), C, n, m


def token_mixer(h, conv_buf, C0, n0, m0, w_in, b_gates, conv_w, conv_b, ln_g, ln_b,
                ws, bs, norm_g, w_out):
    B, T, _ = h.shape
    H, DH = MLSTM_HEADS, MLSTM_HEAD_DIM
    z = h @ w_in
    u = jax.nn.gelu(z[..., :GMLP_W])
    v = layernorm(jax.nn.gelu(z[..., GMLP_W:2 * GMLP_W]), ln_g, ln_b)
    y_a = gmlp_spatial(u, v, ws, bs)
    s0 = 2 * GMLP_W
    qk, new_buf = causal_conv(z[..., s0:s0 + 2 * MLSTM_W], conv_buf, conv_w, conv_b)
    qk = jax.nn.silu(qk)
    s0 += 2 * MLSTM_W
    vm = z[..., s0:s0 + MLSTM_W]
    s0 += MLSTM_W
    o = z[..., s0:s0 + MLSTM_W]
    s0 += MLSTM_W
    gif = (z[..., s0:s0 + 2 * H] + b_gates).astype(jnp.float32)
    s0 += 2 * H
    g_a = z[..., s0:s0 + D_MODEL]
    g_b = z[..., s0 + D_MODEL:s0 + 2 * D_MODEL]

    def heads(a):
        return a.astype(jnp.float32).reshape(B, T, H, DH)

    q = heads(qk[..., :MLSTM_W])
    k = heads(qk[..., MLSTM_W:]) * (DH ** -0.5)
    ht, C, n, m = mlstm_chunked(q, k, heads(vm), gif[..., :H], gif[..., H:],
                                C0.astype(jnp.float32), n0.astype(jnp.float32),
                                m0.astype(jnp.float32))
    mu = jnp.mean(ht, axis=-1, keepdims=True)
    var = jnp.mean(jnp.square(ht - mu), axis=-1, keepdims=True)
    hn = (ht - mu) * lax.rsqrt(var + EPS) * norm_g.astype(jnp.float32).reshape(H, DH)
    y_b = jax.nn.sigmoid(o) * hn.reshape(B, T, MLSTM_W).astype(h.dtype)
    mix = jax.nn.sigmoid(g_a) * y_a + jax.nn.sigmoid(g_b) * y_b
    return mix @ w_out, new_buf, C, n, m, v


def run_trunk(x, c, conv0, C0, n0, m0, w_ada, b_ada, g_ffn1, w_ffn1_in, w_ffn1_out, g_mix,
              w_in, b_gates, conv_w, conv_b, gmlp_ln_g, gmlp_ln_b, gmlp_ws, gmlp_bs,
              mlstm_norm_g, w_out, g_ffn2, w_ffn2_in, w_ffn2_out, w_ada_final, b_ada_final,
              g_final):
    B = x.shape[0]
    cs = jax.nn.silu(c)
    outs = []
    for l in range(DEPTH):
        ada = (cs @ w_ada[l] + b_ada[l]).reshape(B, N_ADA, D_MODEL)
        sh1, sc1, gt1, sh2, sc2, gt2, sh3, sc3, gt3 = [ada[:, j] for j in range(N_ADA)]
        h = modulate(rmsnorm(x, g_ffn1[l]), sh1, sc1)
        x = x + 0.5 * gt1[:, None] * swiglu(h, w_ffn1_in[l], w_ffn1_out[l])
        h = modulate(rmsnorm(x, g_mix[l]), sh2, sc2)
        out, buf, C, n, m, v = token_mixer(h, conv0[l], C0[l], n0[l], m0[l], w_in[l], b_gates[l],
                                           conv_w[l], conv_b[l], gmlp_ln_g[l], gmlp_ln_b[l],
                                           gmlp_ws[l], gmlp_bs[l], mlstm_norm_g[l], w_out[l])
        x = x + gt2[:, None] * out
        h = modulate(rmsnorm(x, g_ffn2[l]), sh3, sc3)
        x = x + 0.5 * gt3[:, None] * swiglu(h, w_ffn2_in[l], w_ffn2_out[l])
        outs.append((buf, C.astype(x.dtype), n.astype(x.dtype), m.astype(x.dtype), v))
    fin = cs @ w_ada_final + b_ada_final
    shf, scf = jnp.split(fin, 2, axis=-1)
    y = modulate(rmsnorm(x, g_final), shf, scf)
    buf_s = jnp.stack([o[0] for o in outs])
    C_s = jnp.stack([o[1] for o in outs])
    n_s = jnp.stack([o[2] for o in outs])
    m_s = jnp.stack([o[3] for o in outs])
    v_s = jnp.stack([o[4] for o in outs])
    return y, buf_s, C_s, n_s, m_s, v_s


def setup_inputs(seed: int = 0) -> dict:
    key = jax.random.key(seed)
    ks = iter(jax.random.split(key, 48))

    def nrm(shape, s):
        return s * jax.random.normal(next(ks), shape, jnp.float32)

    D, H, DH = D_MODEL, MLSTM_HEADS, MLSTM_HEAD_DIM
    f_bias = jnp.linspace(3.0, 6.0, H, dtype=jnp.float32)
    b_gates = jnp.concatenate([nrm((DEPTH, H), 0.1), f_bias[None] + nrm((DEPTH, H), 0.1)], axis=-1)
    return {
        'x_prompt': nrm((BATCH, SEQ, D), 1.0),
        'x_sample': nrm((DEC_BATCH, DEC_SEQ, D), 1.0),
        'c_prompt': nrm((BATCH, D), 1.0),
        'c_sample': nrm((DEC_BATCH, D), 1.0),
        'state_mlstm_C': nrm((DEPTH, DEC_BATCH, H, DH, DH), 0.1),
        'state_mlstm_n': nrm((DEPTH, DEC_BATCH, H, DH), 1.0),
        'state_mlstm_m': nrm((DEPTH, DEC_BATCH, H), 0.5),
        'state_conv': nrm((DEPTH, DEC_BATCH, CONV_W - 1, 2 * MLSTM_W), 1.0),
        'w_ada': nrm((DEPTH, D, N_ADA * D), 0.5 * D ** -0.5),
        'b_ada': nrm((DEPTH, N_ADA * D), 0.1),
        'g_ffn1': 1.0 + nrm((DEPTH, D), 0.1),
        'w_ffn1_in': nrm((DEPTH, D, 2 * D_FF), D ** -0.5),
        'w_ffn1_out': nrm((DEPTH, D_FF, D), D_FF ** -0.5),
        'g_mix': 1.0 + nrm((DEPTH, D), 0.1),
        'w_in': nrm((DEPTH, D, IN_COLS), D ** -0.5),
        'b_gates': b_gates,
        'conv_w': nrm((DEPTH, CONV_W, 2 * MLSTM_W), CONV_W ** -0.5),
        'conv_b': nrm((DEPTH, 2 * MLSTM_W), 0.02),
        'gmlp_ln_g': 1.0 + nrm((DEPTH, GMLP_W), 0.1),
        'gmlp_ln_b': nrm((DEPTH, GMLP_W), 0.02),
        'gmlp_ws': nrm((DEPTH, GMLP_GROUPS, GMLP_CHUNK, GMLP_CHUNK), 0.05),
        'gmlp_bs': 1.0 + nrm((DEPTH, GMLP_GROUPS, GMLP_CHUNK), 0.1),
        'mlstm_norm_g': 1.0 + nrm((DEPTH, MLSTM_W), 0.1),
        'w_out': nrm((DEPTH, D, D), D ** -0.5),
        'g_ffn2': 1.0 + nrm((DEPTH, D), 0.1),
        'w_ffn2_in': nrm((DEPTH, D, 2 * D_FF), D ** -0.5),
        'w_ffn2_out': nrm((DEPTH, D_FF, D), D_FF ** -0.5),
        'w_ada_final': nrm((D, 2 * D), 0.5 * D ** -0.5),
        'b_ada_final': nrm((2 * D,), 0.1),
        'g_final': 1.0 + nrm((D,), 0.1),
    }


def reference(x_prompt, x_sample, c_prompt, c_sample, state_mlstm_C, state_mlstm_n,
              state_mlstm_m, state_conv, w_ada, b_ada, g_ffn1, w_ffn1_in, w_ffn1_out, g_mix,
              w_in, b_gates, conv_w, conv_b, gmlp_ln_g, gmlp_ln_b, gmlp_ws, gmlp_bs,
              mlstm_norm_g, w_out, g_ffn2, w_ffn2_in, w_ffn2_out, w_ada_final, b_ada_final,
              g_final):
    weights = (w_ada, b_ada, g_ffn1, w_ffn1_in, w_ffn1_out, g_mix, w_in, b_gates, conv_w,
               conv_b, gmlp_ln_g, gmlp_ln_b, gmlp_ws, gmlp_bs, mlstm_norm_g, w_out, g_ffn2,
               w_ffn2_in, w_ffn2_out, w_ada_final, b_ada_final, g_final)
    Bp = x_prompt.shape[0]
    H, DH = MLSTM_HEADS, MLSTM_HEAD_DIM
    conv0 = jnp.zeros((DEPTH, Bp, CONV_W - 1, 2 * MLSTM_W), x_prompt.dtype)
    C0 = jnp.zeros((DEPTH, Bp, H, DH, DH), jnp.float32)
    n0 = jnp.zeros((DEPTH, Bp, H, DH), jnp.float32)
    m0 = jnp.zeros((DEPTH, Bp, H), jnp.float32)
    y_prompt, conv_p, C_p, n_p, m_p, _ = run_trunk(x_prompt, c_prompt, conv0, C0, n0, m0,
                                                   *weights)
    y_sample, conv_s, C_s, n_s, m_s, v_s = run_trunk(x_sample, c_sample, state_conv,
                                                     state_mlstm_C, state_mlstm_n,
                                                     state_mlstm_m, *weights)
    return (y_prompt, y_sample, C_p, n_p, m_p, conv_p, C_s, n_s, m_s, conv_s, v_s)
```

```cpp
#include <hip/hip_runtime.h>
#include <hip/hip_cooperative_groups.h>
#include <cstdio>
namespace cg = cooperative_groups;
#ifndef FUSED
#define FUSED 0
#endif
namespace pg8 {
#define PG8_LAS __attribute__((address_space(3)))
typedef unsigned short bf16_t;
typedef short bf16x8 __attribute__((ext_vector_type(8)));
typedef float f32x4 __attribute__((ext_vector_type(4)));
typedef unsigned u32x4 __attribute__((ext_vector_type(4)));
constexpr int BM = 256, BK = 64, HALF = 128, HTB = HALF * BK * 2  , STAGE_BYTES = 8 * HTB, NXCD = 8, WGM = 8;

__host__ __device__ __forceinline__ int lds_byte(int r, int c) { const int st = (r >> 4) * 2 + (c >> 5), rr = r & 15, cc = c & 31, ob = rr * 64 + cc * 2; return st * 1024 + (ob ^ (((ob >> 9) & 1) << 5)); }
__host__ __device__ __forceinline__ void stage_rc(int b, int& R, int& C) { const int st = b / 1024, sb = b % 1024, swz = sb ^ (((sb >> 9) & 1) << 5); R = (st >> 1) * 16 + swz / 64; C = (st & 1) * 32 + (swz % 64) / 2; }
__host__ __device__ __forceinline__ int perm32(int rho) { const int n = rho >> 4, i = rho & 15; return 8 * (i >> 2) + 4 * n + (i & 3); }

struct Unit { int pm, pn; };
struct Gemm { const bf16_t* A; const bf16_t* Bt; int M, N, K; };

struct StaticOrder {
    int nM, nN, nwg, G, c;
    __host__ __device__ void init(int M, int N, int G_, int c_) { nM = M / BM; nN = N / BM; nwg = nM * nN; G = G_; c = c_; }
    __host__ __device__ bool next(int i, Unit& u) const {
        const long L = (long)i * G + c; if (L >= nwg) return false;
        int wgid = (int)L; { const int q = nwg / NXCD, r = nwg % NXCD, xcd = wgid % NXCD, off = wgid / NXCD; wgid = (xcd < r ? xcd * (q + 1) : r * (q + 1) + (xcd - r) * q) + off; }
        const int nig = WGM * nN, gid = wgid / nig, fm = gid * WGM, gsz = (nM - fm) < WGM ? (nM - fm) : WGM;
        u.pm = fm + ((wgid % nig) % gsz); u.pn = (wgid % nig) / gsz; return true;
    }
    __device__ __forceinline__ void a_ready(const Unit&) const {}
    __device__ __forceinline__ void done(const Unit&) const {}
};
__device__ __forceinline__ unsigned cvt_pk_bf16(float lo, float hi) { unsigned r; asm volatile("v_cvt_pk_bf16_f32 %0, %1, %2" : "=v"(r) : "v"(lo), "v"(hi)); return r; }
template <class Epi, class Sched, bool STAMP = false>
__device__ __forceinline__ void gemm_phase(PG8_LAS unsigned char* lds, const Gemm g, const Sched& S, const Epi& E, unsigned long long* stamps) {
    const int tid = threadIdx.x, wid = __builtin_amdgcn_readfirstlane(tid >> 6), lane = tid & 63, wr = wid >> 2, wc = wid & 3, fr = lane & 15, fq = lane >> 4;
    const int K = g.K, nt = K / BK;
    int ts_lo = 0, ts_hi = 0, nts = 0; const unsigned long long rt_entry = STAMP ? (unsigned long long)wall_clock64() : 0ull;
#define PG8_STAMP() do { if (STAMP && wid == 0 && nts < 64) { const unsigned long long _c = (unsigned long long)clock64(); \
        ts_lo = (lane == nts) ? (int)(unsigned)_c : ts_lo; ts_hi = (lane == nts) ? (int)(unsigned)(_c >> 32) : ts_hi; ++nts; } } while (0)
    PG8_STAMP();
    unsigned voffA[2], voffB[2];
#pragma unroll
    for (int i = 0; i < 2; ++i) { int R, C; stage_rc(tid * 16 + i * 8192, R, C); const int Rb = Epi::PERM ? ((R & ~31) + perm32(R & 31)) : R;
        voffA[i] = (unsigned)(R * K + C) * 2u; voffB[i] = (unsigned)(Rb * K + C) * 2u; }
    const size_t kstep = (size_t)(BK * 2);
    const size_t hstep = (size_t)HALF * K * 2;
    const size_t tstep = 2 * hstep;
    const unsigned ldsw = (unsigned)wid * 1024u;
    const int aoff = lds_byte(wr * 64 + fr, fq * 8), boff = lds_byte(wc * 32 + fr, fq * 8);
#define PG8_SA(b, h) (((b) * 2 + (h)) * HTB)
#define PG8_SB(b, h) ((4 + (b) * 2 + (h)) * HTB)
#define PG8_STAGE(bufoff, gbase, voff) do { _Pragma("unroll") for (int _i = 0; _i < 2; ++_i) \
        __builtin_amdgcn_global_load_lds((const unsigned*)((const char*)(gbase) + (voff)[_i]), (PG8_LAS unsigned*)(lds + (bufoff) + ldsw + _i * 8192), 16, 0, 0); } while (0)
#define PG8_LDA(dst, b, h) do { _Pragma("unroll") for (int m = 0; m < 4; ++m) _Pragma("unroll") for (int k = 0; k < 2; ++k) dst[m][k] = *(const PG8_LAS bf16x8*)(lds + PG8_SA(b, h) + aoff + m * 2048 + k * 1024); } while (0)
#define PG8_LDB(dst, b, h) do { _Pragma("unroll") for (int n = 0; n < 2; ++n) _Pragma("unroll") for (int k = 0; k < 2; ++k) dst[n][k] = *(const PG8_LAS bf16x8*)(lds + PG8_SB(b, h) + boff + n * 2048 + k * 1024); } while (0)
#define PG8_MMA(ai, bj, At, Bt) do { __builtin_amdgcn_s_setprio(1); _Pragma("unroll") for (int m = 0; m < 4; ++m) _Pragma("unroll") for (int n = 0; n < 2; ++n) _Pragma("unroll") for (int k = 0; k < 2; ++k) \
        acc[ai][bj][m][n] = __builtin_amdgcn_mfma_f32_16x16x32_bf16(Bt[n][k], At[m][k], acc[ai][bj][m][n], 0, 0, 0); __builtin_amdgcn_s_setprio(0); } while (0)
#define PG8_WAIT_V(n) asm volatile("s_waitcnt vmcnt(" #n ")" ::: "memory")
#define PG8_WAIT_L(n) asm volatile("s_waitcnt lgkmcnt(" #n ")" ::: "memory")
#define PG8_BAR __builtin_amdgcn_s_barrier()
#define PG8_SCHED __builtin_amdgcn_sched_barrier(0)
    Unit cur, nxt; int ui = 0;
    if (!S.next(0, cur)) return;
    f32x4 acc[2][2][4][2];
#pragma unroll
    for (int a = 0; a < 2; ++a)
#pragma unroll
        for (int b = 0; b < 2; ++b)
#pragma unroll
            for (int m = 0; m < 4; ++m)
#pragma unroll
                for (int n = 0; n < 2; ++n) acc[a][b][m][n] = (f32x4){0.f, 0.f, 0.f, 0.f};
    bf16x8 At[4][2], B0[2][2], B1[2][2];
    const char* cA = (const char*)g.A + (size_t)cur.pm * tstep; const char* cB = (const char*)g.Bt + (size_t)cur.pn * tstep;
    S.a_ready(cur);
    PG8_STAGE(PG8_SB(0, 0), cB, voffB); PG8_STAGE(PG8_SA(0, 0), cA, voffA); PG8_STAGE(PG8_SB(0, 1), cB + hstep, voffB); PG8_STAGE(PG8_SA(0, 1), cA + hstep, voffA);
    if (wr == 1) PG8_BAR;
    PG8_WAIT_V(4); PG8_BAR;
    PG8_STAGE(PG8_SB(1, 0), cB + kstep, voffB); PG8_STAGE(PG8_SA(1, 0), cA + kstep, voffA); PG8_STAGE(PG8_SB(1, 1), cB + hstep + kstep, voffB);
    PG8_WAIT_V(6); PG8_BAR;
    PG8_STAMP();
    for (;;) {
        const bool has_next = S.next(ui + 1, nxt);
        const char* nA = has_next ? (const char*)g.A + (size_t)nxt.pm * tstep : cA; const char* nB = has_next ? (const char*)g.Bt + (size_t)nxt.pn * tstep : cB;
        for (int t = 0; t < nt; t += 2) {
            const bool last = (t == nt - 2);
            const char* a1 = cA + (size_t)(t + 1) * kstep;
            const char* a2 = last ? nA : cA + (size_t)(t + 2) * kstep; const char* b2 = last ? nB : cB + (size_t)(t + 2) * kstep;
            const char* a3 = a2 + kstep; const char* b3 = b2 + kstep;
            if (last && has_next) S.a_ready(nxt);
            PG8_LDB(B0, 0, 0); PG8_SCHED; PG8_LDA(At, 0, 0); PG8_STAGE(PG8_SA(1, 1), a1 + hstep, voffA);
            PG8_WAIT_L(8); PG8_BAR; PG8_WAIT_L(0); PG8_MMA(0, 0, At, B0); PG8_BAR; PG8_SCHED;
            PG8_LDB(B1, 0, 1); PG8_STAGE(PG8_SB(0, 0), b2, voffB);
            PG8_BAR; PG8_WAIT_L(0); PG8_MMA(0, 1, At, B1); PG8_BAR;
            PG8_LDA(At, 0, 1); PG8_STAGE(PG8_SA(0, 0), a2, voffA);
            PG8_BAR; PG8_WAIT_L(0); PG8_MMA(1, 0, At, B0); PG8_BAR; PG8_SCHED;
            PG8_STAGE(PG8_SB(0, 1), b2 + hstep, voffB);
            PG8_WAIT_V(6); PG8_BAR; PG8_MMA(1, 1, At, B1); PG8_BAR;
            PG8_LDB(B0, 1, 0); PG8_SCHED; PG8_LDA(At, 1, 0); PG8_STAGE(PG8_SA(0, 1), a2 + hstep, voffA);
            PG8_WAIT_L(8); PG8_BAR; PG8_WAIT_L(0); PG8_MMA(0, 0, At, B0); PG8_BAR; PG8_SCHED;
            PG8_LDB(B1, 1, 1); PG8_STAGE(PG8_SB(1, 0), b3, voffB);
            PG8_BAR; PG8_WAIT_L(0); PG8_MMA(0, 1, At, B1); PG8_BAR;
            PG8_LDA(At, 1, 1); PG8_STAGE(PG8_SA(1, 0), a3, voffA);
            PG8_BAR; PG8_WAIT_L(0); PG8_MMA(1, 0, At, B0); PG8_BAR; PG8_SCHED;
            PG8_STAGE(PG8_SB(1, 1), b3 + hstep, voffB);
            PG8_WAIT_V(6); PG8_BAR; PG8_MMA(1, 1, At, B1); PG8_BAR;
        }
        PG8_STAMP();
        if constexpr (!Epi::AFTER_DRAIN) { E(acc, cur, wr, wc, fr, fq); S.done(cur); }
        PG8_STAMP();
        if (!has_next) break;
#pragma unroll
        for (int a = 0; a < 2; ++a)
#pragma unroll
            for (int b = 0; b < 2; ++b)
#pragma unroll
                for (int m = 0; m < 4; ++m)
#pragma unroll
                    for (int n = 0; n < 2; ++n) acc[a][b][m][n] = (f32x4){0.f, 0.f, 0.f, 0.f};
        cur = nxt; cA = nA; cB = nB; ++ui;
    }
    PG8_WAIT_V(0);
    if (wr == 0) PG8_BAR;
    PG8_BAR;
    if constexpr (Epi::AFTER_DRAIN) { E.fused(acc, cur, wr, wc, fr, fq, lds, wid, lane); S.done(cur); }
    PG8_STAMP();
    if (STAMP && wid == 0) { stamps[lane] = lane < nts ? (((unsigned long long)(unsigned)ts_hi << 32) | (unsigned)ts_lo) : 0ull;
        if (lane == 62) stamps[62] = rt_entry; if (lane == 63) stamps[63] = (unsigned long long)wall_clock64(); }
#undef PG8_STAMP
#undef PG8_SA
#undef PG8_SB
#undef PG8_STAGE
#undef PG8_LDA
#undef PG8_LDB
#undef PG8_MMA
#undef PG8_WAIT_V
#undef PG8_WAIT_L
#undef PG8_BAR
#undef PG8_SCHED
}
}

#define LAS __attribute__((address_space(3)))
typedef unsigned short u16;
typedef short bf16x8 __attribute__((ext_vector_type(8)));
typedef short s16x4 __attribute__((ext_vector_type(4)));
typedef float f32x4 __attribute__((ext_vector_type(4)));
typedef unsigned u32x4 __attribute__((ext_vector_type(4)));
typedef unsigned u32x2 __attribute__((ext_vector_type(2)));

constexpr int DM = 1024, NPR = 16384, NSR = 1024, MR = NPR + NSR, FF = 2816, ZC = 8192, ADAC = 11264;
constexpr int LDS_BYTES = 131072;
constexpr size_t W_WB1 = 0;
constexpr size_t W_WB2 = W_WB1 + (size_t)5632 * 1024 * 2;
constexpr size_t W_WB3 = W_WB2 + (size_t)1024 * 2816 * 2;
constexpr size_t W_WB4 = W_WB3 + (size_t)8192 * 1024 * 2;
constexpr size_t W_WB5 = W_WB4 + (size_t)1024 * 1024 * 2;
constexpr size_t W_WB6 = W_WB5 + (size_t)5632 * 1024 * 2;
constexpr size_t W_CS = W_WB6 + (size_t)1024 * 2816 * 2;
constexpr size_t W_BIAS = W_CS + (size_t)256 * 1024 * 2;
constexpr size_t W_WG = W_BIAS + (size_t)ADAC * 4;
constexpr size_t W_ADA = W_WG + (size_t)8 * 1024 * 4;
constexpr size_t W_H = W_ADA + (size_t)256 * ADAC * 4;
constexpr size_t W_GATES = W_H + (size_t)MR * 1024 * 2;
constexpr size_t W_BS = W_GATES + (size_t)MR * 8 * 4;
constexpr size_t W_AS = W_BS + (size_t)32 * 2048 * 4;
constexpr size_t W_CM = W_AS + (size_t)32 * 2048 * 4;
constexpr size_t W_MINIT = W_CM + (size_t)32 * 2048 * 4;
constexpr size_t W_NINIT = W_MINIT + 4096;
constexpr size_t W_Z = W_NINIT + (size_t)32 * 16 * 256 * 4;
constexpr size_t W_ACT = W_Z;
constexpr size_t W_QB = W_Z + (size_t)MR * ZC * 2;
constexpr size_t W_KB = W_QB + (size_t)MR * 1024 * 2;
constexpr size_t W_CT = W_KB + (size_t)MR * 1024 * 2;
constexpr size_t W_WBA = W_CT;
constexpr size_t W_END = W_CT + (size_t)32 * 16 * 65536 * 2;
constexpr size_t O_Y = 0;
constexpr size_t O_CP = (size_t)MR * 1024;
constexpr size_t O_NP = O_CP + (size_t)8 * 4 * 65536;
constexpr size_t O_MP = O_NP + 8 * 4 * 256;
constexpr size_t O_CVP = O_MP + 32;
constexpr size_t O_CS = O_CVP + 8 * 3 * 2048;
constexpr size_t O_NS = O_CS + (size_t)128 * 4 * 65536;
constexpr size_t O_MS = O_NS + 128 * 4 * 256;
constexpr size_t O_CVS = O_MS + 512;
constexpr size_t O_VS = O_CVS + 128 * 3 * 2048;

struct Params { const float* in[30]; float* out; unsigned char* ws; };

__device__ __forceinline__ float bf2f(u16 b) { return __uint_as_float(((unsigned)b) << 16); }
__device__ __forceinline__ float bflo(unsigned w) { return __uint_as_float(w << 16); }
__device__ __forceinline__ float bfhi(unsigned w) { return __uint_as_float(w & 0xffff0000u); }
__device__ __forceinline__ unsigned pk2(float lo, float hi) { return pg8::cvt_pk_bf16(lo, hi); }
__device__ __forceinline__ float sigm(float x) { return 1.0f / (1.0f + __expf(-x)); }
__device__ __forceinline__ float gelu_t(float x) { return x * sigm(1.5957691216057308f * (x + 0.044715f * x * x * x)); }
__device__ __forceinline__ int bidx(int row) { return row < NPR ? (row >> 11) : 8 + ((row - NPR) >> 3); }
__device__ __forceinline__ float wsum(float v) {
#pragma unroll
    for (int o = 32; o > 0; o >>= 1) v += __shfl_xor(v, o);
    return v;
}
__device__ __forceinline__ void unpack8(const u32x4 v, float* f) { f[0] = bflo(v.x); f[1] = bfhi(v.x); f[2] = bflo(v.y); f[3] = bfhi(v.y); f[4] = bflo(v.z); f[5] = bfhi(v.z); f[6] = bflo(v.w); f[7] = bfhi(v.w); }
__device__ __forceinline__ u32x4 pack8(const float* f) { u32x4 r; r.x = pk2(f[0], f[1]); r.y = pk2(f[2], f[3]); r.z = pk2(f[4], f[5]); r.w = pk2(f[6], f[7]); return r; }

__device__ __forceinline__ bf16x8 frag_rm(LAS const u16* base, int stride, int r0, int k0, int lane) {
    return *(LAS const bf16x8*)(base + (r0 + (lane & 15)) * stride + k0 + (lane >> 4) * 8);
}
__device__ __forceinline__ bf16x8 frag_tr(LAS const u16* base, int stride, int n0, int k0, int lane) {
    const int g = lane >> 4, li = lane & 15, q = li >> 2, pp = li & 3;
    LAS const u16* a = base + (k0 + g * 8 + q) * stride + n0 + 4 * pp;
    const s16x4 lo = __builtin_amdgcn_ds_read_tr16_b64_v4i16((LAS s16x4*)a);
    const s16x4 hi = __builtin_amdgcn_ds_read_tr16_b64_v4i16((LAS s16x4*)(a + 4 * stride));
    return (bf16x8){lo[0], lo[1], lo[2], lo[3], hi[0], hi[1], hi[2], hi[3]};
}
#define MMA_T(acc, Bf, Af) acc = __builtin_amdgcn_mfma_f32_16x16x32_bf16(Bf, Af, acc, 0, 0, 0)

struct EpiF32B {
    static constexpr bool PERM = false, AFTER_DRAIN = false;
    float* C; int ldc; const float* bias;
    __device__ __forceinline__ void operator()(const f32x4 (&acc)[2][2][4][2], const pg8::Unit& u, int wr, int wc, int fr, int fq) const {
        const int row0 = u.pm * 256 + wr * 64 + fr, col0 = u.pn * 256 + wc * 32 + 4 * fq;
#pragma unroll
        for (int ai = 0; ai < 2; ++ai)
#pragma unroll
            for (int m = 0; m < 4; ++m) { float* rowp = C + (size_t)(row0 + ai * 128 + m * 16) * ldc + col0;
#pragma unroll
                for (int bj = 0; bj < 2; ++bj)
#pragma unroll
                    for (int n = 0; n < 2; ++n) *(f32x4*)(rowp + bj * 128 + n * 16) = acc[ai][bj][m][n] + *(const f32x4*)(bias + col0 + bj * 128 + n * 16); }
    }
};
struct EpiSwiglu {
    static constexpr bool PERM = true, AFTER_DRAIN = false;
    u16* O;
    __device__ __forceinline__ void operator()(const f32x4 (&acc)[2][2][4][2], const pg8::Unit& u, int wr, int wc, int fr, int fq) const {
        const int row0 = u.pm * 256 + wr * 64 + fr, col0 = u.pn * 128 + wc * 32 + 8 * fq;
#pragma unroll
        for (int ai = 0; ai < 2; ++ai)
#pragma unroll
            for (int m = 0; m < 4; ++m) { u16* rowp = O + (size_t)(row0 + ai * 128 + m * 16) * FF + col0;
                float o[8];
#pragma unroll
                for (int n = 0; n < 2; ++n)
#pragma unroll
                    for (int j = 0; j < 4; ++j) { const float a = acc[ai][0][m][n][j], b = acc[ai][1][m][n][j]; o[n * 4 + j] = a * sigm(a) * b; }
                *(u32x4*)rowp = pack8(o); }
    }
};
struct EpiZ {
    static constexpr bool PERM = true, AFTER_DRAIN = false;
    u16* O;
    __device__ __forceinline__ void operator()(const f32x4 (&acc)[2][2][4][2], const pg8::Unit& u, int wr, int wc, int fr, int fq) const {
        const int row0 = u.pm * 256 + wr * 64 + fr, col0 = u.pn * 256 + wc * 32 + 8 * fq, seg = u.pn >> 2;
#pragma unroll
        for (int ai = 0; ai < 2; ++ai)
#pragma unroll
            for (int m = 0; m < 4; ++m) { u16* rowp = O + (size_t)(row0 + ai * 128 + m * 16) * ZC + col0;
#pragma unroll
                for (int bj = 0; bj < 2; ++bj) { float o[8];
#pragma unroll
                    for (int n = 0; n < 2; ++n)
#pragma unroll
                        for (int j = 0; j < 4; ++j) { const float v = acc[ai][bj][m][n][j]; o[n * 4 + j] = seg < 2 ? gelu_t(v) : (seg < 5 ? v : sigm(v)); }
                    *(u32x4*)(rowp + bj * 128) = pack8(o); } }
    }
};
struct EpiResid {
    static constexpr bool PERM = false, AFTER_DRAIN = false;
    const float* xp; const float* xs; float* X; const float* gate; float coef;
    __device__ __forceinline__ void operator()(const f32x4 (&acc)[2][2][4][2], const pg8::Unit& u, int wr, int wc, int fr, int fq) const {
        const int row0 = u.pm * 256 + wr * 64 + fr, col0 = u.pn * 256 + wc * 32 + 4 * fq;
#pragma unroll
        for (int ai = 0; ai < 2; ++ai)
#pragma unroll
            for (int m = 0; m < 4; ++m) { const int row = row0 + ai * 128 + m * 16;
                const float* xin = (row < NPR ? xp + (size_t)row * 1024 : xs + (size_t)(row - NPR) * 1024) + col0;
                const float* gp = gate + (size_t)bidx(row) * ADAC + col0; float* op = X + (size_t)row * 1024 + col0;
#pragma unroll
                for (int bj = 0; bj < 2; ++bj)
#pragma unroll
                    for (int n = 0; n < 2; ++n) { const int o = bj * 128 + n * 16;
                        *(f32x4*)(op + o) = *(const f32x4*)(xin + o) + coef * (*(const f32x4*)(gp + o)) * acc[ai][bj][m][n]; } }
    }
};
template <class Epi> __device__ __forceinline__ void run_gemm(LAS unsigned char* lds, const u16* A, const u16* Bt, int M, int N, int K, const Epi& E) {
    pg8::Gemm g; g.A = A; g.Bt = Bt; g.M = M; g.N = N; g.K = K;
    pg8::StaticOrder S; S.init(M, N, (int)gridDim.x, (int)blockIdx.x);
    pg8::gemm_phase<Epi, pg8::StaticOrder, false>(lds, g, S, E, nullptr);
}

__device__ void phase_convert(const Params& p, LAS unsigned char* lds) {
    const int tid = threadIdx.x;
    LAS u16* T = (LAS u16*)lds;
    constexpr int NJ = 8;
    const int jn[NJ] = {5632, 1024, 8192, 1024, 5632, 1024, 9216, 2048};
    const int jk[NJ] = {1024, 2816, 1024, 1024, 1024, 2816, 1024, 1024};
    int total = 0;
#pragma unroll
    for (int j = 0; j < NJ; ++j) total += (jn[j] / 256) * (jk[j] / 64);
    for (int t = blockIdx.x; t < total; t += gridDim.x) {
        int lt = t, job = 0;
#pragma unroll
        for (int j = 0; j < NJ - 1; ++j) { const int c = (jn[j] / 256) * (jk[j] / 64); if (job == j && lt >= c) { lt -= c; job = j + 1; } }
        const float* src; int ld, K, mode; u16* dst;
        switch (job) {
            case 0: src = p.in[11]; ld = 5632; K = 1024; mode = 1; dst = (u16*)(p.ws + W_WB1); break;
            case 1: src = p.in[12]; ld = 1024; K = 2816; mode = 0; dst = (u16*)(p.ws + W_WB2); break;
            case 2: src = p.in[14]; ld = 8200; K = 1024; mode = 2; dst = (u16*)(p.ws + W_WB3); break;
            case 3: src = p.in[23]; ld = 1024; K = 1024; mode = 0; dst = (u16*)(p.ws + W_WB4); break;
            case 4: src = p.in[25]; ld = 5632; K = 1024; mode = 1; dst = (u16*)(p.ws + W_WB5); break;
            case 5: src = p.in[26]; ld = 1024; K = 2816; mode = 0; dst = (u16*)(p.ws + W_WB6); break;
            case 6: src = p.in[8]; ld = 9216; K = 1024; mode = 0; dst = (u16*)(p.ws + W_WBA); break;
            default: src = p.in[27]; ld = 2048; K = 1024; mode = 0; dst = (u16*)(p.ws + W_WBA) + (size_t)9216 * 1024; break;
        }
        const int nk = K / 64, tn = lt / nk, tk = lt - tn * nk, n0 = tn * 256, k0 = tk * 64;
        const int c4 = (tid & 63) * 4, kr = tid >> 6;
        int sc;
        if (mode == 1) sc = (c4 < 128) ? tn * 128 + c4 : FF + tn * 128 + (c4 - 128);
        else if (mode == 2) sc = (n0 < 6144 ? n0 : n0 + 8) + c4;
        else sc = n0 + c4;
        f32x4 v[8];
#pragma unroll
        for (int i = 0; i < 8; ++i) v[i] = *(const f32x4*)(src + (size_t)(k0 + kr + 8 * i) * ld + sc);
#pragma unroll
        for (int i = 0; i < 8; ++i) { const int k = kr + 8 * i;
            const unsigned a = pk2(v[i][0], v[i][1]), b = pk2(v[i][2], v[i][3]);
            T[(c4 + 0) * 72 + k] = (u16)a; T[(c4 + 1) * 72 + k] = (u16)(a >> 16); T[(c4 + 2) * 72 + k] = (u16)b; T[(c4 + 3) * 72 + k] = (u16)(b >> 16); }
        __syncthreads();
#pragma unroll
        for (int i = 0; i < 4; ++i) { const int q = tid + 512 * i, n = q >> 3, k8 = (q & 7) * 8;
            *(u32x4*)(dst + (size_t)(n0 + n) * K + k0 + k8) = *(LAS const u32x4*)(T + n * 72 + k8); }
        __syncthreads();
    }
    const int gt = blockIdx.x * 512 + tid, gs = gridDim.x * 512;
    u16* CS = (u16*)(p.ws + W_CS);
    for (int i = gt; i < 256 * 1024; i += gs) { const int r = i >> 10, c = i & 1023; float v = 0.f;
        if (r < 8) v = p.in[2][r * 1024 + c]; else if (r < 136) v = p.in[3][(r - 8) * 1024 + c];
        v = v * sigm(v); CS[i] = (u16)(pk2(v, 0.f) & 0xffffu); }
    float* BIAS = (float*)(p.ws + W_BIAS);
    for (int i = gt; i < ADAC; i += gs) BIAS[i] = i < 9216 ? p.in[9][i] : p.in[28][i - 9216];
    float* WG = (float*)(p.ws + W_WG);
    for (int i = gt; i < 8192; i += gs) { const int j = i >> 10, k = i & 1023; WG[i] = p.in[14][(size_t)k * 8200 + 6144 + j]; }
}

template <int WHICH> __device__ void phase_prep(const Params& p) {
    const int tid = threadIdx.x, lane = tid & 63, wid = tid >> 6;
    const float* ADA = (const float*)(p.ws + W_ADA);
    float* X = p.out + O_Y;
    u16* H = (u16*)(p.ws + W_H);
    const float* gv = WHICH == 0 ? p.in[10] : WHICH == 1 ? p.in[13] : WHICH == 2 ? p.in[24] : p.in[29];
    const int jsh = WHICH == 3 ? 9 : 3 * WHICH, jsc = jsh + 1;
    const float* WG = (const float*)(p.ws + W_WG);
    for (int row = blockIdx.x * 8 + wid; row < MR; row += gridDim.x * 8) {
        const float* xr = WHICH == 0 ? (row < NPR ? p.in[0] + (size_t)row * 1024 : p.in[1] + (size_t)(row - NPR) * 1024) : X + (size_t)row * 1024;
        const float* ab = ADA + (size_t)bidx(row) * ADAC;
        f32x4 v[4]; float ss = 0.f;
#pragma unroll
        for (int i = 0; i < 4; ++i) { v[i] = *(const f32x4*)(xr + i * 256 + lane * 4); ss += v[i][0] * v[i][0] + v[i][1] * v[i][1] + v[i][2] * v[i][2] + v[i][3] * v[i][3]; }
        ss = wsum(ss);
        const float rstd = rsqrtf(ss * (1.0f / 1024.0f) + 1e-6f);
        float ga[8];
#pragma unroll
        for (int j = 0; j < 8; ++j) ga[j] = 0.f;
#pragma unroll
        for (int i = 0; i < 4; ++i) { const int c = i * 256 + lane * 4;
            const f32x4 g4 = *(const f32x4*)(gv + c), s4 = *(const f32x4*)(ab + jsc * 1024 + c), h4 = *(const f32x4*)(ab + jsh * 1024 + c);
            f32x4 h = v[i] * rstd * g4 * (1.0f + s4) + h4;
            if (WHICH == 3) { *(f32x4*)(X + (size_t)row * 1024 + c) = h; }
            else { u32x2 w; w.x = pk2(h[0], h[1]); w.y = pk2(h[2], h[3]); *(u32x2*)(H + (size_t)row * 1024 + c) = w; }
            if (WHICH == 1) {
#pragma unroll
                for (int j = 0; j < 8; ++j) { const f32x4 w4 = *(const f32x4*)(WG + j * 1024 + c); ga[j] += h[0] * w4[0] + h[1] * w4[1] + h[2] * w4[2] + h[3] * w4[3]; } }
        }
        if (WHICH == 1) {
            float mine = 0.f;
#pragma unroll
            for (int j = 0; j < 8; ++j) { const float s = wsum(ga[j]); if (lane == j) mine = s; }
            if (lane < 8) ((float*)(p.ws + W_GATES))[(size_t)row * 8 + lane] = mine + p.in[15][lane];
        }
    }
}

__device__ void gmlp_prompt_unit(const Params& p, LAS unsigned char* lds, int b, int c, int g) {
    const int tid = threadIdx.x, lane = tid & 63, wid = tid >> 6;
    LAS float* mu = (LAS float*)lds; LAS float* rs = mu + 128;
    LAS u16* WL = (LAS u16*)(lds + 1024);
    LAS u16* VL = (LAS u16*)(lds + 1024 + 34816);
    u16* Z = (u16*)(p.ws + W_Z);
    const size_t R0 = (size_t)b * 2048 + c * 128;
    {   const int r = tid >> 2, part = tid & 3; const u16* src = Z + (R0 + r) * ZC + 1024 + part * 256;
        float s = 0.f, ss = 0.f;
#pragma unroll 8
        for (int i = 0; i < 32; ++i) { float f[8]; unpack8(*(const u32x4*)(src + i * 8), f);
#pragma unroll
            for (int j = 0; j < 8; ++j) { s += f[j]; ss += f[j] * f[j]; } }
        s += __shfl_xor(s, 1); s += __shfl_xor(s, 2); ss += __shfl_xor(ss, 1); ss += __shfl_xor(ss, 2);
        if (part == 0) { const float m = s * (1.0f / 1024.0f); const float var = fmaxf(ss * (1.0f / 1024.0f) - m * m, 0.f); mu[r] = m; rs[r] = rsqrtf(var + 1e-6f); } }
    {   const int t = tid >> 2, s0 = (tid & 3) * 32; const float* w = p.in[20] + (size_t)g * 16384 + t * 128 + s0;
#pragma unroll
        for (int i = 0; i < 8; ++i) { const f32x4 v = *(const f32x4*)(w + i * 4); const int s = s0 + i * 4;
            u32x2 o; o.x = pk2(s <= t ? v[0] : 0.f, s + 1 <= t ? v[1] : 0.f); o.y = pk2(s + 2 <= t ? v[2] : 0.f, s + 3 <= t ? v[3] : 0.f);
            *(LAS u32x2*)(WL + t * 136 + s) = o; } }
    __syncthreads();
    {   const int r = tid >> 2, part = tid & 3; const u16* src = Z + (R0 + r) * ZC + 1024 + g * 256 + part * 64;
        const float m = mu[r], rsd = rs[r]; const float* lg = p.in[18] + g * 256 + part * 64; const float* lb = p.in[19] + g * 256 + part * 64;
#pragma unroll
        for (int i = 0; i < 8; ++i) { float f[8]; unpack8(*(const u32x4*)(src + i * 8), f);
#pragma unroll
            for (int j = 0; j < 8; ++j) f[j] = (f[j] - m) * rsd * lg[i * 8 + j] + lb[i * 8 + j];
            *(LAS u32x4*)(VL + r * 264 + part * 64 + i * 8) = pack8(f); } }
    __syncthreads();
    f32x4 acc[8][2];
#pragma unroll
    for (int i = 0; i < 8; ++i) { acc[i][0] = (f32x4){0.f, 0.f, 0.f, 0.f}; acc[i][1] = (f32x4){0.f, 0.f, 0.f, 0.f}; }
#pragma unroll
    for (int kk = 0; kk < 4; ++kk) {
        const bf16x8 B0 = frag_tr(VL, 264, 32 * wid, 32 * kk, lane), B1 = frag_tr(VL, 264, 32 * wid + 16, 32 * kk, lane);
#pragma unroll
        for (int i = 0; i < 8; ++i) if (32 * kk <= 16 * i + 15) { const bf16x8 A = frag_rm(WL, 136, 16 * i, 32 * kk, lane); MMA_T(acc[i][0], B0, A); MMA_T(acc[i][1], B1, A); }
    }
    const float* bs = p.in[21] + g * 128;
#pragma unroll
    for (int i = 0; i < 8; ++i) { const int t = 16 * i + (lane & 15); const size_t row = R0 + t; const float bsv = bs[t];
#pragma unroll
        for (int nn = 0; nn < 2; ++nn) { const int col = g * 256 + 32 * wid + 16 * nn + (lane >> 4) * 4;
            const u32x2 gu = *(const u32x2*)(Z + row * ZC + col), ga = *(const u32x2*)(Z + row * ZC + 6 * 1024 + col);
            const float o0 = bflo(ga.x) * bflo(gu.x) * (acc[i][nn][0] + bsv), o1 = bfhi(ga.x) * bfhi(gu.x) * (acc[i][nn][1] + bsv);
            const float o2 = bflo(ga.y) * bflo(gu.y) * (acc[i][nn][2] + bsv), o3 = bfhi(ga.y) * bfhi(gu.y) * (acc[i][nn][3] + bsv);
            u32x2 o; o.x = pk2(o0, o1); o.y = pk2(o2, o3); *(u32x2*)(Z + row * ZC + col) = o; } }
    __syncthreads();
}

__device__ void gmlp_sample_unit(const Params& p, LAS unsigned char* lds, int b) {
    const int tid = threadIdx.x, lane = tid & 63, wid = tid >> 6;
    LAS float* VS = (LAS float*)lds;
    u16* Z = (u16*)(p.ws + W_Z);
    const size_t r0 = (size_t)NPR + b * 8;
    {   const int t = wid; const u16* src = Z + (r0 + t) * ZC + 1024 + lane * 16;
        float f[16]; unpack8(*(const u32x4*)src, f); unpack8(*(const u32x4*)(src + 8), f + 8);
        float s = 0.f, ss = 0.f;
#pragma unroll
        for (int j = 0; j < 16; ++j) { s += f[j]; ss += f[j] * f[j]; }
        s = wsum(s); ss = wsum(ss);
        const float m = s * (1.0f / 1024.0f), rsd = rsqrtf(fmaxf(ss * (1.0f / 1024.0f) - m * m, 0.f) + 1e-6f);
        float* vo = p.out + O_VS + ((size_t)b * 8 + t) * 1024 + lane * 16;
#pragma unroll
        for (int j = 0; j < 16; ++j) { const float v = (f[j] - m) * rsd * p.in[18][lane * 16 + j] + p.in[19][lane * 16 + j]; VS[t * 1024 + lane * 16 + j] = v; vo[j] = v; } }
    __syncthreads();
    {   const int c = tid * 2, g = c >> 8; const float* ws = p.in[20] + (size_t)g * 16384; const float* bs = p.in[21] + g * 128;
#pragma unroll
        for (int t = 0; t < 8; ++t) { float a0 = bs[t], a1 = a0;
#pragma unroll
            for (int s = 0; s <= t; ++s) { const float w = ws[t * 128 + s]; a0 += w * VS[s * 1024 + c]; a1 += w * VS[s * 1024 + c + 1]; }
            const size_t row = r0 + t; const unsigned gu = *(const unsigned*)(Z + row * ZC + c), ga = *(const unsigned*)(Z + row * ZC + 6 * 1024 + c);
            *(unsigned*)(Z + row * ZC + c) = pk2(bflo(ga) * bflo(gu) * a0, bfhi(ga) * bfhi(gu) * a1); } }
    __syncthreads();
}

__device__ void conv_unit(const Params& p, size_t rowbase, int nrows, int histmode, const float* hist, float* outconv) {
    const int tid = threadIdx.x, c4 = tid * 4;
    const u16* Z = (const u16*)(p.ws + W_Z);
    u16* dst = c4 < 1024 ? (u16*)(p.ws + W_QB) + c4 : (u16*)(p.ws + W_KB) + (c4 - 1024);
    const float osc = c4 < 1024 ? 1.0f : 0.0625f;
    f32x4 w[4];
#pragma unroll
    for (int j = 0; j < 4; ++j) w[j] = *(const f32x4*)(p.in[16] + j * 2048 + c4);
    const f32x4 cb = *(const f32x4*)(p.in[17] + c4);
    f32x4 x[3];
#pragma unroll
    for (int j = 0; j < 3; ++j) {
        if (histmode == 0) x[j] = (f32x4){0.f, 0.f, 0.f, 0.f};
        else if (histmode == 1) { const u32x2 v = *(const u32x2*)(Z + (rowbase - 3 + j) * ZC + 2048 + c4); x[j] = (f32x4){bflo(v.x), bfhi(v.x), bflo(v.y), bfhi(v.y)}; }
        else x[j] = *(const f32x4*)(hist + j * 2048 + c4);
    }
#pragma unroll 8
    for (int t = 0; t < nrows; ++t) {
        const u32x2 v = *(const u32x2*)(Z + (rowbase + t) * ZC + 2048 + c4);
        const f32x4 xv = (f32x4){bflo(v.x), bfhi(v.x), bflo(v.y), bfhi(v.y)};
        f32x4 y = cb + w[0] * x[0] + w[1] * x[1] + w[2] * x[2] + w[3] * xv;
        u32x2 o; o.x = pk2(y[0] * sigm(y[0]) * osc, y[1] * sigm(y[1]) * osc); o.y = pk2(y[2] * sigm(y[2]) * osc, y[3] * sigm(y[3]) * osc);
        *(u32x2*)(dst + (rowbase + t) * 1024) = o;
        if (outconv && t >= nrows - 3) *(f32x4*)(outconv + (size_t)(t - (nrows - 3)) * 2048 + c4) = xv;
        x[0] = x[1]; x[1] = x[2]; x[2] = xv;
    }
}

__device__ void phase_mix1(const Params& p, LAS unsigned char* lds) {
    for (int u = blockIdx.x; u < 896; u += gridDim.x) {
        if (u < 512) gmlp_prompt_unit(p, lds, u >> 6, (u >> 2) & 15, u & 3);
        else if (u < 640) { const int v = u - 512, b = v >> 4, c = v & 15; conv_unit(p, (size_t)b * 2048 + c * 128, 128, c == 0 ? 0 : 1, nullptr, c == 15 ? p.out + O_CVP + (size_t)b * 6144 : nullptr); }
        else if (u < 768) gmlp_sample_unit(p, lds, u - 640);
        else { const int b = u - 768; conv_unit(p, (size_t)NPR + b * 8, 8, 2, p.in[7] + (size_t)b * 6144, p.out + O_CVS + (size_t)b * 6144); }
    }
}

__device__ __forceinline__ float logsig(float f) { return fminf(f, 0.f) - log1pf(__expf(-fabsf(f))); }

__device__ void scan_prompt_unit(const Params& p, LAS unsigned char* lds, int b, int h, int slab) {
    const int tid = threadIdx.x, lane = tid & 63, wid = tid >> 6, bh = b * 4 + h;
    LAS float* ASl = (LAS float*)lds;
    LAS float* Wl = ASl + 2048;
    LAS float* Mc = Wl + 128;
    LAS float* mi = Mc + 16;
    LAS float* bL = mi + 16;
    LAS float* amx = bL + 16;
    LAS float* nvec = amx + 16;
    LAS u16* KL = (LAS u16*)(lds + 16384);
    LAS u16* VWL = (LAS u16*)(lds + 16384 + 67584);
    const float* GATES = (const float*)(p.ws + W_GATES);
    const u16* Z = (const u16*)(p.ws + W_Z); const u16* KB = (const u16*)(p.ws + W_KB);
    u16* CT = (u16*)(p.ws + W_CT);
    const size_t Rb = (size_t)b * 2048;
    {   const int p0 = tid * 4; float iv[4], bv[4], av[4], cm[4];
        float run = 0.f;
#pragma unroll
        for (int j = 0; j < 4; ++j) { const float* gp = GATES + (Rb + p0 + j) * 8; iv[j] = gp[h]; run += logsig(gp[4 + h]); bv[j] = run; }
        float sc = run;
#pragma unroll
        for (int d = 1; d < 32; d <<= 1) { const float o = __shfl_up(sc, d, 32); if ((lane & 31) >= d) sc += o; }
        const float off = sc - run;
        float rm = -INFINITY;
#pragma unroll
        for (int j = 0; j < 4; ++j) { bv[j] += off; av[j] = iv[j] - bv[j]; rm = fmaxf(rm, av[j]); cm[j] = rm; }
        float sm = rm;
#pragma unroll
        for (int d = 1; d < 32; d <<= 1) { const float o = __shfl_up(sm, d, 32); if ((lane & 31) >= d) sm = fmaxf(sm, o); }
        float em = __shfl_up(sm, 1, 32); if ((lane & 31) == 0) em = -INFINITY;
#pragma unroll
        for (int j = 0; j < 4; ++j) { cm[j] = fmaxf(cm[j], em); ASl[p0 + j] = av[j]; }
        if (slab == 0) {
            *(f32x4*)((float*)(p.ws + W_BS) + (size_t)bh * 2048 + p0) = (f32x4){bv[0], bv[1], bv[2], bv[3]};
            *(f32x4*)((float*)(p.ws + W_AS) + (size_t)bh * 2048 + p0) = (f32x4){av[0], av[1], av[2], av[3]};
            *(f32x4*)((float*)(p.ws + W_CM) + (size_t)bh * 2048 + p0) = (f32x4){cm[0], cm[1], cm[2], cm[3]}; }
        if ((lane & 31) == 31) { bL[p0 >> 7] = bv[3]; amx[p0 >> 7] = cm[3]; } }
    __syncthreads();
    if (tid == 0) { float m = 0.f;
        for (int c = 0; c < 16; ++c) { mi[c] = m; const float M = fmaxf(m, amx[c]); Mc[c] = M; if (slab == 0) ((float*)(p.ws + W_MINIT))[bh * 16 + c] = m; m = bL[c] + M; }
        if (slab == 0) p.out[O_MP + bh] = m; }
    if (tid < 256) nvec[tid] = 0.f;
    __syncthreads();
    f32x4 acc[2][2];
#pragma unroll
    for (int i = 0; i < 2; ++i) { acc[i][0] = (f32x4){0.f, 0.f, 0.f, 0.f}; acc[i][1] = (f32x4){0.f, 0.f, 0.f, 0.f}; }
    for (int c = 0; c < 16; ++c) {
        const float M = Mc[c], ap = __expf(mi[c] - M);
        if (tid < 128) Wl[tid] = __expf(ASl[c * 128 + tid] - M);
        const size_t R0 = Rb + c * 128;
#pragma unroll
        for (int i = 0; i < 8; ++i) { const int q = tid + 512 * i, r = q >> 5, cc = (q & 31) * 8;
            *(LAS u32x4*)(KL + r * 264 + cc) = *(const u32x4*)(KB + (R0 + r) * 1024 + h * 256 + cc); }
        __syncthreads();
        {   const int r = tid >> 2, cc = (tid & 3) * 8; float f[8]; unpack8(*(const u32x4*)(Z + (R0 + r) * ZC + 4096 + h * 256 + slab * 32 + cc), f);
            const float w = Wl[r];
#pragma unroll
            for (int j = 0; j < 8; ++j) f[j] *= w;
            *(LAS u32x4*)(VWL + r * 40 + cc) = pack8(f); }
        __syncthreads();
#pragma unroll
        for (int i = 0; i < 2; ++i) { acc[i][0] *= ap; acc[i][1] *= ap; }
#pragma unroll
        for (int kk = 0; kk < 4; ++kk) {
            const bf16x8 A0 = frag_tr(VWL, 40, 0, 32 * kk, lane), A1 = frag_tr(VWL, 40, 16, 32 * kk, lane);
            const bf16x8 B0 = frag_tr(KL, 264, 32 * wid, 32 * kk, lane), B1 = frag_tr(KL, 264, 32 * wid + 16, 32 * kk, lane);
            MMA_T(acc[0][0], B0, A0); MMA_T(acc[0][1], B1, A0); MMA_T(acc[1][0], B0, A1); MMA_T(acc[1][1], B1, A1);
        }
        if (slab == 0 && tid < 256) { float s = 0.f;
#pragma unroll 8
            for (int r = 0; r < 128; ++r) s += Wl[r] * bf2f(KL[r * 264 + tid]);
            const float nn = ap * nvec[tid] + s; nvec[tid] = nn;
            if (c < 15) ((float*)(p.ws + W_NINIT))[((size_t)bh * 16 + c + 1) * 256 + tid] = nn; }
        if (c < 15) {
#pragma unroll
            for (int et = 0; et < 2; ++et)
#pragma unroll
                for (int dt = 0; dt < 2; ++dt) { const int e = slab * 32 + 16 * et + (lane & 15), d = 32 * wid + 16 * dt + (lane >> 4) * 4;
                    u32x2 o; o.x = pk2(acc[et][dt][0], acc[et][dt][1]); o.y = pk2(acc[et][dt][2], acc[et][dt][3]);
                    *(u32x2*)(CT + (((size_t)bh * 16 + c + 1) * 256 + e) * 256 + d) = o; } }
        __syncthreads();
    }
#pragma unroll
    for (int et = 0; et < 2; ++et)
#pragma unroll
        for (int dt = 0; dt < 2; ++dt) { const int e = slab * 32 + 16 * et + (lane & 15), d = 32 * wid + 16 * dt + (lane >> 4) * 4;
#pragma unroll
            for (int j = 0; j < 4; ++j) p.out[O_CP + ((size_t)bh * 256 + d + j) * 256 + e] = acc[et][dt][j]; }
    if (slab == 0 && tid < 256) p.out[O_NP + (size_t)bh * 256 + tid] = nvec[tid];
    __syncthreads();
}

__device__ void sample_unit(const Params& p, LAS unsigned char* lds, int b, int h) {
    const int tid = threadIdx.x, lane = tid & 63, wid = tid >> 6, bh = b * 4 + h;
    LAS float* QF = (LAS float*)lds;
    LAS float* KF = QF + 2048;
    LAS float* KWF = KF + 2048;
    LAS float* VF = KWF + 2048;
    LAS float* NUM = VF + 2048;
    LAS float* SC = NUM + 4096;
    LAS float* QN = SC + 64;
    LAS float* sa = QN + 8;
    LAS float* sM = sa + 8;
    LAS float* swi = sM + 8;
    LAS float* semt = swi + 8;
    LAS float* sw7 = semt + 8;
    LAS float* sden = sw7 + 8;
    LAS float* smisc = sden + 8;
    const float* GATES = (const float*)(p.ws + W_GATES);
    const u16* Z = (const u16*)(p.ws + W_Z); const u16* QB = (const u16*)(p.ws + W_QB); const u16* KB = (const u16*)(p.ws + W_KB);
    const size_t r0 = (size_t)NPR + b * 8;
    const float m0 = p.in[6][bh];
    if (tid == 0) { float bc = 0.f, cm = -INFINITY; float a[8];
        for (int t = 0; t < 8; ++t) { const float* gp = GATES + (r0 + t) * 8; bc += logsig(gp[4 + h]); a[t] = gp[h] - bc; cm = fmaxf(cm, a[t]); const float M = fmaxf(m0, cm);
            sa[t] = a[t]; sM[t] = M; swi[t] = __expf(m0 - M); semt[t] = __expf(-(bc + M)); if (t == 7) { smisc[0] = __expf(m0 - M); smisc[1] = bc + M; } }
        const float M7 = sM[7];
        for (int s = 0; s < 8; ++s) sw7[s] = __expf(a[s] - M7); }
    {   const int t = tid >> 6, d4 = (tid & 63) * 4;
        const u32x2 q = *(const u32x2*)(QB + (r0 + t) * 1024 + h * 256 + d4), k = *(const u32x2*)(KB + (r0 + t) * 1024 + h * 256 + d4), v = *(const u32x2*)(Z + (r0 + t) * ZC + 4096 + h * 256 + d4);
        QF[(d4 + 0) * 8 + t] = bflo(q.x); QF[(d4 + 1) * 8 + t] = bfhi(q.x); QF[(d4 + 2) * 8 + t] = bflo(q.y); QF[(d4 + 3) * 8 + t] = bfhi(q.y);
        KF[(d4 + 0) * 8 + t] = bflo(k.x); KF[(d4 + 1) * 8 + t] = bfhi(k.x); KF[(d4 + 2) * 8 + t] = bflo(k.y); KF[(d4 + 3) * 8 + t] = bfhi(k.y);
        VF[t * 256 + d4 + 0] = bflo(v.x); VF[t * 256 + d4 + 1] = bfhi(v.x); VF[t * 256 + d4 + 2] = bflo(v.y); VF[t * 256 + d4 + 3] = bfhi(v.y); }
    __syncthreads();
    {   const int pair = tid >> 3, t = pair >> 3, s = pair & 7, sub = tid & 7; float dot = 0.f, qn = 0.f;
        const float* n0 = p.in[5] + (size_t)bh * 256;
#pragma unroll 8
        for (int i = 0; i < 32; ++i) { const int d = sub * 32 + i; const float q = QF[d * 8 + t]; dot += q * KF[d * 8 + s]; qn += q * n0[d]; }
        dot += __shfl_xor(dot, 1); dot += __shfl_xor(dot, 2); dot += __shfl_xor(dot, 4);
        qn += __shfl_xor(qn, 1); qn += __shfl_xor(qn, 2); qn += __shfl_xor(qn, 4);
        if (sub == 0) { SC[t * 8 + s] = s <= t ? dot * __expf(fminf(sa[s] - sM[t], 0.f)) : 0.f; if (s == 0) QN[t] = qn; }
        const int d = tid >> 1, s4 = (tid & 1) * 4;
#pragma unroll
        for (int j = 0; j < 4; ++j) KWF[d * 8 + s4 + j] = KF[d * 8 + s4 + j] * sw7[s4 + j]; }
    __syncthreads();
    if (tid < 8) { float dn = swi[tid] * QN[tid];
        for (int s = 0; s < 8; ++s) dn += SC[tid * 8 + s];
        sden[tid] = dn; }
    const float ap = smisc[0];
    {   const int e = tid & 255, dh = tid >> 8; float vv[8], num[8];
#pragma unroll
        for (int s = 0; s < 8; ++s) { vv[s] = VF[s * 256 + e]; num[s] = 0.f; }
        const float* C0 = p.in[4] + (size_t)bh * 65536 + e; float* Co = p.out + O_CS + (size_t)bh * 65536 + e;
#pragma unroll 4
        for (int i = 0; i < 128; ++i) { const int d = dh * 128 + i; const float c0 = C0[(size_t)d * 256];
            const f32x4 q0 = *(LAS const f32x4*)(QF + d * 8), q1 = *(LAS const f32x4*)(QF + d * 8 + 4), k0 = *(LAS const f32x4*)(KWF + d * 8), k1 = *(LAS const f32x4*)(KWF + d * 8 + 4);
            float cn = ap * c0;
#pragma unroll
            for (int j = 0; j < 4; ++j) { num[j] += q0[j] * c0; num[4 + j] += q1[j] * c0; cn += k0[j] * vv[j] + k1[j] * vv[4 + j]; }
            Co[(size_t)d * 256] = cn; }
#pragma unroll
        for (int t = 0; t < 8; ++t) NUM[(dh * 8 + t) * 256 + e] = num[t];
        if (tid < 256) { const int d = tid; float s = ap * p.in[5][(size_t)bh * 256 + d];
#pragma unroll
            for (int j = 0; j < 8; ++j) s += KWF[d * 8 + j];
            p.out[O_NS + (size_t)bh * 256 + d] = s; }
        if (tid == 0) p.out[O_MS + bh] = smisc[1]; }
    __syncthreads();
    {   const int t = wid, e0 = lane * 4; const float wi = swi[t], dn = fmaxf(fabsf(sden[t]), semt[t]); float hv[4]; float s1 = 0.f, s2 = 0.f;
#pragma unroll
        for (int j = 0; j < 4; ++j) { const int e = e0 + j; float n = wi * (NUM[t * 256 + e] + NUM[(8 + t) * 256 + e]);
#pragma unroll
            for (int s = 0; s < 8; ++s) n += SC[t * 8 + s] * VF[s * 256 + e];
            hv[j] = n / dn; s1 += hv[j]; s2 += hv[j] * hv[j]; }
        s1 = wsum(s1); s2 = wsum(s2);
        const float mean = s1 * (1.0f / 256.0f), rstd = rsqrtf(fmaxf(s2 * (1.0f / 256.0f) - mean * mean, 0.f) + 1e-6f);
        const size_t row = r0 + t; const int col = h * 256 + e0;
        const u32x2 ma = *(const u32x2*)(Z + row * ZC + col), so = *(const u32x2*)(Z + row * ZC + 5 * 1024 + col), gb = *(const u32x2*)(Z + row * ZC + 7 * 1024 + col);
        const f32x4 ng = *(const f32x4*)(p.in[22] + col);
        const float o0 = bflo(ma.x) + bflo(gb.x) * bflo(so.x) * (hv[0] - mean) * rstd * ng[0], o1 = bfhi(ma.x) + bfhi(gb.x) * bfhi(so.x) * (hv[1] - mean) * rstd * ng[1];
        const float o2 = bflo(ma.y) + bflo(gb.y) * bflo(so.y) * (hv[2] - mean) * rstd * ng[2], o3 = bfhi(ma.y) + bfhi(gb.y) * bfhi(so.y) * (hv[3] - mean) * rstd * ng[3];
        u32x2 o; o.x = pk2(o0, o1); o.y = pk2(o2, o3); *(u32x2*)((u16*)(p.ws + W_H) + row * 1024 + col) = o; }
    __syncthreads();
}

__device__ void phase_mix2(const Params& p, LAS unsigned char* lds) {
    for (int u = blockIdx.x; u < 768; u += gridDim.x) {
        if (u < 256) scan_prompt_unit(p, lds, u >> 5, (u >> 3) & 3, u & 7);
        else { const int v = u - 256; sample_unit(p, lds, v >> 2, v & 3); }
    }
}

__device__ void out_prompt_unit(const Params& p, LAS unsigned char* lds, int b, int h, int c, int th) {
    const int tid = threadIdx.x, lane = tid & 63, wid = tid >> 6, bh = b * 4 + h;
    LAS u16* QL = (LAS u16*)lds;
    LAS u16* KVL = (LAS u16*)(lds + 33792);
    LAS u16* PL = (LAS u16*)(lds + 101376);
    LAS float* al = (LAS float*)(lds + 118784);
    LAS float* Ml = al + 128;
    LAS float* wil = Ml + 64;
    LAS float* emtl = wil + 64;
    LAS float* RS = emtl + 64;
    LAS float* DEN = RS + 512;
    LAS float* QN = DEN + 64;
    LAS float* nin = QN + 64;
    LAS float* LNS = nin + 256;
    const u16* Z = (const u16*)(p.ws + W_Z); const u16* QB = (const u16*)(p.ws + W_QB); const u16* KB = (const u16*)(p.ws + W_KB);
    const u16* CT = (const u16*)(p.ws + W_CT);
    const size_t R0 = (size_t)b * 2048 + c * 128;
    const int ns = 64 * (th + 1);
    if (tid < 128) al[tid] = ((const float*)(p.ws + W_AS))[(size_t)bh * 2048 + c * 128 + tid];
    if (tid < 64) { const int t = 64 * th + tid; const float cm = ((const float*)(p.ws + W_CM))[(size_t)bh * 2048 + c * 128 + t], bt = ((const float*)(p.ws + W_BS))[(size_t)bh * 2048 + c * 128 + t];
        const float mi = ((const float*)(p.ws + W_MINIT))[bh * 16 + c]; const float M = fmaxf(mi, cm);
        Ml[tid] = M; wil[tid] = __expf(mi - M); emtl[tid] = __expf(-(bt + M)); }
    if (tid < 256) nin[tid] = c > 0 ? ((const float*)(p.ws + W_NINIT))[((size_t)bh * 16 + c) * 256 + tid] : 0.f;
#pragma unroll
    for (int i = 0; i < 4; ++i) { const int q = tid + 512 * i, r = q >> 5, cc = (q & 31) * 8;
        *(LAS u32x4*)(QL + r * 264 + cc) = *(const u32x4*)(QB + (R0 + 64 * th + r) * 1024 + h * 256 + cc); }
    for (int i = 0; i < ns / 16; ++i) { const int q = tid + 512 * i, r = q >> 5, cc = (q & 31) * 8;
        *(LAS u32x4*)(KVL + r * 264 + cc) = *(const u32x4*)(KB + (R0 + r) * 1024 + h * 256 + cc); }
    __syncthreads();
    if (16 * wid < ns) {
        f32x4 sacc[4];
#pragma unroll
        for (int i = 0; i < 4; ++i) sacc[i] = (f32x4){0.f, 0.f, 0.f, 0.f};
#pragma unroll
        for (int kk = 0; kk < 8; ++kk) { const bf16x8 B = frag_rm(KVL, 264, 16 * wid, 32 * kk, lane);
#pragma unroll
            for (int tt = 0; tt < 4; ++tt) { const bf16x8 A = frag_rm(QL, 264, 16 * tt, 32 * kk, lane); MMA_T(sacc[tt], B, A); } }
        const int s0 = 16 * wid + (lane >> 4) * 4;
#pragma unroll
        for (int tt = 0; tt < 4; ++tt) { const int tl = 16 * tt + (lane & 15), tg = 64 * th + tl; const float M = Ml[tl]; float pv[4]; float ps = 0.f;
#pragma unroll
            for (int j = 0; j < 4; ++j) { const int s = s0 + j; pv[j] = s <= tg ? sacc[tt][j] * __expf(fminf(al[s] - M, 0.f)) : 0.f; ps += pv[j]; }
            ps += __shfl_xor(ps, 16); ps += __shfl_xor(ps, 32);
            if (lane < 16) RS[wid * 64 + tl] = ps;
            u32x2 o; o.x = pk2(pv[0], pv[1]); o.y = pk2(pv[2], pv[3]); *(LAS u32x2*)(PL + tl * 136 + s0) = o; }
    } else { RS[wid * 64 + lane] = 0.f; }
    {   const int t = tid >> 3, sub = tid & 7; float qn = 0.f;
#pragma unroll 8
        for (int i = 0; i < 32; ++i) { const int d = sub * 32 + i; qn += bf2f(QL[t * 264 + d]) * nin[d]; }
        qn += __shfl_xor(qn, 1); qn += __shfl_xor(qn, 2); qn += __shfl_xor(qn, 4);
        if (sub == 0) QN[t] = qn; }
    __syncthreads();
    for (int i = 0; i < ns / 16; ++i) { const int q = tid + 512 * i, r = q >> 5, cc = (q & 31) * 8;
        *(LAS u32x4*)(KVL + r * 264 + cc) = *(const u32x4*)(Z + (R0 + r) * ZC + 4096 + h * 256 + cc); }
    if (tid < 64) { float dn = wil[tid] * QN[tid];
#pragma unroll
        for (int w = 0; w < 8; ++w) dn += RS[w * 64 + tid];
        DEN[tid] = dn; }
    f32x4 acc[4][2];
#pragma unroll
    for (int i = 0; i < 4; ++i) { acc[i][0] = (f32x4){0.f, 0.f, 0.f, 0.f}; acc[i][1] = (f32x4){0.f, 0.f, 0.f, 0.f}; }
    if (c > 0) {
        const u16* cb = CT + (((size_t)bh * 16 + c) * 256 + 32 * wid + (lane & 15)) * 256 + (lane >> 4) * 8;
#pragma unroll
        for (int kk = 0; kk < 8; ++kk) { const bf16x8 B0 = *(const bf16x8*)(cb + 32 * kk), B1 = *(const bf16x8*)(cb + 16 * 256 + 32 * kk);
#pragma unroll
            for (int tt = 0; tt < 4; ++tt) { const bf16x8 A = frag_rm(QL, 264, 16 * tt, 32 * kk, lane); MMA_T(acc[tt][0], B0, A); MMA_T(acc[tt][1], B1, A); } }
#pragma unroll
        for (int tt = 0; tt < 4; ++tt) { const float w = wil[16 * tt + (lane & 15)]; acc[tt][0] *= w; acc[tt][1] *= w; }
    }
    __syncthreads();
    for (int kk = 0; kk < ns / 32; ++kk) { const bf16x8 B0 = frag_tr(KVL, 264, 32 * wid, 32 * kk, lane), B1 = frag_tr(KVL, 264, 32 * wid + 16, 32 * kk, lane);
#pragma unroll
        for (int tt = 0; tt < 4; ++tt) { const bf16x8 A = frag_rm(PL, 136, 16 * tt, 32 * kk, lane); MMA_T(acc[tt][0], B0, A); MMA_T(acc[tt][1], B1, A); } }
#pragma unroll
    for (int tt = 0; tt < 4; ++tt) { const int tl = 16 * tt + (lane & 15); const float inv = 1.0f / fmaxf(fabsf(DEN[tl]), emtl[tl]); float s1 = 0.f, s2 = 0.f;
#pragma unroll
        for (int et = 0; et < 2; ++et) { acc[tt][et] *= inv;
#pragma unroll
            for (int j = 0; j < 4; ++j) { s1 += acc[tt][et][j]; s2 += acc[tt][et][j] * acc[tt][et][j]; } }
        s1 += __shfl_xor(s1, 16); s1 += __shfl_xor(s1, 32); s2 += __shfl_xor(s2, 16); s2 += __shfl_xor(s2, 32);
        if (lane < 16) { LNS[(wid * 64 + tl) * 2] = s1; LNS[(wid * 64 + tl) * 2 + 1] = s2; } }
    __syncthreads();
    u16* H = (u16*)(p.ws + W_H);
#pragma unroll
    for (int tt = 0; tt < 4; ++tt) { const int tl = 16 * tt + (lane & 15); float s1 = 0.f, s2 = 0.f;
#pragma unroll
        for (int w = 0; w < 8; ++w) { s1 += LNS[(w * 64 + tl) * 2]; s2 += LNS[(w * 64 + tl) * 2 + 1]; }
        const float mean = s1 * (1.0f / 256.0f), rstd = rsqrtf(fmaxf(s2 * (1.0f / 256.0f) - mean * mean, 0.f) + 1e-6f);
        const size_t row = R0 + 64 * th + tl;
#pragma unroll
        for (int et = 0; et < 2; ++et) { const int col = h * 256 + 32 * wid + 16 * et + (lane >> 4) * 4;
            const u32x2 ma = *(const u32x2*)(Z + row * ZC + col), so = *(const u32x2*)(Z + row * ZC + 5 * 1024 + col), gb = *(const u32x2*)(Z + row * ZC + 7 * 1024 + col);
            const f32x4 ng = *(const f32x4*)(p.in[22] + col);
            const float o0 = bflo(ma.x) + bflo(gb.x) * bflo(so.x) * (acc[tt][et][0] - mean) * rstd * ng[0], o1 = bfhi(ma.x) + bfhi(gb.x) * bfhi(so.x) * (acc[tt][et][1] - mean) * rstd * ng[1];
            const float o2 = bflo(ma.y) + bflo(gb.y) * bflo(so.y) * (acc[tt][et][2] - mean) * rstd * ng[2], o3 = bfhi(ma.y) + bfhi(gb.y) * bfhi(so.y) * (acc[tt][et][3] - mean) * rstd * ng[3];
            u32x2 o; o.x = pk2(o0, o1); o.y = pk2(o2, o3); *(u32x2*)(H + row * 1024 + col) = o; } }
    __syncthreads();
}

__device__ void phase_mix3(const Params& p, LAS unsigned char* lds) {
    for (int u = blockIdx.x; u < 1024; u += gridDim.x) { const int th = u & 1, c = (u >> 1) & 15, bh = u >> 5; out_prompt_unit(p, lds, bh >> 2, bh & 3, c, th); }
}

constexpr int NPHASE = 14;
__device__ __forceinline__ void run_phase(int ph, const Params& p, LAS unsigned char* lds) {
    unsigned char* ws = p.ws; const float* ADA = (const float*)(ws + W_ADA); float* X = p.out + O_Y;
    u16* H = (u16*)(ws + W_H); u16* ACT = (u16*)(ws + W_ACT);
    switch (ph) {
        case 0: phase_convert(p, lds); break;
        case 1: { EpiF32B E; E.C = (float*)(ws + W_ADA); E.ldc = ADAC; E.bias = (const float*)(ws + W_BIAS); run_gemm(lds, (const u16*)(ws + W_CS), (const u16*)(ws + W_WBA), 256, ADAC, 1024, E); } break;
        case 2: phase_prep<0>(p); break;
        case 3: { EpiSwiglu E; E.O = ACT; run_gemm(lds, H, (const u16*)(ws + W_WB1), MR, 5632, 1024, E); } break;
        case 4: { EpiResid E; E.xp = p.in[0]; E.xs = p.in[1]; E.X = X; E.gate = ADA + 2 * 1024; E.coef = 0.5f; run_gemm(lds, ACT, (const u16*)(ws + W_WB2), MR, 1024, FF, E); } break;
        case 5: phase_prep<1>(p); break;
        case 6: { EpiZ E; E.O = (u16*)(ws + W_Z); run_gemm(lds, H, (const u16*)(ws + W_WB3), MR, ZC, 1024, E); } break;
        case 7: phase_mix1(p, lds); break;
        case 8: phase_mix2(p, lds); break;
        case 9: phase_mix3(p, lds); break;
        case 10: { EpiResid E; E.xp = X; E.xs = X + (size_t)NPR * 1024; E.X = X; E.gate = ADA + 5 * 1024; E.coef = 1.0f; run_gemm(lds, H, (const u16*)(ws + W_WB4), MR, 1024, 1024, E); } break;
        case 11: phase_prep<2>(p); break;
        case 12: { EpiSwiglu E; E.O = ACT; run_gemm(lds, H, (const u16*)(ws + W_WB5), MR, 5632, 1024, E); } break;
        case 13: { EpiResid E; E.xp = X; E.xs = X + (size_t)NPR * 1024; E.X = X; E.gate = ADA + 8 * 1024; E.coef = 0.5f; run_gemm(lds, ACT, (const u16*)(ws + W_WB6), MR, 1024, FF, E); } break;
        default: phase_prep<3>(p); break;
    }
}

#if FUSED
__global__ void __launch_bounds__(512, 2) mega_kernel(Params p) {
    extern __shared__ __attribute__((aligned(16))) unsigned char shm[];
    cg::grid_group grid = cg::this_grid();
    LAS unsigned char* lds = (LAS unsigned char*)shm;
#pragma unroll 1
    for (int ph = 0; ph <= NPHASE; ++ph) { run_phase(ph, p, lds); if (ph < NPHASE) grid.sync(); }
}
#else
template <int PH> __global__ void __launch_bounds__(512, 2) phase_kernel(Params p) {
    extern __shared__ __attribute__((aligned(16))) unsigned char shm[];
    run_phase(PH, p, (LAS unsigned char*)shm);
}
template <int PH> static void launch_phase(const Params& p, int grid, hipStream_t stream) {
    static bool attr = false;
    if (!attr) { hipFuncSetAttribute((const void*)phase_kernel<PH>, hipFuncAttributeMaxDynamicSharedMemorySize, LDS_BYTES); attr = true; }
    hipLaunchKernelGGL(phase_kernel<PH>, dim3(grid), dim3(512), LDS_BYTES, stream, p);
}
#endif

extern "C" void kernel_launch(void* const* d_in, const int* in_sizes, int n_in, void* d_out, int out_size, void* d_ws, size_t ws_size, hipStream_t stream) {
    static int grid = 0;
    if (grid == 0) {
        if (n_in != 30 || ws_size < W_END) { fprintf(stderr, "kernel_launch: need 30 inputs and %zu workspace bytes; got %d, %zu\n", (size_t)W_END, n_in, ws_size); grid = -1; return; }
        int dev = 0, cus = 0;
        hipGetDevice(&dev); hipDeviceGetAttribute(&cus, hipDeviceAttributeMultiprocessorCount, dev);
#if FUSED
        int per_cu = 0;
        hipFuncSetAttribute((const void*)mega_kernel, hipFuncAttributeMaxDynamicSharedMemorySize, LDS_BYTES);
        hipOccupancyMaxActiveBlocksPerMultiprocessor(&per_cu, (const void*)mega_kernel, 512, LDS_BYTES);
        if (per_cu < 1) { fprintf(stderr, "kernel_launch: occupancy query says %d blocks per CU\n", per_cu); grid = -1; return; }
        grid = cus;
#else
        grid = cus;
#endif
    }
    if (grid < 0) return;
    Params p{};
    for (int i = 0; i < 30; ++i) p.in[i] = (const float*)d_in[i];
    p.out = (float*)d_out; p.ws = (unsigned char*)d_ws;
#if FUSED
    void* args[] = {&p};
    hipError_t e = hipLaunchCooperativeKernel((const void*)mega_kernel, dim3(grid), dim3(512), args, LDS_BYTES, stream);
    if (e != hipSuccess) fprintf(stderr, "cooperative launch failed: %s (grid %d)\n", hipGetErrorString(e), grid);
#else
    launch_phase<0>(p, grid, stream); launch_phase<1>(p, grid, stream); launch_phase<2>(p, grid, stream); launch_phase<3>(p, grid, stream); launch_phase<4>(p, grid, stream);
    launch_phase<5>(p, grid, stream); launch_phase<6>(p, grid, stream); launch_phase<7>(p, grid, stream); launch_phase<8>(p, grid, stream); launch_phase<9>(p, grid, stream);
    launch_phase<10>(p, grid, stream); launch_phase<11>(p, grid, stream); launch_phase<12>(p, grid, stream); launch_phase<13>(p, grid, stream); launch_phase<14>(p, grid, stream);
#endif
}
```

```cpp
#include <hip/hip_runtime.h>
#include <hip/hip_cooperative_groups.h>
#include <cstdio>
namespace cg = cooperative_groups;
#ifndef FUSED
#define FUSED 1
#endif
__device__ __forceinline__ int tid_opaque() { int t = (int)threadIdx.x; asm volatile("" : "+v"(t)); return t; }
namespace pg8 {
#define PG8_LAS __attribute__((address_space(3)))
typedef unsigned short bf16_t;
typedef short bf16x8 __attribute__((ext_vector_type(8)));
typedef float f32x4 __attribute__((ext_vector_type(4)));
typedef unsigned u32x4 __attribute__((ext_vector_type(4)));
constexpr int BM = 256, BK = 64, HALF = 128, HTB = HALF * BK * 2  , STAGE_BYTES = 8 * HTB, NXCD = 8, WGM = 8;

__host__ __device__ __forceinline__ int lds_byte(int r, int c) { const int st = (r >> 4) * 2 + (c >> 5), rr = r & 15, cc = c & 31, ob = rr * 64 + cc * 2; return st * 1024 + (ob ^ (((ob >> 9) & 1) << 5)); }
__host__ __device__ __forceinline__ void stage_rc(int b, int& R, int& C) { const int st = b / 1024, sb = b % 1024, swz = sb ^ (((sb >> 9) & 1) << 5); R = (st >> 1) * 16 + swz / 64; C = (st & 1) * 32 + (swz % 64) / 2; }
__host__ __device__ __forceinline__ int perm32(int rho) { const int n = rho >> 4, i = rho & 15; return 8 * (i >> 2) + 4 * n + (i & 3); }

struct Unit { int pm, pn, k0, nt; };
struct Gemm { const bf16_t* A; const bf16_t* Bt; int M, N, K; };

struct StaticOrder {
    int nM, nN, nwg, G, c, ntf, ppu, pnt, nMt;
    __host__ __device__ void init(int M, int N, int G_, int c_, int ntf_ = 0, int ppu_ = 0, int pnt_ = 0, int nMt_ = 0) { nM = M / BM - (ppu_ > 0 ? nMt_ : 0); nN = N / BM; nwg = nM * nN; G = G_; c = c_; ntf = ntf_; ppu = ppu_; pnt = pnt_; nMt = nMt_; }
    __host__ __device__ void map(int wgid, Unit& u) const {
        { const int q = nwg / NXCD, r = nwg % NXCD, xcd = wgid % NXCD, off = wgid / NXCD; wgid = (xcd < r ? xcd * (q + 1) : r * (q + 1) + (xcd - r) * q) + off; }
        const int nig = WGM * nN, gid = wgid / nig, fm = gid * WGM, gsz = (nM - fm) < WGM ? (nM - fm) : WGM;
        u.pm = fm + ((wgid % nig) % gsz); u.pn = (wgid % nig) / gsz;
    }
    __host__ __device__ bool next(int i, Unit& u) const {
        const long L = (long)i * G + c;
        if (L < nwg) { map((int)L, u); u.k0 = 0; u.nt = ntf; return true; }
        if (ppu == 0) return false;
        const int full = ((nwg + G - 1) / G) * G; if (L < full) return false;
        const int q = (int)(L - full); if (q >= nMt * nN * ppu) return false;
        const int pi = q % ppu, j = q / ppu; u.pm = nM + j % nMt; u.pn = j / nMt; u.k0 = pi * pnt * BK; u.nt = (pi == ppu - 1) ? ntf - pnt * (ppu - 1) : pnt; return true;
    }
    __device__ __forceinline__ void a_ready(const Unit&) const {}
    __device__ __forceinline__ void done(const Unit&) const {}
};
__device__ __forceinline__ unsigned cvt_pk_bf16(float lo, float hi) { unsigned r; asm volatile("v_cvt_pk_bf16_f32 %0, %1, %2" : "=v"(r) : "v"(lo), "v"(hi)); return r; }
template <class Epi, class Sched, bool STAMP = false>
__device__ __forceinline__ void gemm_phase(PG8_LAS unsigned char* lds, const Gemm g, const Sched& S, const Epi& E, unsigned long long* stamps) {
    const int tid = tid_opaque(), wid = __builtin_amdgcn_readfirstlane(tid >> 6), lane = tid & 63, wr = wid >> 2, wc = wid & 3, fr = lane & 15, fq = lane >> 4;
    const int K = g.K;
    int ts_lo = 0, ts_hi = 0, nts = 0; const unsigned long long rt_entry = STAMP ? (unsigned long long)wall_clock64() : 0ull;
#define PG8_STAMP() do { if (STAMP && wid == 0 && nts < 64) { const unsigned long long _c = (unsigned long long)clock64(); \
        ts_lo = (lane == nts) ? (int)(unsigned)_c : ts_lo; ts_hi = (lane == nts) ? (int)(unsigned)(_c >> 32) : ts_hi; ++nts; } } while (0)
    PG8_STAMP();
    unsigned voffA[2], voffB[2];
#pragma unroll
    for (int i = 0; i < 2; ++i) { int R, C; stage_rc(tid * 16 + i * 8192, R, C); const int Rb = Epi::PERM ? ((R & ~31) + perm32(R & 31)) : R;
        voffA[i] = (unsigned)(R * K + C) * 2u; voffB[i] = (unsigned)(Rb * K + C) * 2u; }
    const size_t kstep = (size_t)(BK * 2);
    const size_t hstep = (size_t)HALF * K * 2;
    const size_t tstep = 2 * hstep;
    const unsigned ldsw = (unsigned)wid * 1024u;
    const int aoff = lds_byte(wr * 64 + fr, fq * 8), boff = lds_byte(wc * 32 + fr, fq * 8);
#define PG8_SA(b, h) (((b) * 2 + (h)) * HTB)
#define PG8_SB(b, h) ((4 + (b) * 2 + (h)) * HTB)
#define PG8_STAGE(bufoff, gbase, voff) do { _Pragma("unroll") for (int _i = 0; _i < 2; ++_i) \
        __builtin_amdgcn_global_load_lds((const unsigned*)((const char*)(gbase) + (voff)[_i]), (PG8_LAS unsigned*)(lds + (bufoff) + ldsw + _i * 8192), 16, 0, 0); } while (0)
#define PG8_LDA(dst, b, h) do { _Pragma("unroll") for (int m = 0; m < 4; ++m) _Pragma("unroll") for (int k = 0; k < 2; ++k) dst[m][k] = *(const PG8_LAS bf16x8*)(lds + PG8_SA(b, h) + aoff + m * 2048 + k * 1024); } while (0)
#define PG8_LDB(dst, b, h) do { _Pragma("unroll") for (int n = 0; n < 2; ++n) _Pragma("unroll") for (int k = 0; k < 2; ++k) dst[n][k] = *(const PG8_LAS bf16x8*)(lds + PG8_SB(b, h) + boff + n * 2048 + k * 1024); } while (0)
#define PG8_MMA(ai, bj, At, Bt) do { __builtin_amdgcn_s_setprio(1); _Pragma("unroll") for (int m = 0; m < 4; ++m) _Pragma("unroll") for (int n = 0; n < 2; ++n) _Pragma("unroll") for (int k = 0; k < 2; ++k) \
        acc[ai][bj][m][n] = __builtin_amdgcn_mfma_f32_16x16x32_bf16(Bt[n][k], At[m][k], acc[ai][bj][m][n], 0, 0, 0); __builtin_amdgcn_s_setprio(0); } while (0)
#define PG8_WAIT_V(n) asm volatile("s_waitcnt vmcnt(" #n ")" ::: "memory")
#define PG8_WAIT_L(n) asm volatile("s_waitcnt lgkmcnt(" #n ")" ::: "memory")
#define PG8_BAR __builtin_amdgcn_s_barrier()
#define PG8_SCHED __builtin_amdgcn_sched_barrier(0)
    Unit cur, nxt; int ui = 0;
    if (!S.next(0, cur)) return;
    f32x4 acc[2][2][4][2];
#pragma unroll
    for (int a = 0; a < 2; ++a)
#pragma unroll
        for (int b = 0; b < 2; ++b)
#pragma unroll
            for (int m = 0; m < 4; ++m)
#pragma unroll
                for (int n = 0; n < 2; ++n) acc[a][b][m][n] = (f32x4){0.f, 0.f, 0.f, 0.f};
    bf16x8 At[4][2], B0[2][2], B1[2][2];
    const char* cA = (const char*)g.A + (size_t)cur.pm * tstep + (size_t)cur.k0 * 2; const char* cB = (const char*)g.Bt + (size_t)cur.pn * tstep + (size_t)cur.k0 * 2;
    S.a_ready(cur);
    PG8_STAGE(PG8_SB(0, 0), cB, voffB); PG8_STAGE(PG8_SA(0, 0), cA, voffA); PG8_STAGE(PG8_SB(0, 1), cB + hstep, voffB); PG8_STAGE(PG8_SA(0, 1), cA + hstep, voffA);
    if (wr == 1) PG8_BAR;
    PG8_WAIT_V(4); PG8_BAR;
    PG8_STAGE(PG8_SB(1, 0), cB + kstep, voffB); PG8_STAGE(PG8_SA(1, 0), cA + kstep, voffA); PG8_STAGE(PG8_SB(1, 1), cB + hstep + kstep, voffB);
    PG8_WAIT_V(6); PG8_BAR;
    PG8_STAMP();
    for (;;) {
        const bool has_next = S.next(ui + 1, nxt);
        const char* nA = has_next ? (const char*)g.A + (size_t)nxt.pm * tstep + (size_t)nxt.k0 * 2 : cA; const char* nB = has_next ? (const char*)g.Bt + (size_t)nxt.pn * tstep + (size_t)nxt.k0 * 2 : cB;
        const int nt = cur.nt;
        for (int t = 0; t < nt; t += 2) {
            const bool last = (t == nt - 2);
            const char* a1 = cA + (size_t)(t + 1) * kstep;
            const char* a2 = last ? nA : cA + (size_t)(t + 2) * kstep; const char* b2 = last ? nB : cB + (size_t)(t + 2) * kstep;
            const char* a3 = a2 + kstep; const char* b3 = b2 + kstep;
            if (last && has_next) S.a_ready(nxt);
            PG8_LDB(B0, 0, 0); PG8_SCHED; PG8_LDA(At, 0, 0); PG8_STAGE(PG8_SA(1, 1), a1 + hstep, voffA);
            PG8_WAIT_L(8); PG8_BAR; PG8_WAIT_L(0); PG8_MMA(0, 0, At, B0); PG8_BAR; PG8_SCHED;
            PG8_LDB(B1, 0, 1); PG8_STAGE(PG8_SB(0, 0), b2, voffB);
            PG8_BAR; PG8_WAIT_L(0); PG8_MMA(0, 1, At, B1); PG8_BAR;
            PG8_LDA(At, 0, 1); PG8_STAGE(PG8_SA(0, 0), a2, voffA);
            PG8_BAR; PG8_WAIT_L(0); PG8_MMA(1, 0, At, B0); PG8_BAR; PG8_SCHED;
            PG8_STAGE(PG8_SB(0, 1), b2 + hstep, voffB);
            PG8_WAIT_V(6); PG8_BAR; PG8_MMA(1, 1, At, B1); PG8_BAR;
            PG8_LDB(B0, 1, 0); PG8_SCHED; PG8_LDA(At, 1, 0); PG8_STAGE(PG8_SA(0, 1), a2 + hstep, voffA);
            PG8_WAIT_L(8); PG8_BAR; PG8_WAIT_L(0); PG8_MMA(0, 0, At, B0); PG8_BAR; PG8_SCHED;
            PG8_LDB(B1, 1, 1); PG8_STAGE(PG8_SB(1, 0), b3, voffB);
            PG8_BAR; PG8_WAIT_L(0); PG8_MMA(0, 1, At, B1); PG8_BAR;
            PG8_LDA(At, 1, 1); PG8_STAGE(PG8_SA(1, 0), a3, voffA);
            PG8_BAR; PG8_WAIT_L(0); PG8_MMA(1, 0, At, B0); PG8_BAR; PG8_SCHED;
            PG8_STAGE(PG8_SB(1, 1), b3 + hstep, voffB);
            PG8_WAIT_V(6); PG8_BAR; PG8_MMA(1, 1, At, B1); PG8_BAR;
        }
        PG8_STAMP();
        if constexpr (!Epi::AFTER_DRAIN) { E(acc, cur, wr, wc, fr, fq); S.done(cur); }
        PG8_STAMP();
        if (!has_next) break;
#pragma unroll
        for (int a = 0; a < 2; ++a)
#pragma unroll
            for (int b = 0; b < 2; ++b)
#pragma unroll
                for (int m = 0; m < 4; ++m)
#pragma unroll
                    for (int n = 0; n < 2; ++n) acc[a][b][m][n] = (f32x4){0.f, 0.f, 0.f, 0.f};
        cur = nxt; cA = nA; cB = nB; ++ui;
    }
    PG8_WAIT_V(0);
    if (wr == 0) PG8_BAR;
    PG8_BAR;
    if constexpr (Epi::AFTER_DRAIN) { E.fused(acc, cur, wr, wc, fr, fq, lds, wid, lane); S.done(cur); }
    PG8_STAMP();
    if (STAMP && wid == 0) { stamps[lane] = lane < nts ? (((unsigned long long)(unsigned)ts_hi << 32) | (unsigned)ts_lo) : 0ull;
        if (lane == 62) stamps[62] = rt_entry; if (lane == 63) stamps[63] = (unsigned long long)wall_clock64(); }
#undef PG8_STAMP
#undef PG8_SA
#undef PG8_SB
#undef PG8_STAGE
#undef PG8_LDA
#undef PG8_LDB
#undef PG8_MMA
#undef PG8_WAIT_V
#undef PG8_WAIT_L
#undef PG8_BAR
#undef PG8_SCHED
}
}

#define LAS __attribute__((address_space(3)))
typedef unsigned short u16;
typedef short bf16x8 __attribute__((ext_vector_type(8)));
typedef short s16x4 __attribute__((ext_vector_type(4)));
typedef float f32x4 __attribute__((ext_vector_type(4)));
typedef unsigned u32x4 __attribute__((ext_vector_type(4)));
typedef unsigned u32x2 __attribute__((ext_vector_type(2)));

constexpr int DM = 1024, NPR = 16384, NSR = 1024, MR = NPR + NSR, FF = 2816, ZC = 8192, ADAC = 11264;
constexpr int LDS_BYTES = 151552;
constexpr size_t W_WB1 = 0;
constexpr size_t W_WB2 = W_WB1 + (size_t)5632 * 1024 * 2;
constexpr size_t W_WB3 = W_WB2 + (size_t)1024 * 2816 * 2;
constexpr size_t W_WB4 = W_WB3 + (size_t)8192 * 1024 * 2;
constexpr size_t W_WB5 = W_WB4 + (size_t)1024 * 1024 * 2;
constexpr size_t W_WB6 = W_WB5 + (size_t)5632 * 1024 * 2;
constexpr size_t W_CS = W_WB6 + (size_t)1024 * 2816 * 2;
constexpr size_t W_BIAS = W_CS + (size_t)256 * 1024 * 2;
constexpr size_t W_WG = W_BIAS + (size_t)ADAC * 4;
constexpr size_t W_ADA = W_WG + (size_t)8 * 1024 * 4;
constexpr size_t W_H = W_ADA + (size_t)256 * ADAC * 4;
constexpr size_t W_GATES = W_H + (size_t)MR * 1024 * 2;
constexpr size_t W_BS = W_GATES + (size_t)MR * 8 * 4;
constexpr size_t W_AS = W_BS + (size_t)32 * 2048 * 4;
constexpr size_t W_CM = W_AS + (size_t)32 * 2048 * 4;
constexpr size_t W_MINIT = W_CM + (size_t)32 * 2048 * 4;
constexpr size_t W_NINIT = W_MINIT + 4096;
constexpr size_t W_Z = W_NINIT + (size_t)32 * 16 * 256 * 4;
constexpr size_t W_ACT = W_Z;
constexpr size_t W_SLAB = W_Z + (size_t)200 * 1024 * 1024;
constexpr size_t W_X3 = W_Z + (size_t)164 * 1024 * 1024;
constexpr size_t W_X2 = W_Z + (size_t)128 * 1024 * 1024;
constexpr size_t W_QB = W_Z + (size_t)MR * ZC * 2;
constexpr size_t W_KB = W_QB + (size_t)MR * 1024 * 2;
constexpr size_t W_CT = W_KB + (size_t)MR * 1024 * 2;
constexpr size_t W_WBA = W_CT;
constexpr size_t W_BAR = W_CT + (size_t)32 * 16 * 65536 * 2;
constexpr size_t W_VST = W_BAR + 16384;
constexpr size_t W_XS = W_VST + (size_t)MR * 32 * 4;
constexpr size_t W_END = W_XS + (size_t)NSR * 1024 * 4;
constexpr size_t O_Y = 0;
constexpr size_t O_CP = (size_t)MR * 1024;
constexpr size_t O_NP = O_CP + (size_t)8 * 4 * 65536;
constexpr size_t O_MP = O_NP + 8 * 4 * 256;
constexpr size_t O_CVP = O_MP + 32;
constexpr size_t O_CS = O_CVP + 8 * 3 * 2048;
constexpr size_t O_NS = O_CS + (size_t)128 * 4 * 65536;
constexpr size_t O_MS = O_NS + 128 * 4 * 256;
constexpr size_t O_CVS = O_MS + 512;
constexpr size_t O_VS = O_CVS + 128 * 3 * 2048;

struct Params { const float* in[30]; float* out; unsigned char* ws; };

__device__ __forceinline__ float bf2f(u16 b) { return __uint_as_float(((unsigned)b) << 16); }
__device__ __forceinline__ float bflo(unsigned w) { return __uint_as_float(w << 16); }
__device__ __forceinline__ float bfhi(unsigned w) { return __uint_as_float(w & 0xffff0000u); }
__device__ __forceinline__ unsigned pk2(float lo, float hi) { return pg8::cvt_pk_bf16(lo, hi); }
__device__ __forceinline__ float sigm(float x) { return __builtin_amdgcn_rcpf(1.0f + __builtin_amdgcn_exp2f(-1.4426950408889634f * x)); }
__device__ __forceinline__ float gelu_t(float x) { return x * sigm(1.5957691216057308f * (x + 0.044715f * x * x * x)); }
__device__ __forceinline__ size_t zo(size_t row, int col) { return ((size_t)(col >> 8) * MR + row) * 256 + (col & 255); }
__device__ __forceinline__ size_t qo(size_t row, int col) { return ((size_t)(col >> 8) * MR + row) * 256 + (col & 255); }
__device__ __forceinline__ int bidx(int row) { return row < NPR ? (row >> 11) : 8 + ((row - NPR) >> 3); }
__device__ __forceinline__ float wsum(float v) {
#pragma unroll
    for (int o = 32; o > 0; o >>= 1) v += __shfl_xor(v, o);
    return v;
}
__device__ __forceinline__ void unpack8(const u32x4 v, float* f) { f[0] = bflo(v.x); f[1] = bfhi(v.x); f[2] = bflo(v.y); f[3] = bfhi(v.y); f[4] = bflo(v.z); f[5] = bfhi(v.z); f[6] = bflo(v.w); f[7] = bfhi(v.w); }
__device__ __forceinline__ u32x4 pack8(const float* f) { u32x4 r; r.x = pk2(f[0], f[1]); r.y = pk2(f[2], f[3]); r.z = pk2(f[4], f[5]); r.w = pk2(f[6], f[7]); return r; }

__device__ __forceinline__ void lds_barrier() { asm volatile("s_waitcnt lgkmcnt(0)\n\ts_barrier" ::: "memory"); }
__device__ __forceinline__ bf16x8 frag_rm(LAS const u16* base, int stride, int r0, int k0, int lane) {
    return *(LAS const bf16x8*)(base + (r0 + (lane & 15)) * stride + k0 + (lane >> 4) * 8);
}
__device__ __forceinline__ bf16x8 frag_tr(LAS const u16* base, int stride, int n0, int k0, int lane) {
    const int g = lane >> 4, li = lane & 15, q = li >> 2, pp = li & 3;
    LAS const u16* a = base + (k0 + g * 8 + q) * stride + n0 + 4 * pp;
    const s16x4 lo = __builtin_amdgcn_ds_read_tr16_b64_v4i16((LAS s16x4*)a);
    const s16x4 hi = __builtin_amdgcn_ds_read_tr16_b64_v4i16((LAS s16x4*)(a + 4 * stride));
    return (bf16x8){lo[0], lo[1], lo[2], lo[3], hi[0], hi[1], hi[2], hi[3]};
}
#define MMA_T(acc, Bf, Af) acc = __builtin_amdgcn_mfma_f32_16x16x32_bf16(Bf, Af, acc, 0, 0, 0)

struct EpiF32B {
    static constexpr bool PERM = false, AFTER_DRAIN = false;
    float* C; int ldc; const float* bias;
    __device__ __forceinline__ void operator()(const f32x4 (&acc)[2][2][4][2], const pg8::Unit& u, int wr, int wc, int fr, int fq) const {
        const int row0 = u.pm * 256 + wr * 64 + fr, col0 = u.pn * 256 + wc * 32 + 4 * fq;
#pragma unroll
        for (int ai = 0; ai < 2; ++ai)
#pragma unroll
            for (int m = 0; m < 4; ++m) { float* rowp = C + (size_t)(row0 + ai * 128 + m * 16) * ldc + col0;
#pragma unroll
                for (int bj = 0; bj < 2; ++bj)
#pragma unroll
                    for (int n = 0; n < 2; ++n) *(f32x4*)(rowp + bj * 128 + n * 16) = acc[ai][bj][m][n] + *(const f32x4*)(bias + col0 + bj * 128 + n * 16); }
    }
};
struct EpiSwiglu {
    static constexpr bool PERM = true, AFTER_DRAIN = false;
    u16* O;
    __device__ __forceinline__ void operator()(const f32x4 (&acc)[2][2][4][2], const pg8::Unit& u, int wr, int wc, int fr, int fq) const {
        const int row0 = u.pm * 256 + wr * 64 + fr, col0 = u.pn * 128 + wc * 32 + 8 * fq;
#pragma unroll
        for (int ai = 0; ai < 2; ++ai)
#pragma unroll
            for (int m = 0; m < 4; ++m) { u16* rowp = O + (size_t)(row0 + ai * 128 + m * 16) * FF + col0;
                float o[8];
#pragma unroll
                for (int n = 0; n < 2; ++n)
#pragma unroll
                    for (int j = 0; j < 4; ++j) { const float a = acc[ai][0][m][n][j], b = acc[ai][1][m][n][j]; o[n * 4 + j] = a * sigm(a) * b; }
                *(u32x4*)rowp = pack8(o); }
    }
};
struct EpiZ {
    static constexpr bool PERM = true, AFTER_DRAIN = false;
    u16* O; float* vst;
    template <bool GELU> __device__ __forceinline__ void body(const f32x4 (&acc)[2][2][4][2], const pg8::Unit& u, int wr, int wc, int fr, int fq) const {
        const int row0 = u.pm * 256 + wr * 64 + fr, col0 = u.pn * 256 + wc * 32 + 8 * fq;
#pragma unroll
        for (int ai = 0; ai < 2; ++ai)
#pragma unroll
            for (int m = 0; m < 4; ++m) { u16* rowp = O + zo((size_t)(row0 + ai * 128 + m * 16), col0); float s1 = 0.f, s2 = 0.f;
#pragma unroll
                for (int bj = 0; bj < 2; ++bj) { float o[8];
#pragma unroll
                    for (int n = 0; n < 2; ++n)
#pragma unroll
                        for (int j = 0; j < 4; ++j) { const float v = acc[ai][bj][m][n][j]; o[n * 4 + j] = GELU ? gelu_t(v) : v; if (GELU) { s1 += o[n * 4 + j]; s2 += o[n * 4 + j] * o[n * 4 + j]; } }
                    *(u32x4*)(rowp + bj * 128) = pack8(o); }
                if (GELU) { s1 += __shfl_xor(s1, 16); s1 += __shfl_xor(s1, 32); s2 += __shfl_xor(s2, 16); s2 += __shfl_xor(s2, 32);
                    if (fq == 0) { float* q = vst + ((size_t)(row0 + ai * 128 + m * 16) * 16 + (u.pn & 3) * 4 + wc) * 2; q[0] = s1; q[1] = s2; } } }
    }
    __device__ __forceinline__ void operator()(const f32x4 (&acc)[2][2][4][2], const pg8::Unit& u, int wr, int wc, int fr, int fq) const {
        if ((u.pn >> 2) == 1) body<true>(acc, u, wr, wc, fr, fq); else body<false>(acc, u, wr, wc, fr, fq);
    }
};
template <bool XF32> struct EpiResid {
    static constexpr bool PERM = true, AFTER_DRAIN = false;
    const float* __restrict__ XinF; const u16* __restrict__ XinB; u16* __restrict__ Xout; float* __restrict__ XoutT; const float* __restrict__ gate; float coef; int ntf, pk;
    __device__ __forceinline__ void operator()(const f32x4 (&acc)[2][2][4][2], const pg8::Unit& u, int wr, int wc, int fr, int fq) const {
        const int row0 = u.pm * 256 + wr * 64 + fr, col0 = u.pn * 256 + wc * 32 + 8 * fq;
        if (u.nt == ntf) {
#pragma unroll
            for (int ai = 0; ai < 2; ++ai)
#pragma unroll
                for (int m = 0; m < 4; ++m) { const int row = row0 + ai * 128 + m * 16; const float* gp = gate + (size_t)bidx(row) * ADAC + col0;
#pragma unroll
                    for (int bj = 0; bj < 2; ++bj) { const int o = bj * 128; float x[8];
                        if (XF32) { const f32x4 a = *(const f32x4*)(XinF + (size_t)row * 1024 + col0 + o), b = *(const f32x4*)(XinF + (size_t)row * 1024 + col0 + o + 4);
#pragma unroll
                            for (int j = 0; j < 4; ++j) { x[j] = a[j]; x[4 + j] = b[j]; } }
                        else unpack8(*(const u32x4*)(XinB + (size_t)row * 1024 + col0 + o), x);
                        const f32x4 g0 = *(const f32x4*)(gp + o), g1 = *(const f32x4*)(gp + o + 4);
#pragma unroll
                        for (int j = 0; j < 4; ++j) { x[j] += coef * g0[j] * acc[ai][bj][m][0][j]; x[4 + j] += coef * g1[j] * acc[ai][bj][m][1][j]; }
                        *(u32x4*)(Xout + (size_t)row * 1024 + col0 + o) = pack8(x); } }
        } else {
            float* sl = XoutT + (size_t)(u.k0 / pk) * ((size_t)NSR * 1024);
#pragma unroll
            for (int ai = 0; ai < 2; ++ai)
#pragma unroll
                for (int m = 0; m < 4; ++m) { const int row = row0 + ai * 128 + m * 16;
                    const float* gp = gate + (size_t)bidx(row) * ADAC + col0; float* op = sl + (size_t)(row - NPR) * 1024 + col0;
#pragma unroll
                    for (int bj = 0; bj < 2; ++bj) { const int o = bj * 128;
                        *(f32x4*)(op + o) = coef * (*(const f32x4*)(gp + o)) * acc[ai][bj][m][0]; *(f32x4*)(op + o + 4) = coef * (*(const f32x4*)(gp + o + 4)) * acc[ai][bj][m][1]; } }
        }
    }
};
template <class Epi> __device__ __forceinline__ void run_gemm(LAS unsigned char* lds, const u16* A, const u16* Bt, int M, int N, int K, const Epi& E, int ppu = 0, int pnt = 0, int nMt = 0) {
    pg8::Gemm g; g.A = A; g.Bt = Bt; g.M = M; g.N = N; g.K = K;
    pg8::StaticOrder S; S.init(M, N, (int)gridDim.x, (int)blockIdx.x, K / 64, ppu, pnt, nMt);
    pg8::gemm_phase<Epi, pg8::StaticOrder, false>(lds, g, S, E, nullptr);
}

__device__ __forceinline__ void phase_convert(const Params& p, LAS unsigned char* lds, int t_begin, int t_end, int first_wg, int n_wg, bool extras) {
    const int tid = tid_opaque();
    LAS u16* T = (LAS u16*)lds;
    constexpr int NJ = 8;
    const int jn[NJ] = {5632, 1024, 8192, 1024, 5632, 1024, 9216, 2048};
    const int jk[NJ] = {1024, 2816, 1024, 1024, 1024, 2816, 1024, 1024};
    int total = 0;
#pragma unroll
    for (int j = 0; j < NJ; ++j) total += (jn[j] / 256) * (jk[j] / 64);
    (void)total;
    const int c4 = (tid & 63) * 4, kr = tid >> 6;
    const bool active = (int)blockIdx.x >= first_wg && (int)blockIdx.x < first_wg + n_wg;
    f32x4 v[8]; u16* dst = nullptr; int K = 0, n0 = 0, k0 = 0;
    auto issue = [&](int t) {
        int lt = t, job = 0;
#pragma unroll
        for (int j = 0; j < NJ - 1; ++j) { const int c = (jn[j] / 256) * (jk[j] / 64); if (job == j && lt >= c) { lt -= c; job = j + 1; } }
        const float* src; int ld, mode;
        switch (job) {
            case 0: src = p.in[11]; ld = 5632; K = 1024; mode = 1; dst = (u16*)(p.ws + W_WB1); break;
            case 1: src = p.in[12]; ld = 1024; K = 2816; mode = 0; dst = (u16*)(p.ws + W_WB2); break;
            case 2: src = p.in[14]; ld = 8200; K = 1024; mode = 2; dst = (u16*)(p.ws + W_WB3); break;
            case 3: src = p.in[23]; ld = 1024; K = 1024; mode = 0; dst = (u16*)(p.ws + W_WB4); break;
            case 4: src = p.in[25]; ld = 5632; K = 1024; mode = 1; dst = (u16*)(p.ws + W_WB5); break;
            case 5: src = p.in[26]; ld = 1024; K = 2816; mode = 0; dst = (u16*)(p.ws + W_WB6); break;
            case 6: src = p.in[8]; ld = 9216; K = 1024; mode = 0; dst = (u16*)(p.ws + W_WBA); break;
            default: src = p.in[27]; ld = 2048; K = 1024; mode = 0; dst = (u16*)(p.ws + W_WBA) + (size_t)9216 * 1024; break;
        }
        const int nk = K / 64, tn = lt / nk, tk = lt - tn * nk; n0 = tn * 256; k0 = tk * 64;
        int sc;
        if (mode == 1) sc = (c4 < 128) ? tn * 128 + c4 : FF + tn * 128 + (c4 - 128);
        else if (mode == 2) sc = (n0 < 6144 ? n0 : n0 + 8) + c4;
        else sc = n0 + c4;
#pragma unroll
        for (int i = 0; i < 4; ++i) { const float* r = src + (size_t)(k0 + 2 * (kr + 8 * i)) * ld + sc; v[2 * i] = *(const f32x4*)r; v[2 * i + 1] = *(const f32x4*)(r + ld); }
    };
    int t = t_begin + ((int)blockIdx.x - first_wg);
    if (active && t < t_end) issue(t);
    for (; active && t < t_end; t += n_wg) {
#pragma unroll
        for (int i = 0; i < 4; ++i) { const int k = 2 * (kr + 8 * i);
#pragma unroll
            for (int j = 0; j < 4; ++j) *(LAS unsigned*)(T + (c4 + j) * 72 + k) = pk2(v[2 * i][j], v[2 * i + 1][j]); }
        u16* cdst = dst; const int cK = K, cn0 = n0, ck0 = k0;
        if (t + n_wg < t_end) issue(t + n_wg);
        lds_barrier();
#pragma unroll
        for (int i = 0; i < 4; ++i) { const int q = tid + 512 * i, n = q >> 3, k8 = (q & 7) * 8;
            *(u32x4*)(cdst + (size_t)(cn0 + n) * cK + ck0 + k8) = *(LAS const u32x4*)(T + n * 72 + k8); }
        lds_barrier();
    }
    if (!extras) return;
    const int gt = blockIdx.x * 512 + tid, gs = gridDim.x * 512;
    u16* CS = (u16*)(p.ws + W_CS);
    for (int i = gt; i < 256 * 1024; i += gs) { const int r = i >> 10, c = i & 1023; float v = 0.f;
        if (r < 8) v = p.in[2][r * 1024 + c]; else if (r < 136) v = p.in[3][(r - 8) * 1024 + c];
        v = v * sigm(v); CS[i] = (u16)(pk2(v, 0.f) & 0xffffu); }
    float* BIAS = (float*)(p.ws + W_BIAS);
    for (int i = gt; i < ADAC; i += gs) BIAS[i] = i < 9216 ? p.in[9][i] : p.in[28][i - 9216];
    float* WG = (float*)(p.ws + W_WG);
    for (int i = gt; i < 8192; i += gs) { const int j = i >> 10, k = i & 1023; WG[i] = p.in[14][(size_t)k * 8200 + 6144 + j]; }
}

template <int WHICH> __device__ __forceinline__ void phase_prep(const Params& p) {
    const int tid = tid_opaque(), lane = tid & 63, wid = tid >> 6;
    const float* ADA = (const float*)(p.ws + W_ADA);
    float* X = p.out + O_Y;
    u16* H = (u16*)(p.ws + W_H);
    const float* gv = WHICH == 0 ? p.in[10] : WHICH == 1 ? p.in[13] : WHICH == 2 ? p.in[24] : p.in[29];
    const int jsh = WHICH == 3 ? 9 : 3 * WHICH, jsc = jsh + 1;
    const float* WG = (const float*)(p.ws + W_WG);
    for (int row = blockIdx.x * 8 + wid; row < MR; row += gridDim.x * 8) {
        const float* ab = ADA + (size_t)bidx(row) * ADAC;
        float* XS = (float*)(p.ws + W_XS);
        f32x4 v[4]; float ss = 0.f;
#pragma unroll
        for (int i = 0; i < 4; ++i) { const int c = i * 256 + lane * 4;
            if (WHICH == 0) v[i] = *(const f32x4*)((row < NPR ? p.in[0] + (size_t)row * 1024 : p.in[1] + (size_t)(row - NPR) * 1024) + c);
            else if (row < NPR) { const u16* xb = WHICH == 1 ? (const u16*)p.out : WHICH == 2 ? (const u16*)(p.ws + W_X2) : (const u16*)(p.ws + W_X3);
                const u32x2 w = *(const u32x2*)(xb + (size_t)row * 1024 + c); v[i] = (f32x4){bflo(w.x), bfhi(w.x), bflo(w.y), bfhi(w.y)}; }
            else {
                v[i] = *(const f32x4*)(XS + (size_t)(row - NPR) * 1024 + c);
                const float* sl = (const float*)(p.ws + W_SLAB) + (size_t)(row - NPR) * 1024 + c;
#pragma unroll
                for (int pi = 0; pi < (WHICH == 2 ? 4 : 5); ++pi) v[i] += *(const f32x4*)(sl + (size_t)pi * NSR * 1024);
                if (WHICH < 3) *(f32x4*)(XS + (size_t)(row - NPR) * 1024 + c) = v[i]; }
            ss += v[i][0] * v[i][0] + v[i][1] * v[i][1] + v[i][2] * v[i][2] + v[i][3] * v[i][3]; }
        ss = wsum(ss);
        const float rstd = rsqrtf(ss * (1.0f / 1024.0f) + 1e-6f);
        float ga[8];
#pragma unroll
        for (int j = 0; j < 8; ++j) ga[j] = 0.f;
#pragma unroll
        for (int i = 0; i < 4; ++i) { const int c = i * 256 + lane * 4;
            const f32x4 g4 = *(const f32x4*)(gv + c), s4 = *(const f32x4*)(ab + jsc * 1024 + c), h4 = *(const f32x4*)(ab + jsh * 1024 + c);
            f32x4 h = v[i] * rstd * g4 * (1.0f + s4) + h4;
            if (WHICH == 0 && row >= NPR) *(f32x4*)((float*)(p.ws + W_XS) + (size_t)(row - NPR) * 1024 + c) = v[i];
            if (WHICH == 3) { *(f32x4*)(X + (size_t)row * 1024 + c) = h; }
            else { u32x2 w; w.x = pk2(h[0], h[1]); w.y = pk2(h[2], h[3]); *(u32x2*)(H + (size_t)row * 1024 + c) = w; }
            if (WHICH == 1) {
#pragma unroll
                for (int j = 0; j < 8; ++j) { const f32x4 w4 = *(const f32x4*)(WG + j * 1024 + c); ga[j] += h[0] * w4[0] + h[1] * w4[1] + h[2] * w4[2] + h[3] * w4[3]; } }
        }
        if (WHICH == 1) {
            float mine = 0.f;
#pragma unroll
            for (int j = 0; j < 8; ++j) { const float s = wsum(ga[j]); if (lane == j) mine = s; }
            if (lane < 8) ((float*)(p.ws + W_GATES))[(size_t)row * 8 + lane] = mine + p.in[15][lane];
        }
    }
}

__device__ __forceinline__ void gmlp_prompt_unit(const Params& p, LAS unsigned char* lds, int b, int c, int g) {
    const int tid = tid_opaque(), lane = tid & 63, wid = tid >> 6;
    LAS float* mu = (LAS float*)lds; LAS float* rs = mu + 128;
    LAS u16* WL = (LAS u16*)(lds + 1024);
    LAS u16* VL = (LAS u16*)(lds + 1024 + 34816);
    u16* Z = (u16*)(p.ws + W_Z);
    const size_t R0 = (size_t)b * 2048 + c * 128;
    if (tid < 128) { const f32x4* q = (const f32x4*)((const float*)(p.ws + W_VST) + (R0 + tid) * 32); float s = 0.f, ss = 0.f;
#pragma unroll
        for (int i = 0; i < 8; ++i) { const f32x4 v = q[i]; s += v[0] + v[2]; ss += v[1] + v[3]; }
        const float m = s * (1.0f / 1024.0f); const float var = fmaxf(ss * (1.0f / 1024.0f) - m * m, 0.f); mu[tid] = m; rs[tid] = rsqrtf(var + 1e-6f); }
    {   const float* w = p.in[20] + (size_t)g * 16384;
#pragma unroll
        for (int i = 0; i < 8; ++i) { const int q = tid + 512 * i, t = q >> 5, s = (q & 31) * 4; const f32x4 v = *(const f32x4*)(w + t * 128 + s);
            u32x2 o; o.x = pk2(s <= t ? v[0] : 0.f, s + 1 <= t ? v[1] : 0.f); o.y = pk2(s + 2 <= t ? v[2] : 0.f, s + 3 <= t ? v[3] : 0.f);
            *(LAS u32x2*)(WL + t * 136 + s) = o; } }
    lds_barrier();
    {   const int cc = (tid & 31) * 8; float lg[8], lb[8];
#pragma unroll
        for (int j = 0; j < 8; ++j) { lg[j] = p.in[18][g * 256 + cc + j]; lb[j] = p.in[19][g * 256 + cc + j]; }
        u32x4 vv[8];
#pragma unroll
        for (int i = 0; i < 8; ++i) { const int r = (tid + 512 * i) >> 5; vv[i] = *(const u32x4*)(Z + zo(R0 + r, 1024 + g * 256 + cc)); }
#pragma unroll
        for (int i = 0; i < 8; ++i) { const int r = (tid + 512 * i) >> 5; const float m = mu[r], rsd = rs[r]; float f[8]; unpack8(vv[i], f);
#pragma unroll
            for (int j = 0; j < 8; ++j) f[j] = (f[j] - m) * rsd * lg[j] + lb[j];
            *(LAS u32x4*)(VL + r * 264 + cc) = pack8(f); } }
    lds_barrier();
    f32x4 acc[8][2];
#pragma unroll
    for (int i = 0; i < 8; ++i) { acc[i][0] = (f32x4){0.f, 0.f, 0.f, 0.f}; acc[i][1] = (f32x4){0.f, 0.f, 0.f, 0.f}; }
#pragma unroll
    for (int kk = 0; kk < 4; ++kk) {
        const bf16x8 B0 = frag_tr(VL, 264, 32 * wid, 32 * kk, lane), B1 = frag_tr(VL, 264, 32 * wid + 16, 32 * kk, lane);
#pragma unroll
        for (int i = 0; i < 8; ++i) if (32 * kk <= 16 * i + 15) { const bf16x8 A = frag_rm(WL, 136, 16 * i, 32 * kk, lane); MMA_T(acc[i][0], B0, A); MMA_T(acc[i][1], B1, A); }
    }
    const int cc = (tid & 31) * 8;
    u32x4 gu[8], ga[8];
#pragma unroll
    for (int i = 0; i < 8; ++i) { const int r = (tid + 512 * i) >> 5; gu[i] = *(const u32x4*)(Z + zo(R0 + r, g * 256 + cc)); ga[i] = *(const u32x4*)(Z + zo(R0 + r, 6 * 1024 + g * 256 + cc)); }
    lds_barrier();
    const float* bs = p.in[21] + g * 128;
#pragma unroll
    for (int i = 0; i < 8; ++i) { const int t = 16 * i + (lane & 15); const float bsv = bs[t];
#pragma unroll
        for (int nn = 0; nn < 2; ++nn) { const int d = 32 * wid + 16 * nn + (lane >> 4) * 4;
            u32x2 o; o.x = pk2(acc[i][nn][0] + bsv, acc[i][nn][1] + bsv); o.y = pk2(acc[i][nn][2] + bsv, acc[i][nn][3] + bsv); *(LAS u32x2*)(VL + t * 264 + d) = o; } }
    lds_barrier();
#pragma unroll
    for (int i = 0; i < 8; ++i) { const int r = (tid + 512 * i) >> 5; float o[8], u8[8], a8[8]; unpack8(*(LAS const u32x4*)(VL + r * 264 + cc), o); unpack8(gu[i], u8); unpack8(ga[i], a8);
#pragma unroll
        for (int j = 0; j < 8; ++j) o[j] = sigm(a8[j]) * gelu_t(u8[j]) * o[j];
        *(u32x4*)(Z + zo(R0 + r, g * 256 + cc)) = pack8(o); }
    lds_barrier();
}

__device__ __forceinline__ void gmlp_sample_unit(const Params& p, LAS unsigned char* lds, int b) {
    const int tid = tid_opaque(), lane = tid & 63, wid = tid >> 6;
    LAS float* VS = (LAS float*)lds;
    u16* Z = (u16*)(p.ws + W_Z);
    const size_t r0 = (size_t)NPR + b * 8;
    {   const int t = wid; const u16* src = Z + zo(r0 + t, 1024 + lane * 16);
        float f[16]; unpack8(*(const u32x4*)src, f); unpack8(*(const u32x4*)(src + 8), f + 8);
        float s = 0.f, ss = 0.f;
#pragma unroll
        for (int j = 0; j < 16; ++j) { s += f[j]; ss += f[j] * f[j]; }
        s = wsum(s); ss = wsum(ss);
        const float m = s * (1.0f / 1024.0f), rsd = rsqrtf(fmaxf(ss * (1.0f / 1024.0f) - m * m, 0.f) + 1e-6f);
        float* vo = p.out + O_VS + ((size_t)b * 8 + t) * 1024 + lane * 16;
#pragma unroll
        for (int j = 0; j < 16; ++j) { const float v = (f[j] - m) * rsd * p.in[18][lane * 16 + j] + p.in[19][lane * 16 + j]; VS[t * 1024 + lane * 16 + j] = v; vo[j] = v; } }
    lds_barrier();
    {   const int c = tid * 2, g = c >> 8; const float* ws = p.in[20] + (size_t)g * 16384; const float* bs = p.in[21] + g * 128;
#pragma unroll
        for (int t = 0; t < 8; ++t) { float a0 = bs[t], a1 = a0;
#pragma unroll
            for (int s = 0; s <= t; ++s) { const float w = ws[t * 128 + s]; a0 += w * VS[s * 1024 + c]; a1 += w * VS[s * 1024 + c + 1]; }
            const size_t row = r0 + t; const unsigned gu = *(const unsigned*)(Z + zo(row, c)), ga = *(const unsigned*)(Z + zo(row, 6 * 1024 + c));
            *(unsigned*)(Z + zo(row, c)) = pk2(sigm(bflo(ga)) * gelu_t(bflo(gu)) * a0, sigm(bfhi(ga)) * gelu_t(bfhi(gu)) * a1); } }
    lds_barrier();
}

__device__ __forceinline__ void conv_unit(const Params& p, size_t rowbase, int nrows, int histmode, const float* hist, float* outconv) {
    const int tid = tid_opaque(), c4 = tid * 4;
    const u16* Z = (const u16*)(p.ws + W_Z);
    u16* dst = c4 < 1024 ? (u16*)(p.ws + W_QB) : (u16*)(p.ws + W_KB); const int dc = c4 & 1023;
    const float osc = c4 < 1024 ? 1.0f : 0.0625f;
    f32x4 w[4];
#pragma unroll
    for (int j = 0; j < 4; ++j) w[j] = *(const f32x4*)(p.in[16] + j * 2048 + c4);
    const f32x4 cb = *(const f32x4*)(p.in[17] + c4);
    f32x4 x[3];
#pragma unroll
    for (int j = 0; j < 3; ++j) {
        if (histmode == 0) x[j] = (f32x4){0.f, 0.f, 0.f, 0.f};
        else if (histmode == 1) { const u32x2 v = *(const u32x2*)(Z + zo(rowbase - 3 + j, 2048 + c4)); x[j] = (f32x4){bflo(v.x), bfhi(v.x), bflo(v.y), bfhi(v.y)}; }
        else x[j] = *(const f32x4*)(hist + j * 2048 + c4);
    }
#pragma unroll 8
    for (int t = 0; t < nrows; ++t) {
        const u32x2 v = *(const u32x2*)(Z + zo(rowbase + t, 2048 + c4));
        const f32x4 xv = (f32x4){bflo(v.x), bfhi(v.x), bflo(v.y), bfhi(v.y)};
        f32x4 y = cb + w[0] * x[0] + w[1] * x[1] + w[2] * x[2] + w[3] * xv;
        u32x2 o; o.x = pk2(y[0] * sigm(y[0]) * osc, y[1] * sigm(y[1]) * osc); o.y = pk2(y[2] * sigm(y[2]) * osc, y[3] * sigm(y[3]) * osc);
        *(u32x2*)(dst + qo(rowbase + t, dc)) = o;
        if (outconv && t >= nrows - 3) *(f32x4*)(outconv + (size_t)(t - (nrows - 3)) * 2048 + c4) = xv;
        x[0] = x[1]; x[1] = x[2]; x[2] = xv;
    }
}

__device__ __forceinline__ void conv_unit64(const Params& p, size_t rowbase, bool zero_hist, float* outconv) {
    const int tid = tid_opaque(), c8 = (tid & 255) * 8, rh = tid >> 8;
    const u16* Z = (const u16*)(p.ws + W_Z); const int zc = 2048 + c8;
    u16* dst = c8 < 1024 ? (u16*)(p.ws + W_QB) : (u16*)(p.ws + W_KB); const int dc = c8 & 1023;
    const float osc = c8 < 1024 ? 1.0f : 0.0625f;
    float w[4][8], cb[8], x[3][8];
#pragma unroll
    for (int j = 0; j < 4; ++j) { const f32x4 a = *(const f32x4*)(p.in[16] + j * 2048 + c8), b = *(const f32x4*)(p.in[16] + j * 2048 + c8 + 4);
#pragma unroll
        for (int e = 0; e < 4; ++e) { w[j][e] = a[e]; w[j][4 + e] = b[e]; } }
    {   const f32x4 a = *(const f32x4*)(p.in[17] + c8), b = *(const f32x4*)(p.in[17] + c8 + 4);
#pragma unroll
        for (int e = 0; e < 4; ++e) { cb[e] = a[e]; cb[4 + e] = b[e]; } }
    const size_t r0 = rowbase + 32 * rh;
    u32x4 cur[8], nxt[8];
#pragma unroll
    for (int i = 0; i < 8; ++i) cur[i] = *(const u32x4*)(Z + zo(r0 + i, zc));
#pragma unroll
    for (int j = 0; j < 3; ++j) {
        if (zero_hist && rh == 0) {
#pragma unroll
            for (int e = 0; e < 8; ++e) x[j][e] = 0.f; }
        else unpack8(*(const u32x4*)(Z + zo(r0 - 3 + j, zc)), x[j]);
    }
#pragma unroll
    for (int blk = 0; blk < 4; ++blk) {
        if (blk < 3) {
#pragma unroll
            for (int i = 0; i < 8; ++i) nxt[i] = *(const u32x4*)(Z + zo(r0 + 8 * (blk + 1) + i, zc)); }
#pragma unroll
        for (int i = 0; i < 8; ++i) { const int t = 8 * blk + i; float xv[8], o[8]; unpack8(cur[i], xv);
#pragma unroll
            for (int e = 0; e < 8; ++e) { const float y = cb[e] + w[0][e] * x[0][e] + w[1][e] * x[1][e] + w[2][e] * x[2][e] + w[3][e] * xv[e]; o[e] = y * sigm(y) * osc; }
            *(u32x4*)(dst + qo(r0 + t, dc)) = pack8(o);
            if (outconv && rh == 1 && t >= 29) { float* oc = outconv + (size_t)(t - 29) * 2048 + c8; *(f32x4*)oc = (f32x4){xv[0], xv[1], xv[2], xv[3]}; *(f32x4*)(oc + 4) = (f32x4){xv[4], xv[5], xv[6], xv[7]}; }
#pragma unroll
            for (int e = 0; e < 8; ++e) { x[0][e] = x[1][e]; x[1][e] = x[2][e]; x[2][e] = xv[e]; } }
        if (blk < 3) {
#pragma unroll
            for (int i = 0; i < 8; ++i) cur[i] = nxt[i]; }
    }
}

__device__ __forceinline__ void phase_mix1(const Params& p, LAS unsigned char* lds) {
    for (int u = blockIdx.x; u < 1024; u += gridDim.x) {
        if (u < 512) gmlp_prompt_unit(p, lds, u >> 6, (u >> 2) & 15, u & 3);
        else if (u < 768) { const int v = u - 512, b = v >> 5, hc = v & 31; conv_unit64(p, (size_t)b * 2048 + hc * 64, hc == 0, hc == 31 ? p.out + O_CVP + (size_t)b * 6144 : nullptr); }
        else if (u < 896) gmlp_sample_unit(p, lds, u - 768);
        else { const int b = u - 896; conv_unit(p, (size_t)NPR + b * 8, 8, 2, p.in[7] + (size_t)b * 6144, p.out + O_CVS + (size_t)b * 6144); }
    }
}

__device__ __forceinline__ float logsig(float f) { return fminf(f, 0.f) - log1pf(__expf(-fabsf(f))); }

__device__ __forceinline__ void scan_prompt_unit(const Params& p, LAS unsigned char* lds, int b, int h, int slab) {
    const int tid = tid_opaque(), lane = tid & 63, wid = tid >> 6, bh = b * 4 + h;
    LAS float* ASl = (LAS float*)lds;
    LAS float* Mc = ASl + 2048;
    LAS float* mi = Mc + 16;
    LAS float* bL = mi + 16;
    LAS float* amx = bL + 16;
    LAS u16* KL = (LAS u16*)(lds + 16384);
    LAS u16* VWL = (LAS u16*)(lds + 16384 + 67584);
    const float* GATES = (const float*)(p.ws + W_GATES);
    const u16* Z = (const u16*)(p.ws + W_Z); const u16* KB = (const u16*)(p.ws + W_KB);
    u16* CT = (u16*)(p.ws + W_CT);
    const size_t Rb = (size_t)b * 2048;
    u32x4 kreg[8], vreg[2];
    const int vr = tid >> 2, vcc = (tid & 3) * 16;
#pragma unroll
    for (int i = 0; i < 8; ++i) { const int q = tid + 512 * i, r = q >> 5, cc = (q & 31) * 8; kreg[i] = *(const u32x4*)(KB + qo(Rb + r, h * 256 + cc)); }
    vreg[0] = *(const u32x4*)(Z + zo(Rb + vr, 4096 + h * 256 + slab * 64 + vcc)); vreg[1] = *(const u32x4*)(Z + zo(Rb + vr, 4096 + h * 256 + slab * 64 + vcc + 8));
    {   const int p0 = tid * 4; float iv[4], bv[4], av[4], cm[4];
        float run = 0.f;
#pragma unroll
        for (int j = 0; j < 4; ++j) { const float* gp = GATES + (Rb + p0 + j) * 8; iv[j] = gp[h]; run += logsig(gp[4 + h]); bv[j] = run; }
        float sc = run;
#pragma unroll
        for (int d = 1; d < 32; d <<= 1) { const float o = __shfl_up(sc, d, 32); if ((lane & 31) >= d) sc += o; }
        const float off = sc - run;
        float rm = -INFINITY;
#pragma unroll
        for (int j = 0; j < 4; ++j) { bv[j] += off; av[j] = iv[j] - bv[j]; rm = fmaxf(rm, av[j]); cm[j] = rm; }
        float sm = rm;
#pragma unroll
        for (int d = 1; d < 32; d <<= 1) { const float o = __shfl_up(sm, d, 32); if ((lane & 31) >= d) sm = fmaxf(sm, o); }
        float em = __shfl_up(sm, 1, 32); if ((lane & 31) == 0) em = -INFINITY;
#pragma unroll
        for (int j = 0; j < 4; ++j) { cm[j] = fmaxf(cm[j], em); ASl[p0 + j] = av[j]; }
        if (slab == 0) {
            *(f32x4*)((float*)(p.ws + W_BS) + (size_t)bh * 2048 + p0) = (f32x4){bv[0], bv[1], bv[2], bv[3]};
            *(f32x4*)((float*)(p.ws + W_AS) + (size_t)bh * 2048 + p0) = (f32x4){av[0], av[1], av[2], av[3]};
            *(f32x4*)((float*)(p.ws + W_CM) + (size_t)bh * 2048 + p0) = (f32x4){cm[0], cm[1], cm[2], cm[3]}; }
        if ((lane & 31) == 31) { bL[p0 >> 7] = bv[3]; amx[p0 >> 7] = cm[3]; } }
    lds_barrier();
    if (tid == 0) { float m = 0.f;
        for (int c = 0; c < 16; ++c) { mi[c] = m; const float M = fmaxf(m, amx[c]); Mc[c] = M; if (slab == 0) ((float*)(p.ws + W_MINIT))[bh * 16 + c] = m; m = bL[c] + M; }
        if (slab == 0) p.out[O_MP + bh] = m; }
    lds_barrier();
    f32x4 acc[5][2];
#pragma unroll
    for (int i = 0; i < 5; ++i) { acc[i][0] = (f32x4){0.f, 0.f, 0.f, 0.f}; acc[i][1] = (f32x4){0.f, 0.f, 0.f, 0.f}; }
    for (int c = 0; c < 16; ++c) {
        const float M = Mc[c], ap = __expf(mi[c] - M);
        const float w = __expf(ASl[c * 128 + vr] - M);
#pragma unroll
        for (int i = 0; i < 8; ++i) { const int q = tid + 512 * i, r = q >> 5, cc = (q & 31) * 8; *(LAS u32x4*)(KL + r * 264 + cc) = kreg[i]; }
        {   float f[8];
#pragma unroll
            for (int q = 0; q < 2; ++q) { unpack8(vreg[q], f);
#pragma unroll
                for (int j = 0; j < 8; ++j) f[j] *= w;
                *(LAS u32x4*)(VWL + vr * 88 + vcc + 8 * q) = pack8(f); }
            if ((tid & 3) == 0) { u32x4 e; e.x = pk2(w, 0.f); e.y = 0u; e.z = 0u; e.w = 0u; *(LAS u32x4*)(VWL + vr * 88 + 64) = e; e.x = 0u; *(LAS u32x4*)(VWL + vr * 88 + 72) = e; } }
        lds_barrier();
        if (c < 15) { const size_t R1 = Rb + (c + 1) * 128;
#pragma unroll
            for (int i = 0; i < 8; ++i) { const int q = tid + 512 * i, r = q >> 5, cc = (q & 31) * 8; kreg[i] = *(const u32x4*)(KB + qo(R1 + r, h * 256 + cc)); }
            vreg[0] = *(const u32x4*)(Z + zo(R1 + vr, 4096 + h * 256 + slab * 64 + vcc)); vreg[1] = *(const u32x4*)(Z + zo(R1 + vr, 4096 + h * 256 + slab * 64 + vcc + 8)); }
#pragma unroll
        for (int i = 0; i < 5; ++i) { acc[i][0] *= ap; acc[i][1] *= ap; }
#pragma unroll
        for (int kk = 0; kk < 4; ++kk) {
            const bf16x8 B0 = frag_tr(KL, 264, 32 * wid, 32 * kk, lane), B1 = frag_tr(KL, 264, 32 * wid + 16, 32 * kk, lane);
#pragma unroll
            for (int et = 0; et < 4; ++et) { const bf16x8 A = frag_tr(VWL, 88, 16 * et, 32 * kk, lane); MMA_T(acc[et][0], B0, A); MMA_T(acc[et][1], B1, A); }
            if (slab == 0) { const bf16x8 A4 = frag_tr(VWL, 88, 64, 32 * kk, lane); MMA_T(acc[4][0], B0, A4); MMA_T(acc[4][1], B1, A4); }
        }
        if (c < 15) {
#pragma unroll
            for (int et = 0; et < 4; ++et)
#pragma unroll
                for (int dt = 0; dt < 2; ++dt) { const int e = slab * 64 + 16 * et + (lane & 15), d = 32 * wid + 16 * dt + (lane >> 4) * 4;
                    u32x2 o; o.x = pk2(acc[et][dt][0], acc[et][dt][1]); o.y = pk2(acc[et][dt][2], acc[et][dt][3]);
                    *(u32x2*)(CT + (((size_t)bh * 16 + c + 1) * 256 + e) * 256 + d) = o; }
            if (slab == 0 && (lane & 15) == 0) {
#pragma unroll
                for (int dt = 0; dt < 2; ++dt) { const int d = 32 * wid + 16 * dt + (lane >> 4) * 4; *(f32x4*)((float*)(p.ws + W_NINIT) + ((size_t)bh * 16 + c + 1) * 256 + d) = acc[4][dt]; } } }
        lds_barrier();
    }
#pragma unroll
    for (int et = 0; et < 4; ++et)
#pragma unroll
        for (int dt = 0; dt < 2; ++dt) { const int e = slab * 64 + 16 * et + (lane & 15), d = 32 * wid + 16 * dt + (lane >> 4) * 4;
#pragma unroll
            for (int j = 0; j < 4; ++j) p.out[O_CP + ((size_t)bh * 256 + d + j) * 256 + e] = acc[et][dt][j]; }
    if (slab == 0 && (lane & 15) == 0) {
#pragma unroll
        for (int dt = 0; dt < 2; ++dt) { const int d = 32 * wid + 16 * dt + (lane >> 4) * 4; *(f32x4*)(p.out + O_NP + (size_t)bh * 256 + d) = acc[4][dt]; } }
    lds_barrier();
}

__device__ __forceinline__ void sample_unit(const Params& p, LAS unsigned char* lds, int b, int h) {
    const int tid = tid_opaque(), lane = tid & 63, wid = tid >> 6, bh = b * 4 + h;
    LAS float* QF = (LAS float*)lds;
    LAS float* KF = QF + 2048;
    LAS float* KWF = KF + 2048;
    LAS float* VF = KWF + 2048;
    LAS float* NUM = VF + 2048;
    LAS float* SC = NUM + 16384;
    LAS float* QN = SC + 64;
    LAS float* sa = QN + 8;
    LAS float* sM = sa + 8;
    LAS float* swi = sM + 8;
    LAS float* semt = swi + 8;
    LAS float* sw7 = semt + 8;
    LAS float* sden = sw7 + 8;
    LAS float* smisc = sden + 8;
    const float* GATES = (const float*)(p.ws + W_GATES);
    const u16* Z = (const u16*)(p.ws + W_Z); const u16* QB = (const u16*)(p.ws + W_QB); const u16* KB = (const u16*)(p.ws + W_KB);
    const size_t r0 = (size_t)NPR + b * 8;
    const float m0 = p.in[6][bh];
    const int e4 = lane * 4, dg = wid * 32;
    const float* C0 = p.in[4] + (size_t)bh * 65536 + e4; float* Co = p.out + O_CS + (size_t)bh * 65536 + e4;
    f32x4 cpre[4];
#pragma unroll
    for (int u = 0; u < 4; ++u) cpre[u] = __builtin_nontemporal_load((const f32x4*)(C0 + (size_t)(dg + u) * 256));
    if (tid == 0) { float bc = 0.f, cm = -INFINITY; float a[8];
        for (int t = 0; t < 8; ++t) { const float* gp = GATES + (r0 + t) * 8; bc += logsig(gp[4 + h]); a[t] = gp[h] - bc; cm = fmaxf(cm, a[t]); const float M = fmaxf(m0, cm);
            sa[t] = a[t]; sM[t] = M; swi[t] = __expf(m0 - M); semt[t] = __expf(-(bc + M)); if (t == 7) { smisc[0] = __expf(m0 - M); smisc[1] = bc + M; } }
        const float M7 = sM[7];
        for (int s = 0; s < 8; ++s) sw7[s] = __expf(a[s] - M7); }
    {   const int t = tid >> 6, d4 = (tid & 63) * 4;
        const u32x2 q = *(const u32x2*)(QB + qo(r0 + t, h * 256 + d4)), k = *(const u32x2*)(KB + qo(r0 + t, h * 256 + d4)), v = *(const u32x2*)(Z + zo(r0 + t, 4096 + h * 256 + d4));
        QF[(d4 + 0) * 8 + t] = bflo(q.x); QF[(d4 + 1) * 8 + t] = bfhi(q.x); QF[(d4 + 2) * 8 + t] = bflo(q.y); QF[(d4 + 3) * 8 + t] = bfhi(q.y);
        KF[(d4 + 0) * 8 + t] = bflo(k.x); KF[(d4 + 1) * 8 + t] = bfhi(k.x); KF[(d4 + 2) * 8 + t] = bflo(k.y); KF[(d4 + 3) * 8 + t] = bfhi(k.y);
        *(LAS f32x4*)(VF + t * 256 + d4) = (f32x4){bflo(v.x), bfhi(v.x), bflo(v.y), bfhi(v.y)}; }
    lds_barrier();
    {   const int pair = tid >> 3, t = pair >> 3, s = pair & 7, sub = tid & 7; float dot = 0.f, qn = 0.f;
        const float* n0 = p.in[5] + (size_t)bh * 256;
#pragma unroll 8
        for (int i = 0; i < 32; ++i) { const int d = sub * 32 + i; const float q = QF[d * 8 + t]; dot += q * KF[d * 8 + s]; qn += q * n0[d]; }
        dot += __shfl_xor(dot, 1); dot += __shfl_xor(dot, 2); dot += __shfl_xor(dot, 4);
        qn += __shfl_xor(qn, 1); qn += __shfl_xor(qn, 2); qn += __shfl_xor(qn, 4);
        if (sub == 0) { SC[t * 8 + s] = s <= t ? dot * __expf(fminf(sa[s] - sM[t], 0.f)) : 0.f; if (s == 0) QN[t] = qn; }
        const int d = tid >> 1, s4 = (tid & 1) * 4;
#pragma unroll
        for (int j = 0; j < 4; ++j) KWF[d * 8 + s4 + j] = KF[d * 8 + s4 + j] * sw7[s4 + j]; }
    lds_barrier();
    if (tid < 8) { float dn = swi[tid] * QN[tid];
        for (int s = 0; s < 8; ++s) dn += SC[tid * 8 + s];
        sden[tid] = dn; }
    const float ap = smisc[0];
    {   f32x4 vv[8], num[8];
#pragma unroll
        for (int s = 0; s < 8; ++s) { vv[s] = *(LAS const f32x4*)(VF + s * 256 + e4); num[s] = (f32x4){0.f, 0.f, 0.f, 0.f}; }
#pragma unroll 1
        for (int i = 0; i < 32; i += 4) {
            f32x4 cnx[4];
            if (i + 4 < 32) {
#pragma unroll
                for (int u = 0; u < 4; ++u) cnx[u] = __builtin_nontemporal_load((const f32x4*)(C0 + (size_t)(dg + i + 4 + u) * 256)); }
#pragma unroll
            for (int u = 0; u < 4; ++u) { const int d = dg + i + u; const f32x4 c0 = cpre[u];
                const f32x4 q0 = *(LAS const f32x4*)(QF + d * 8), q1 = *(LAS const f32x4*)(QF + d * 8 + 4), k0 = *(LAS const f32x4*)(KWF + d * 8), k1 = *(LAS const f32x4*)(KWF + d * 8 + 4);
                f32x4 cn = ap * c0;
#pragma unroll
                for (int j = 0; j < 4; ++j) { num[j] += q0[j] * c0; num[4 + j] += q1[j] * c0; cn += k0[j] * vv[j] + k1[j] * vv[4 + j]; }
                __builtin_nontemporal_store(cn, (f32x4*)(Co + (size_t)d * 256)); }
            if (i + 4 < 32) {
#pragma unroll
                for (int u = 0; u < 4; ++u) cpre[u] = cnx[u]; }
        }
#pragma unroll
        for (int t = 0; t < 8; ++t) *(LAS f32x4*)(NUM + (wid * 8 + t) * 256 + e4) = num[t];
        if (tid < 256) { const int d = tid; float s = ap * p.in[5][(size_t)bh * 256 + d];
#pragma unroll
            for (int j = 0; j < 8; ++j) s += KWF[d * 8 + j];
            p.out[O_NS + (size_t)bh * 256 + d] = s; }
        if (tid == 0) p.out[O_MS + bh] = smisc[1]; }
    lds_barrier();
    {   const int t = wid; const float wi = swi[t], dn = fmaxf(fabsf(sden[t]), semt[t]);
        f32x4 n = (f32x4){0.f, 0.f, 0.f, 0.f};
#pragma unroll
        for (int g = 0; g < 8; ++g) n += *(LAS const f32x4*)(NUM + (g * 8 + t) * 256 + e4);
        n *= wi;
#pragma unroll
        for (int s = 0; s < 8; ++s) n += SC[t * 8 + s] * (*(LAS const f32x4*)(VF + s * 256 + e4));
        float hv[4]; float s1 = 0.f, s2 = 0.f;
#pragma unroll
        for (int j = 0; j < 4; ++j) { hv[j] = n[j] / dn; s1 += hv[j]; s2 += hv[j] * hv[j]; }
        s1 = wsum(s1); s2 = wsum(s2);
        const float mean = s1 * (1.0f / 256.0f), rstd = rsqrtf(fmaxf(s2 * (1.0f / 256.0f) - mean * mean, 0.f) + 1e-6f);
        const size_t row = r0 + t; const int col = h * 256 + e4;
        const u32x2 ma = *(const u32x2*)(Z + zo(row, col)), so = *(const u32x2*)(Z + zo(row, 5 * 1024 + col)), gb = *(const u32x2*)(Z + zo(row, 7 * 1024 + col));
        const f32x4 ng = *(const f32x4*)(p.in[22] + col);
        const float o0 = bflo(ma.x) + sigm(bflo(gb.x)) * sigm(bflo(so.x)) * (hv[0] - mean) * rstd * ng[0], o1 = bfhi(ma.x) + sigm(bfhi(gb.x)) * sigm(bfhi(so.x)) * (hv[1] - mean) * rstd * ng[1];
        const float o2 = bflo(ma.y) + sigm(bflo(gb.y)) * sigm(bflo(so.y)) * (hv[2] - mean) * rstd * ng[2], o3 = bfhi(ma.y) + sigm(bfhi(gb.y)) * sigm(bfhi(so.y)) * (hv[3] - mean) * rstd * ng[3];
        u32x2 o; o.x = pk2(o0, o1); o.y = pk2(o2, o3); *(u32x2*)((u16*)(p.ws + W_H) + row * 1024 + col) = o; }
    lds_barrier();
}

__device__ __forceinline__ void phase_mix2(const Params& p, LAS unsigned char* lds) {
    const int nscan = (int)gridDim.x / 2;
    if ((int)blockIdx.x < nscan) {
#pragma unroll 1
        for (int u = blockIdx.x; u < 128; u += nscan) { const int x = u & 7, j = u >> 3, bh = x * 4 + (j >> 2);
            scan_prompt_unit(p, lds, bh >> 2, bh & 3, j & 3); }
    }
    unsigned* ctr = (unsigned*)(p.ws + W_BAR) + 3584;
    LAS unsigned* slot = (LAS unsigned*)(lds + LDS_BYTES) + 2;
#pragma unroll 1
    for (;;) {
        if (tid_opaque() == 0) *slot = __hip_atomic_fetch_add(ctr, 1u, __ATOMIC_RELAXED, __HIP_MEMORY_SCOPE_AGENT);
        lds_barrier();
        const unsigned v = *slot;
        lds_barrier();
        if (v >= 512u) break;
        sample_unit(p, lds, (int)(v >> 2), (int)(v & 3));
    }
}

__device__ __forceinline__ void out_prompt_unit(const Params& p, LAS unsigned char* lds, int b, int h, int c) {
    const int tid = tid_opaque(), lane = tid & 63, wid = __builtin_amdgcn_readfirstlane(tid >> 6), bh = b * 4 + h;
    LAS u16* QL = (LAS u16*)lds;
    LAS u16* KVL = (LAS u16*)(lds + 67584);
    LAS float* al = (LAS float*)(lds + 135168);
    LAS float* Ml = al + 128;
    LAS float* wil = Ml + 128;
    LAS float* emtl = wil + 128;
    LAS float* RS = emtl + 128;
    LAS float* DEN = RS + 1024;
    LAS float* QN = DEN + 128;
    LAS float* nin = QN + 128;
    LAS float* LNS = nin + 256;
    const u16* Z = (const u16*)(p.ws + W_Z); const u16* QB = (const u16*)(p.ws + W_QB); const u16* KB = (const u16*)(p.ws + W_KB);
    const u16* CT = (const u16*)(p.ws + W_CT);
    const size_t R0 = (size_t)b * 2048 + c * 128;
    const int sr = tid >> 5, scc = (tid & 31) * 8;
    u32x4 vreg[8];
#pragma unroll
    for (int i = 0; i < 8; ++i) { const int r = sr + 16 * i;
        *(LAS u32x4*)(QL + r * 264 + scc) = *(const u32x4*)(QB + qo(R0 + r, h * 256 + scc));
        *(LAS u32x4*)(KVL + r * 264 + scc) = *(const u32x4*)(KB + qo(R0 + r, h * 256 + scc)); }
#pragma unroll
    for (int i = 0; i < 8; ++i) vreg[i] = *(const u32x4*)(Z + zo(R0 + sr + 16 * i, 4096 + h * 256 + scc));
    if (tid < 128) { const size_t gi = (size_t)bh * 2048 + c * 128 + tid; const float a = ((const float*)(p.ws + W_AS))[gi], cm = ((const float*)(p.ws + W_CM))[gi], bt = ((const float*)(p.ws + W_BS))[gi];
        const float mi = ((const float*)(p.ws + W_MINIT))[bh * 16 + c]; const float M = fmaxf(mi, cm);
        al[tid] = a; Ml[tid] = M; wil[tid] = __expf(mi - M); emtl[tid] = __expf(-(bt + M)); }
    if (tid < 256) nin[tid] = c > 0 ? ((const float*)(p.ws + W_NINIT))[((size_t)bh * 16 + c) * 256 + tid] : 0.f;
    RS[wid * 128 + lane] = 0.f; RS[wid * 128 + 64 + lane] = 0.f;
    lds_barrier();
    u32x2 preg[5];
#pragma unroll
    for (int it = 0; it < 5; ++it) {
        const int idx = wid + 8 * it;
        preg[it] = (u32x2){0u, 0u};
        if (idx < 36) {
            int tt = 0; while (idx >= (tt + 1) * (tt + 2) / 2) ++tt;
            const int st = idx - tt * (tt + 1) / 2;
            f32x4 sacc = (f32x4){0.f, 0.f, 0.f, 0.f};
#pragma unroll
            for (int kk = 0; kk < 8; ++kk) { const bf16x8 B = frag_rm(KVL, 264, 16 * st, 32 * kk, lane), A = frag_rm(QL, 264, 16 * tt, 32 * kk, lane); MMA_T(sacc, B, A); }
            const int t = 16 * tt + (lane & 15), s0 = 16 * st + (lane >> 4) * 4; const float M = Ml[t]; float pv[4]; float ps = 0.f;
#pragma unroll
            for (int j = 0; j < 4; ++j) { const int s = s0 + j; pv[j] = s <= t ? sacc[j] * __expf(fminf(al[s] - M, 0.f)) : 0.f; ps += pv[j]; }
            ps += __shfl_xor(ps, 16); ps += __shfl_xor(ps, 32);
            if (lane < 16) RS[wid * 128 + t] += ps;
            preg[it].x = pk2(pv[0], pv[1]); preg[it].y = pk2(pv[2], pv[3]);
        }
    }
    {   const int t = tid >> 2, sub = tid & 3; float qn = 0.f;
#pragma unroll 8
        for (int i = 0; i < 64; ++i) { const int d = sub * 64 + i; qn += bf2f(QL[t * 264 + d]) * nin[d]; }
        qn += __shfl_xor(qn, 1); qn += __shfl_xor(qn, 2);
        if (sub == 0) QN[t] = qn; }
    f32x4 acc[8][2];
#pragma unroll
    for (int i = 0; i < 8; ++i) { acc[i][0] = (f32x4){0.f, 0.f, 0.f, 0.f}; acc[i][1] = (f32x4){0.f, 0.f, 0.f, 0.f}; }
    if (c > 0) {
        const u16* cb = CT + (((size_t)bh * 16 + c) * 256 + 32 * wid + (lane & 15)) * 256 + (lane >> 4) * 8;
#pragma unroll
        for (int kk = 0; kk < 8; ++kk) { const bf16x8 B0 = *(const bf16x8*)(cb + 32 * kk), B1 = *(const bf16x8*)(cb + 16 * 256 + 32 * kk);
#pragma unroll
            for (int tt = 0; tt < 8; ++tt) { const bf16x8 A = frag_rm(QL, 264, 16 * tt, 32 * kk, lane); MMA_T(acc[tt][0], B0, A); MMA_T(acc[tt][1], B1, A); } }
#pragma unroll
        for (int tt = 0; tt < 8; ++tt) { const float w = wil[16 * tt + (lane & 15)]; acc[tt][0] *= w; acc[tt][1] *= w; }
    }
    lds_barrier();
    LAS u16* PL = QL;
#pragma unroll
    for (int it = 0; it < 5; ++it) {
        const int idx = wid + 8 * it;
        if (idx < 36) {
            int tt = 0; while (idx >= (tt + 1) * (tt + 2) / 2) ++tt;
            const int st = idx - tt * (tt + 1) / 2;
            const int t = 16 * tt + (lane & 15), s0 = 16 * st + (lane >> 4) * 4;
            *(LAS u32x2*)(PL + t * 136 + s0) = preg[it];
            if (st == tt && (tt & 1) == 0) *(LAS u32x2*)(PL + t * 136 + s0 + 16) = (u32x2){0u, 0u};
        }
    }
#pragma unroll
    for (int i = 0; i < 8; ++i) *(LAS u32x4*)(KVL + (sr + 16 * i) * 264 + scc) = vreg[i];
    if (tid < 128) { float dn = wil[tid] * QN[tid];
#pragma unroll
        for (int w = 0; w < 8; ++w) dn += RS[w * 128 + tid];
        DEN[tid] = dn; }
    lds_barrier();
#pragma unroll
    for (int kk = 0; kk < 4; ++kk) { const bf16x8 B0 = frag_tr(KVL, 264, 32 * wid, 32 * kk, lane), B1 = frag_tr(KVL, 264, 32 * wid + 16, 32 * kk, lane);
#pragma unroll
        for (int tt = 2 * kk; tt < 8; ++tt) { const bf16x8 A = frag_rm(PL, 136, 16 * tt, 32 * kk, lane); MMA_T(acc[tt][0], B0, A); MMA_T(acc[tt][1], B1, A); } }
#pragma unroll
    for (int tt = 0; tt < 8; ++tt) { const int tl = 16 * tt + (lane & 15); const float inv = 1.0f / fmaxf(fabsf(DEN[tl]), emtl[tl]); float s1 = 0.f, s2 = 0.f;
#pragma unroll
        for (int et = 0; et < 2; ++et) { acc[tt][et] *= inv;
#pragma unroll
            for (int j = 0; j < 4; ++j) { s1 += acc[tt][et][j]; s2 += acc[tt][et][j] * acc[tt][et][j]; } }
        s1 += __shfl_xor(s1, 16); s1 += __shfl_xor(s1, 32); s2 += __shfl_xor(s2, 16); s2 += __shfl_xor(s2, 32);
        if (lane < 16) { LNS[(wid * 128 + tl) * 2] = s1; LNS[(wid * 128 + tl) * 2 + 1] = s2; } }
    lds_barrier();
#pragma unroll
    for (int tt = 0; tt < 8; ++tt) { const int tl = 16 * tt + (lane & 15); float s1 = 0.f, s2 = 0.f;
#pragma unroll
        for (int w = 0; w < 8; ++w) { s1 += LNS[(w * 128 + tl) * 2]; s2 += LNS[(w * 128 + tl) * 2 + 1]; }
        const float mean = s1 * (1.0f / 256.0f), rstd = rsqrtf(fmaxf(s2 * (1.0f / 256.0f) - mean * mean, 0.f) + 1e-6f);
#pragma unroll
        for (int et = 0; et < 2; ++et) { const int e = 32 * wid + 16 * et + (lane >> 4) * 4;
            u32x2 o; o.x = pk2((acc[tt][et][0] - mean) * rstd, (acc[tt][et][1] - mean) * rstd); o.y = pk2((acc[tt][et][2] - mean) * rstd, (acc[tt][et][3] - mean) * rstd);
            *(LAS u32x2*)(KVL + tl * 264 + e) = o; } }
    lds_barrier();
    {   u16* H = (u16*)(p.ws + W_H); float ng[8];
#pragma unroll
        for (int j = 0; j < 8; ++j) ng[j] = p.in[22][h * 256 + scc + j];
        u32x4 ma[8], so[8], gb[8];
#pragma unroll
        for (int i = 0; i < 8; ++i) { const size_t zr = R0 + sr + 16 * i; ma[i] = *(const u32x4*)(Z + zo(zr, h * 256 + scc)); so[i] = *(const u32x4*)(Z + zo(zr, 5 * 1024 + h * 256 + scc)); gb[i] = *(const u32x4*)(Z + zo(zr, 7 * 1024 + h * 256 + scc)); }
#pragma unroll
        for (int i = 0; i < 8; ++i) { const int r = sr + 16 * i; float hn[8], m8[8], s8[8], g8[8]; unpack8(*(LAS const u32x4*)(KVL + r * 264 + scc), hn); unpack8(ma[i], m8); unpack8(so[i], s8); unpack8(gb[i], g8);
#pragma unroll
            for (int j = 0; j < 8; ++j) hn[j] = m8[j] + sigm(g8[j]) * sigm(s8[j]) * hn[j] * ng[j];
            *(u32x4*)(H + (R0 + r) * 1024 + h * 256 + scc) = pack8(hn); } }
    lds_barrier();
}

__device__ __forceinline__ void phase_mix3(const Params& p, LAS unsigned char* lds) {
#pragma unroll 1
    for (int u = blockIdx.x; u < 512; u += gridDim.x) { const int c = u & 15, bh = u >> 4; out_prompt_unit(p, lds, bh >> 2, bh & 3, c); }
}

#define XB_TMO      128
#define XB_XCNT(j)  (256  + 64 * (j))
#define XB_XSUB(j)  (1280 + 64 * (j))
#define XB_XGEN(j)  (2304 + 64 * (j))
#define XB_TOP      3328
#define XB_TOPGEN   3392
#define XCD_BAR_WORDS 3456
#define XB_SPIN_CAP (1u << 18)
__device__ __forceinline__ unsigned xb_ld(unsigned* p)              { return __hip_atomic_load(p, __ATOMIC_RELAXED, __HIP_MEMORY_SCOPE_AGENT); }
__device__ __forceinline__ unsigned xb_add(unsigned* p, unsigned v) { return __hip_atomic_fetch_add(p, v, __ATOMIC_RELAXED, __HIP_MEMORY_SCOPE_AGENT); }
__device__ __forceinline__ unsigned xb_xcc_id() { return (unsigned)__builtin_amdgcn_s_getreg((3 << 11) | 20) & 0xFu; }
#define XB_SPIN(cond, bar) do { unsigned _sp = 0; while (cond) { __builtin_amdgcn_s_sleep(1); \
    if ((++_sp & 255u) == 0u) { if (xb_ld(&(bar)[XB_TMO])) break; if (_sp > XB_SPIN_CAP) { atomicAdd(&(bar)[XB_TMO], 1u); break; } } } } while (0)
struct XcdBarrier { unsigned* bar; unsigned x; volatile LAS unsigned* st; };
__device__ __forceinline__ XcdBarrier xcd_barrier_post(unsigned* bar, volatile LAS unsigned* st) {
    XcdBarrier b; b.bar = bar; b.x = xb_xcc_id(); b.st = st;
    if (threadIdx.x == 0) (void)xb_add(&bar[XB_XCNT(b.x)], 1u);
    return b;
}
__device__ __forceinline__ void xcd_barrier_complete(unsigned* bar, unsigned x, unsigned& nloc, unsigned& nx) {
    const unsigned G = gridDim.x * gridDim.y * gridDim.z;
    unsigned sum, cnt, mine, sp = 0u;
    for (;;) {
        sum = 0u; cnt = 0u; mine = 0u;
#pragma unroll
        for (unsigned j = 0; j < 16; ++j) { const unsigned c = xb_ld(&bar[XB_XCNT(j)]); sum += c; cnt += (c > 0u) ? 1u : 0u; mine = (j == x) ? c : mine; }
        if (sum == G) break;
        __builtin_amdgcn_s_sleep(1);
        if ((++sp & 255u) == 0u) { if (xb_ld(&bar[XB_TMO])) break; if (sp > XB_SPIN_CAP) { atomicAdd(&bar[XB_TMO], 1u); break; } }
    }
    nloc = mine > 0u ? mine : 1u; nx = cnt > 0u ? cnt : 1u;
}
__device__ __forceinline__ void xcd_barrier(const XcdBarrier& b) {
    asm volatile("s_waitcnt vmcnt(0)" ::: "memory");
    __syncthreads();
    if (threadIdx.x == 0) {
        unsigned* bar = b.bar;
        __builtin_amdgcn_s_waitcnt(0);
        unsigned nloc = b.st[0], nx = b.st[1];
        if (nloc == 0u) { xcd_barrier_complete(bar, b.x, nloc, nx); b.st[0] = nloc; b.st[1] = nx; }
        const unsigned old = xb_add(&bar[XB_XSUB(b.x)], 1u);
        const unsigned gen = old / nloc;
        if (old + 1u == (gen + 1u) * nloc) {
            __builtin_amdgcn_fence(__ATOMIC_RELEASE, "agent");
            asm volatile("s_waitcnt vmcnt(0)" ::: "memory");
            const unsigned og = xb_add(&bar[XB_TOP], 1u);
            const unsigned tg = og / nx;
            if (og + 1u == (tg + 1u) * nx) xb_add(&bar[XB_TOPGEN], 1u);
            else XB_SPIN(xb_ld(&bar[XB_TOPGEN]) == tg, bar);
            __builtin_amdgcn_fence(__ATOMIC_ACQUIRE, "agent");
            xb_add(&bar[XB_XGEN(b.x)], 1u);
            asm volatile("s_waitcnt vmcnt(0)" ::: "memory");
        } else {
            XB_SPIN(xb_ld(&bar[XB_XGEN(b.x)]) == gen, bar);
            __builtin_amdgcn_fence(__ATOMIC_ACQUIRE, "agent");
            asm volatile("s_waitcnt vmcnt(0)" ::: "memory");
        }
    }
    __syncthreads();
}

constexpr int NPHASE = 14;
__device__ __forceinline__ void run_phase(int ph, const Params& p, LAS unsigned char* lds) {
    unsigned char* ws = p.ws; const float* ADA = (const float*)(ws + W_ADA); float* X = p.out + O_Y;
    u16* H = (u16*)(ws + W_H); u16* ACT = (u16*)(ws + W_ACT);
    switch (ph) {
        case 0: phase_convert(p, lds, 1632, 2336, 0, (int)gridDim.x, true); break;
        case 1: { EpiF32B E; E.C = (float*)(ws + W_ADA); E.ldc = ADAC; E.bias = (const float*)(ws + W_BIAS); run_gemm(lds, (const u16*)(ws + W_CS), (const u16*)(ws + W_WBA), 256, ADAC, 1024, E);
                  const int nb = (int)gridDim.x - 44;
                  phase_convert(p, lds, 0, 7 * nb, 44, nb, false); phase_convert(p, lds, 7 * nb, 1632, 0, 44, false); } break;
        case 2: phase_prep<0>(p); break;
        case 3: { EpiSwiglu E; E.O = ACT; run_gemm(lds, H, (const u16*)(ws + W_WB1), MR, 5632, 1024, E); } break;
        case 4: { EpiResid<true> E; E.XinF = p.in[0]; E.XinB = nullptr; E.Xout = (u16*)p.out; E.XoutT = (float*)(ws + W_SLAB); E.gate = ADA + 2 * 1024; E.coef = 0.5f; E.ntf = FF / 64; E.pk = 8 * 64; run_gemm(lds, ACT, (const u16*)(ws + W_WB2), MR, 1024, FF, E, 5, 8, 4); } break;
        case 5: phase_prep<1>(p); break;
        case 6: { EpiZ E; E.O = (u16*)(ws + W_Z); E.vst = (float*)(ws + W_VST); run_gemm(lds, H, (const u16*)(ws + W_WB3), MR, ZC, 1024, E); } break;
        case 7: phase_mix1(p, lds); break;
        case 8: phase_mix2(p, lds); break;
        case 9: phase_mix3(p, lds); break;
        case 10: { EpiResid<false> E; E.XinF = nullptr; E.XinB = (const u16*)p.out; E.Xout = (u16*)(ws + W_X2); E.XoutT = (float*)(ws + W_SLAB); E.gate = ADA + 5 * 1024; E.coef = 1.0f; E.ntf = 16; E.pk = 4 * 64; run_gemm(lds, H, (const u16*)(ws + W_WB4), MR, 1024, 1024, E, 4, 4, 4); } break;
        case 11: phase_prep<2>(p); break;
        case 12: { EpiSwiglu E; E.O = ACT; run_gemm(lds, H, (const u16*)(ws + W_WB5), MR, 5632, 1024, E); } break;
        case 13: { EpiResid<false> E; E.XinF = nullptr; E.XinB = (const u16*)(ws + W_X2); E.Xout = (u16*)(ws + W_X3); E.XoutT = (float*)(ws + W_SLAB); E.gate = ADA + 8 * 1024; E.coef = 0.5f; E.ntf = FF / 64; E.pk = 8 * 64; run_gemm(lds, ACT, (const u16*)(ws + W_WB6), MR, 1024, FF, E, 5, 8, 4); } break;
        default: phase_prep<3>(p); break;
    }
}

#if FUSED
__global__ void __launch_bounds__(512, 2) mega_kernel(Params p) {
    extern __shared__ __attribute__((aligned(16))) unsigned char shm[];
    cg::grid_group grid = cg::this_grid();
    LAS unsigned char* lds = (LAS unsigned char*)shm;
    volatile LAS unsigned* st = (volatile LAS unsigned*)(lds + LDS_BYTES);
    if (threadIdx.x == 0) { st[0] = 0u; st[1] = 0u; st[2] = 0u; st[3] = 0u; }
    __syncthreads();
    const XcdBarrier xb = xcd_barrier_post((unsigned*)(p.ws + W_BAR), st);
    run_phase(0, p, lds); grid.sync();
    run_phase(1, p, lds); xcd_barrier(xb); run_phase(2, p, lds); xcd_barrier(xb); run_phase(3, p, lds); xcd_barrier(xb);
    run_phase(4, p, lds); xcd_barrier(xb); run_phase(5, p, lds); xcd_barrier(xb); run_phase(6, p, lds); xcd_barrier(xb); run_phase(7, p, lds); xcd_barrier(xb);
    run_phase(8, p, lds); xcd_barrier(xb); run_phase(9, p, lds); xcd_barrier(xb); run_phase(10, p, lds); xcd_barrier(xb); run_phase(11, p, lds); xcd_barrier(xb);
    run_phase(12, p, lds); xcd_barrier(xb); run_phase(13, p, lds); xcd_barrier(xb); run_phase(14, p, lds);
}
#else
template <int PH> __global__ void __launch_bounds__(512, 2) phase_kernel(Params p) {
    extern __shared__ __attribute__((aligned(16))) unsigned char shm[];
    run_phase(PH, p, (LAS unsigned char*)shm);
}
template <int PH> static void launch_phase(const Params& p, int grid, hipStream_t stream) {
    static bool attr = false;
    if (!attr) { hipFuncSetAttribute((const void*)phase_kernel<PH>, hipFuncAttributeMaxDynamicSharedMemorySize, LDS_BYTES); attr = true; }
    hipLaunchKernelGGL(phase_kernel<PH>, dim3(grid), dim3(512), LDS_BYTES, stream, p);
}
#endif

extern "C" void kernel_launch(void* const* d_in, const int* in_sizes, int n_in, void* d_out, int out_size, void* d_ws, size_t ws_size, hipStream_t stream) {
    static int grid = 0;
    if (grid == 0) {
        if (n_in != 30 || ws_size < W_END) { fprintf(stderr, "kernel_launch: need 30 inputs and %zu workspace bytes; got %d, %zu\n", (size_t)W_END, n_in, ws_size); grid = -1; return; }
        int dev = 0, cus = 0;
        hipGetDevice(&dev); hipDeviceGetAttribute(&cus, hipDeviceAttributeMultiprocessorCount, dev);
#if FUSED
        int per_cu = 0;
        hipFuncSetAttribute((const void*)mega_kernel, hipFuncAttributeMaxDynamicSharedMemorySize, LDS_BYTES + 16);
        hipOccupancyMaxActiveBlocksPerMultiprocessor(&per_cu, (const void*)mega_kernel, 512, LDS_BYTES + 16);
        if (per_cu < 1) { fprintf(stderr, "kernel_launch: occupancy query says %d blocks per CU\n", per_cu); grid = -1; return; }
        grid = cus;
#else
        grid = cus;
#endif
    }
    if (grid < 0) return;
    Params p{};
    for (int i = 0; i < 30; ++i) p.in[i] = (const float*)d_in[i];
    p.out = (float*)d_out; p.ws = (unsigned char*)d_ws;
#if FUSED
    hipMemsetAsync((unsigned char*)d_ws + W_BAR, 0, 16384, stream);
    void* args[] = {&p};
    hipError_t e = hipLaunchCooperativeKernel((const void*)mega_kernel, dim3(grid), dim3(512), args, LDS_BYTES + 16, stream);
    if (e != hipSuccess) fprintf(stderr, "cooperative launch failed: %s (grid %d)\n", hipGetErrorString(e), grid);
#else
    launch_phase<0>(p, grid, stream); launch_phase<1>(p, grid, stream); launch_phase<2>(p, grid, stream); launch_phase<3>(p, grid, stream); launch_phase<4>(p, grid, stream);
    launch_phase<5>(p, grid, stream); launch_phase<6>(p, grid, stream); launch_phase<7>(p, grid, stream); launch_phase<8>(p, grid, stream); launch_phase<9>(p, grid, stream);
    launch_phase<10>(p, grid, stream); launch_phase<11>(p, grid, stream); launch_phase<12>(p, grid, stream); launch_phase<13>(p, grid, stream); launch_phase<14>(p, grid, stream);
#endif
}
```

```cpp
#include <hip/hip_runtime.h>
#include <hip/hip_cooperative_groups.h>
#include <cstdio>
namespace cg = cooperative_groups;
#ifndef FUSED
#define FUSED 1
#endif
__device__ __forceinline__ int tid_opaque() { int t = (int)threadIdx.x; asm volatile("" : "+v"(t)); return t; }
namespace pg8 {
#define PG8_LAS __attribute__((address_space(3)))
typedef unsigned short bf16_t;
typedef short bf16x8 __attribute__((ext_vector_type(8)));
typedef float f32x4 __attribute__((ext_vector_type(4)));
typedef unsigned u32x4 __attribute__((ext_vector_type(4)));
constexpr int BM = 256, BK = 64, HALF = 128, HTB = HALF * BK * 2  , STAGE_BYTES = 8 * HTB, NXCD = 8, WGM = 8;

__host__ __device__ __forceinline__ int lds_byte(int r, int c) { const int st = (r >> 4) * 2 + (c >> 5), rr = r & 15, cc = c & 31, ob = rr * 64 + cc * 2; return st * 1024 + (ob ^ (((ob >> 9) & 1) << 5)); }
__host__ __device__ __forceinline__ void stage_rc(int b, int& R, int& C) { const int st = b / 1024, sb = b % 1024, swz = sb ^ (((sb >> 9) & 1) << 5); R = (st >> 1) * 16 + swz / 64; C = (st & 1) * 32 + (swz % 64) / 2; }
__host__ __device__ __forceinline__ int perm32(int rho) { const int n = rho >> 4, i = rho & 15; return 8 * (i >> 2) + 4 * n + (i & 3); }

struct Unit { int pm, pn, k0, nt; };
struct Gemm { const bf16_t* A; const bf16_t* Bt; int M, N, K; };

struct StaticOrder {
    int nM, nN, nwg, G, c, ntf, ppu, pnt, nMt;
    __host__ __device__ void init(int M, int N, int G_, int c_, int ntf_ = 0, int ppu_ = 0, int pnt_ = 0, int nMt_ = 0) { nM = M / BM - (ppu_ > 0 ? nMt_ : 0); nN = N / BM; nwg = nM * nN; G = G_; c = c_; ntf = ntf_; ppu = ppu_; pnt = pnt_; nMt = nMt_; }
    __host__ __device__ void map(int wgid, Unit& u) const {
        { const int q = nwg / NXCD, r = nwg % NXCD, xcd = wgid % NXCD, off = wgid / NXCD; wgid = (xcd < r ? xcd * (q + 1) : r * (q + 1) + (xcd - r) * q) + off; }
        const int nig = WGM * nN, gid = wgid / nig, fm = gid * WGM, gsz = (nM - fm) < WGM ? (nM - fm) : WGM;
        u.pm = fm + ((wgid % nig) % gsz); u.pn = (wgid % nig) / gsz;
    }
    __host__ __device__ bool next(int i, Unit& u) const {
        const long L = (long)i * G + c;
        if (L < nwg) { map((int)L, u); u.k0 = 0; u.nt = ntf; return true; }
        if (ppu == 0) return false;
        const int full = ((nwg + G - 1) / G) * G; if (L < full) return false;
        const int q = (int)(L - full); if (q >= nMt * nN * ppu) return false;
        const int pi = q % ppu, j = q / ppu; u.pm = nM + j % nMt; u.pn = j / nMt; u.k0 = pi * pnt * BK; u.nt = (pi == ppu - 1) ? ntf - pnt * (ppu - 1) : pnt; return true;
    }
    __device__ __forceinline__ void a_ready(const Unit&) const {}
    __device__ __forceinline__ void done(const Unit&) const {}
};
__device__ __forceinline__ unsigned cvt_pk_bf16(float lo, float hi) { unsigned r; asm volatile("v_cvt_pk_bf16_f32 %0, %1, %2" : "=v"(r) : "v"(lo), "v"(hi)); return r; }
template <class Epi, class Sched, bool STAMP = false>
__device__ __forceinline__ void gemm_phase(PG8_LAS unsigned char* lds, const Gemm g, const Sched& S, const Epi& E, unsigned long long* stamps) {
    const int tid = tid_opaque(), wid = __builtin_amdgcn_readfirstlane(tid >> 6), lane = tid & 63, wr = wid >> 2, wc = wid & 3, fr = lane & 15, fq = lane >> 4;
    const int K = g.K;
    int ts_lo = 0, ts_hi = 0, nts = 0; const unsigned long long rt_entry = STAMP ? (unsigned long long)wall_clock64() : 0ull;
#define PG8_STAMP() do { if (STAMP && wid == 0 && nts < 64) { const unsigned long long _c = (unsigned long long)clock64(); \
        ts_lo = (lane == nts) ? (int)(unsigned)_c : ts_lo; ts_hi = (lane == nts) ? (int)(unsigned)(_c >> 32) : ts_hi; ++nts; } } while (0)
    PG8_STAMP();
    unsigned voffA[2], voffB[2];
#pragma unroll
    for (int i = 0; i < 2; ++i) { int R, C; stage_rc(tid * 16 + i * 8192, R, C); const int Rb = Epi::PERM ? ((R & ~31) + perm32(R & 31)) : R;
        voffA[i] = (unsigned)(R * K + C) * 2u; voffB[i] = (unsigned)(Rb * K + C) * 2u; }
    const size_t kstep = (size_t)(BK * 2);
    const size_t hstep = (size_t)HALF * K * 2;
    const size_t tstep = 2 * hstep;
    const unsigned ldsw = (unsigned)wid * 1024u;
    const int aoff = lds_byte(wr * 64 + fr, fq * 8), boff = lds_byte(wc * 32 + fr, fq * 8);
#define PG8_SA(b, h) (((b) * 2 + (h)) * HTB)
#define PG8_SB(b, h) ((4 + (b) * 2 + (h)) * HTB)
#define PG8_STAGE(bufoff, gbase, voff) do { _Pragma("unroll") for (int _i = 0; _i < 2; ++_i) \
        __builtin_amdgcn_global_load_lds((const unsigned*)((const char*)(gbase) + (voff)[_i]), (PG8_LAS unsigned*)(lds + (bufoff) + ldsw + _i * 8192), 16, 0, 0); } while (0)
#define PG8_LDA(dst, b, h) do { _Pragma("unroll") for (int m = 0; m < 4; ++m) _Pragma("unroll") for (int k = 0; k < 2; ++k) dst[m][k] = *(const PG8_LAS bf16x8*)(lds + PG8_SA(b, h) + aoff + m * 2048 + k * 1024); } while (0)
#define PG8_LDB(dst, b, h) do { _Pragma("unroll") for (int n = 0; n < 2; ++n) _Pragma("unroll") for (int k = 0; k < 2; ++k) dst[n][k] = *(const PG8_LAS bf16x8*)(lds + PG8_SB(b, h) + boff + n * 2048 + k * 1024); } while (0)
#define PG8_MMA(ai, bj, At, Bt) do { __builtin_amdgcn_s_setprio(1); _Pragma("unroll") for (int m = 0; m < 4; ++m) _Pragma("unroll") for (int n = 0; n < 2; ++n) _Pragma("unroll") for (int k = 0; k < 2; ++k) \
        acc[ai][bj][m][n] = __builtin_amdgcn_mfma_f32_16x16x32_bf16(Bt[n][k], At[m][k], acc[ai][bj][m][n], 0, 0, 0); __builtin_amdgcn_s_setprio(0); } while (0)
#define PG8_WAIT_V(n) asm volatile("s_waitcnt vmcnt(" #n ")" ::: "memory")
#define PG8_WAIT_L(n) asm volatile("s_waitcnt lgkmcnt(" #n ")" ::: "memory")
#define PG8_BAR __builtin_amdgcn_s_barrier()
#define PG8_SCHED __builtin_amdgcn_sched_barrier(0)
    Unit cur, nxt; int ui = 0;
    if (!S.next(0, cur)) return;
    f32x4 acc[2][2][4][2];
#pragma unroll
    for (int a = 0; a < 2; ++a)
#pragma unroll
        for (int b = 0; b < 2; ++b)
#pragma unroll
            for (int m = 0; m < 4; ++m)
#pragma unroll
                for (int n = 0; n < 2; ++n) acc[a][b][m][n] = (f32x4){0.f, 0.f, 0.f, 0.f};
    bf16x8 At[4][2], B0[2][2], B1[2][2];
    const char* cA = (const char*)g.A + (size_t)cur.pm * tstep + (size_t)cur.k0 * 2; const char* cB = (const char*)g.Bt + (size_t)cur.pn * tstep + (size_t)cur.k0 * 2;
    S.a_ready(cur);
    PG8_STAGE(PG8_SB(0, 0), cB, voffB); PG8_STAGE(PG8_SA(0, 0), cA, voffA); PG8_STAGE(PG8_SB(0, 1), cB + hstep, voffB); PG8_STAGE(PG8_SA(0, 1), cA + hstep, voffA);
    if (wr == 1) PG8_BAR;
    PG8_WAIT_V(4); PG8_BAR;
    PG8_STAGE(PG8_SB(1, 0), cB + kstep, voffB); PG8_STAGE(PG8_SA(1, 0), cA + kstep, voffA); PG8_STAGE(PG8_SB(1, 1), cB + hstep + kstep, voffB);
    PG8_WAIT_V(6); PG8_BAR;
    PG8_STAMP();
    for (;;) {
        const bool has_next = S.next(ui + 1, nxt);
        const char* nA = has_next ? (const char*)g.A + (size_t)nxt.pm * tstep + (size_t)nxt.k0 * 2 : cA; const char* nB = has_next ? (const char*)g.Bt + (size_t)nxt.pn * tstep + (size_t)nxt.k0 * 2 : cB;
        const int nt = cur.nt;
        for (int t = 0; t < nt; t += 2) {
            const bool last = (t == nt - 2);
            const char* a1 = cA + (size_t)(t + 1) * kstep;
            const char* a2 = last ? nA : cA + (size_t)(t + 2) * kstep; const char* b2 = last ? nB : cB + (size_t)(t + 2) * kstep;
            const char* a3 = a2 + kstep; const char* b3 = b2 + kstep;
            if (last && has_next) S.a_ready(nxt);
            PG8_LDB(B0, 0, 0); PG8_SCHED; PG8_LDA(At, 0, 0); PG8_STAGE(PG8_SA(1, 1), a1 + hstep, voffA);
            PG8_WAIT_L(8); PG8_BAR; PG8_WAIT_L(0); PG8_MMA(0, 0, At, B0); PG8_BAR; PG8_SCHED;
            PG8_LDB(B1, 0, 1); PG8_STAGE(PG8_SB(0, 0), b2, voffB);
            PG8_BAR; PG8_WAIT_L(0); PG8_MMA(0, 1, At, B1); PG8_BAR;
            PG8_LDA(At, 0, 1); PG8_STAGE(PG8_SA(0, 0), a2, voffA);
            PG8_BAR; PG8_WAIT_L(0); PG8_MMA(1, 0, At, B0); PG8_BAR; PG8_SCHED;
            PG8_STAGE(PG8_SB(0, 1), b2 + hstep, voffB);
            PG8_WAIT_V(6); PG8_BAR; PG8_MMA(1, 1, At, B1); PG8_BAR;
            PG8_LDB(B0, 1, 0); PG8_SCHED; PG8_LDA(At, 1, 0); PG8_STAGE(PG8_SA(0, 1), a2 + hstep, voffA);
            PG8_WAIT_L(8); PG8_BAR; PG8_WAIT_L(0); PG8_MMA(0, 0, At, B0); PG8_BAR; PG8_SCHED;
            PG8_LDB(B1, 1, 1); PG8_STAGE(PG8_SB(1, 0), b3, voffB);
            PG8_BAR; PG8_WAIT_L(0); PG8_MMA(0, 1, At, B1); PG8_BAR;
            PG8_LDA(At, 1, 1); PG8_STAGE(PG8_SA(1, 0), a3, voffA);
            PG8_BAR; PG8_WAIT_L(0); PG8_MMA(1, 0, At, B0); PG8_BAR; PG8_SCHED;
            PG8_STAGE(PG8_SB(1, 1), b3 + hstep, voffB);
            PG8_WAIT_V(6); PG8_BAR; PG8_MMA(1, 1, At, B1); PG8_BAR;
        }
        PG8_STAMP();
        if constexpr (!Epi::AFTER_DRAIN) { E(acc, cur, wr, wc, fr, fq); S.done(cur); }
        PG8_STAMP();
        if (!has_next) break;
#pragma unroll
        for (int a = 0; a < 2; ++a)
#pragma unroll
            for (int b = 0; b < 2; ++b)
#pragma unroll
                for (int m = 0; m < 4; ++m)
#pragma unroll
                    for (int n = 0; n < 2; ++n) acc[a][b][m][n] = (f32x4){0.f, 0.f, 0.f, 0.f};
        cur = nxt; cA = nA; cB = nB; ++ui;
    }
    PG8_WAIT_V(0);
    if (wr == 0) PG8_BAR;
    PG8_BAR;
    if constexpr (Epi::AFTER_DRAIN) { E.fused(acc, cur, wr, wc, fr, fq, lds, wid, lane); S.done(cur); }
    PG8_STAMP();
    if (STAMP && wid == 0) { stamps[lane] = lane < nts ? (((unsigned long long)(unsigned)ts_hi << 32) | (unsigned)ts_lo) : 0ull;
        if (lane == 62) stamps[62] = rt_entry; if (lane == 63) stamps[63] = (unsigned long long)wall_clock64(); }
#undef PG8_STAMP
#undef PG8_SA
#undef PG8_SB
#undef PG8_STAGE
#undef PG8_LDA
#undef PG8_LDB
#undef PG8_MMA
#undef PG8_WAIT_V
#undef PG8_WAIT_L
#undef PG8_BAR
#undef PG8_SCHED
}
}

#define LAS __attribute__((address_space(3)))
typedef unsigned short u16;
typedef short bf16x8 __attribute__((ext_vector_type(8)));
typedef short s16x4 __attribute__((ext_vector_type(4)));
typedef float f32x4 __attribute__((ext_vector_type(4)));
typedef unsigned u32x4 __attribute__((ext_vector_type(4)));
typedef unsigned u32x2 __attribute__((ext_vector_type(2)));

constexpr int DM = 1024, NPR = 16384, NSR = 1024, MR = NPR + NSR, FF = 2816, ZC = 8192, ADAC = 11264;
constexpr int LDS_BYTES = 151552;
constexpr size_t W_WB1 = 0;
constexpr size_t W_WB2 = W_WB1 + (size_t)5632 * 1024 * 2;
constexpr size_t W_WB3 = W_WB2 + (size_t)1024 * 2816 * 2;
constexpr size_t W_WB4 = W_WB3 + (size_t)8192 * 1024 * 2;
constexpr size_t W_WB5 = W_WB4 + (size_t)1024 * 1024 * 2;
constexpr size_t W_WB6 = W_WB5 + (size_t)5632 * 1024 * 2;
constexpr size_t W_CS = W_WB6 + (size_t)1024 * 2816 * 2;
constexpr size_t W_BIAS = W_CS + (size_t)256 * 1024 * 2;
constexpr size_t W_WG = W_BIAS + (size_t)ADAC * 4;
constexpr size_t W_ADA = W_WG + (size_t)8 * 1024 * 4;
constexpr size_t W_H = W_ADA + (size_t)256 * ADAC * 4;
constexpr size_t W_GATES = W_H + (size_t)MR * 1024 * 2;
constexpr size_t W_BS = W_GATES + (size_t)MR * 8 * 4;
constexpr size_t W_AS = W_BS + (size_t)32 * 2048 * 4;
constexpr size_t W_CM = W_AS + (size_t)32 * 2048 * 4;
constexpr size_t W_MINIT = W_CM + (size_t)32 * 2048 * 4;
constexpr size_t W_NINIT = W_MINIT + 4096;
constexpr size_t W_Z = W_NINIT + (size_t)32 * 16 * 256 * 4;
constexpr size_t W_ACT = W_Z;
constexpr size_t W_SLAB = W_Z + (size_t)200 * 1024 * 1024;
constexpr size_t W_X3 = W_Z + (size_t)164 * 1024 * 1024;
constexpr size_t W_X2 = W_Z + (size_t)128 * 1024 * 1024;
constexpr size_t W_QB = W_Z + (size_t)MR * ZC * 2;
constexpr size_t W_KB = W_QB + (size_t)MR * 1024 * 2;
constexpr size_t W_CT = W_KB + (size_t)MR * 1024 * 2;
constexpr size_t W_WBA = W_CT;
constexpr size_t W_BAR = W_CT + (size_t)32 * 16 * 65536 * 2;
constexpr size_t W_VST = W_BAR + 16384;
constexpr size_t W_XS = W_VST + (size_t)MR * 32 * 4;
constexpr size_t W_END = W_XS + (size_t)NSR * 1024 * 4;
constexpr size_t O_Y = 0;
constexpr size_t O_CP = (size_t)MR * 1024;
constexpr size_t O_NP = O_CP + (size_t)8 * 4 * 65536;
constexpr size_t O_MP = O_NP + 8 * 4 * 256;
constexpr size_t O_CVP = O_MP + 32;
constexpr size_t O_CS = O_CVP + 8 * 3 * 2048;
constexpr size_t O_NS = O_CS + (size_t)128 * 4 * 65536;
constexpr size_t O_MS = O_NS + 128 * 4 * 256;
constexpr size_t O_CVS = O_MS + 512;
constexpr size_t O_VS = O_CVS + 128 * 3 * 2048;

struct Params { const float* in[30]; float* out; unsigned char* ws; };

__device__ __forceinline__ float bf2f(u16 b) { return __uint_as_float(((unsigned)b) << 16); }
__device__ __forceinline__ float bflo(unsigned w) { return __uint_as_float(w << 16); }
__device__ __forceinline__ float bfhi(unsigned w) { return __uint_as_float(w & 0xffff0000u); }
__device__ __forceinline__ unsigned pk2(float lo, float hi) { return pg8::cvt_pk_bf16(lo, hi); }
__device__ __forceinline__ float sigm(float x) { return __builtin_amdgcn_rcpf(1.0f + __builtin_amdgcn_exp2f(-1.4426950408889634f * x)); }
__device__ __forceinline__ float gelu_t(float x) { return x * sigm(1.5957691216057308f * (x + 0.044715f * x * x * x)); }
__device__ __forceinline__ size_t zo(size_t row, int col) { return ((size_t)(col >> 8) * MR + row) * 256 + (col & 255); }
__device__ __forceinline__ size_t qo(size_t row, int col) { return ((size_t)(col >> 8) * MR + row) * 256 + (col & 255); }
__device__ __forceinline__ int bidx(int row) { return row < NPR ? (row >> 11) : 8 + ((row - NPR) >> 3); }
__device__ __forceinline__ float wsum(float v) {
#pragma unroll
    for (int o = 32; o > 0; o >>= 1) v += __shfl_xor(v, o);
    return v;
}
__device__ __forceinline__ void unpack8(const u32x4 v, float* f) { f[0] = bflo(v.x); f[1] = bfhi(v.x); f[2] = bflo(v.y); f[3] = bfhi(v.y); f[4] = bflo(v.z); f[5] = bfhi(v.z); f[6] = bflo(v.w); f[7] = bfhi(v.w); }
__device__ __forceinline__ u32x4 pack8(const float* f) { u32x4 r; r.x = pk2(f[0], f[1]); r.y = pk2(f[2], f[3]); r.z = pk2(f[4], f[5]); r.w = pk2(f[6], f[7]); return r; }

__device__ __forceinline__ void lds_barrier() { asm volatile("s_waitcnt lgkmcnt(0)\n\ts_barrier" ::: "memory"); }
__device__ __forceinline__ bf16x8 frag_rm(LAS const u16* base, int stride, int r0, int k0, int lane) {
    return *(LAS const bf16x8*)(base + (r0 + (lane & 15)) * stride + k0 + (lane >> 4) * 8);
}
__device__ __forceinline__ bf16x8 frag_tr(LAS const u16* base, int stride, int n0, int k0, int lane) {
    const int g = lane >> 4, li = lane & 15, q = li >> 2, pp = li & 3;
    LAS const u16* a = base + (k0 + g * 8 + q) * stride + n0 + 4 * pp;
    const s16x4 lo = __builtin_amdgcn_ds_read_tr16_b64_v4i16((LAS s16x4*)a);
    const s16x4 hi = __builtin_amdgcn_ds_read_tr16_b64_v4i16((LAS s16x4*)(a + 4 * stride));
    return (bf16x8){lo[0], lo[1], lo[2], lo[3], hi[0], hi[1], hi[2], hi[3]};
}
#define MMA_T(acc, Bf, Af) acc = __builtin_amdgcn_mfma_f32_16x16x32_bf16(Bf, Af, acc, 0, 0, 0)

struct EpiF32B {
    static constexpr bool PERM = false, AFTER_DRAIN = false;
    float* C; int ldc; const float* bias;
    __device__ __forceinline__ void operator()(const f32x4 (&acc)[2][2][4][2], const pg8::Unit& u, int wr, int wc, int fr, int fq) const {
        const int row0 = u.pm * 256 + wr * 64 + fr, col0 = u.pn * 256 + wc * 32 + 4 * fq;
#pragma unroll
        for (int ai = 0; ai < 2; ++ai)
#pragma unroll
            for (int m = 0; m < 4; ++m) { float* rowp = C + (size_t)(row0 + ai * 128 + m * 16) * ldc + col0;
#pragma unroll
                for (int bj = 0; bj < 2; ++bj)
#pragma unroll
                    for (int n = 0; n < 2; ++n) *(f32x4*)(rowp + bj * 128 + n * 16) = acc[ai][bj][m][n] + *(const f32x4*)(bias + col0 + bj * 128 + n * 16); }
    }
};
struct EpiSwiglu {
    static constexpr bool PERM = true, AFTER_DRAIN = false;
    u16* O;
    __device__ __forceinline__ void operator()(const f32x4 (&acc)[2][2][4][2], const pg8::Unit& u, int wr, int wc, int fr, int fq) const {
        const int row0 = u.pm * 256 + wr * 64 + fr, col0 = u.pn * 128 + wc * 32 + 8 * fq;
#pragma unroll
        for (int ai = 0; ai < 2; ++ai)
#pragma unroll
            for (int m = 0; m < 4; ++m) { u16* rowp = O + (size_t)(row0 + ai * 128 + m * 16) * FF + col0;
                float o[8];
#pragma unroll
                for (int n = 0; n < 2; ++n)
#pragma unroll
                    for (int j = 0; j < 4; ++j) { const float a = acc[ai][0][m][n][j], b = acc[ai][1][m][n][j]; o[n * 4 + j] = a * sigm(a) * b; }
                *(u32x4*)rowp = pack8(o); }
    }
};
struct EpiZ {
    static constexpr bool PERM = true, AFTER_DRAIN = false;
    u16* O; float* vst;
    template <bool GELU> __device__ __forceinline__ void body(const f32x4 (&acc)[2][2][4][2], const pg8::Unit& u, int wr, int wc, int fr, int fq) const {
        const int row0 = u.pm * 256 + wr * 64 + fr, col0 = u.pn * 256 + wc * 32 + 8 * fq;
#pragma unroll
        for (int ai = 0; ai < 2; ++ai)
#pragma unroll
            for (int m = 0; m < 4; ++m) { u16* rowp = O + zo((size_t)(row0 + ai * 128 + m * 16), col0); float s1 = 0.f, s2 = 0.f;
#pragma unroll
                for (int bj = 0; bj < 2; ++bj) { float o[8];
#pragma unroll
                    for (int n = 0; n < 2; ++n)
#pragma unroll
                        for (int j = 0; j < 4; ++j) { const float v = acc[ai][bj][m][n][j]; o[n * 4 + j] = GELU ? gelu_t(v) : v; if (GELU) { s1 += o[n * 4 + j]; s2 += o[n * 4 + j] * o[n * 4 + j]; } }
                    *(u32x4*)(rowp + bj * 128) = pack8(o); }
                if (GELU) { s1 += __shfl_xor(s1, 16); s1 += __shfl_xor(s1, 32); s2 += __shfl_xor(s2, 16); s2 += __shfl_xor(s2, 32);
                    if (fq == 0) { float* q = vst + ((size_t)(row0 + ai * 128 + m * 16) * 16 + (u.pn & 3) * 4 + wc) * 2; q[0] = s1; q[1] = s2; } } }
    }
    __device__ __forceinline__ void operator()(const f32x4 (&acc)[2][2][4][2], const pg8::Unit& u, int wr, int wc, int fr, int fq) const {
        if ((u.pn >> 2) == 1) body<true>(acc, u, wr, wc, fr, fq); else body<false>(acc, u, wr, wc, fr, fq);
    }
};
template <bool XF32> struct EpiResid {
    static constexpr bool PERM = true, AFTER_DRAIN = false;
    const float* __restrict__ XinF; const u16* __restrict__ XinB; u16* __restrict__ Xout; float* __restrict__ XoutT; const float* __restrict__ gate; float coef; int ntf, pk;
    __device__ __forceinline__ void operator()(const f32x4 (&acc)[2][2][4][2], const pg8::Unit& u, int wr, int wc, int fr, int fq) const {
        const int row0 = u.pm * 256 + wr * 64 + fr, col0 = u.pn * 256 + wc * 32 + 8 * fq;
        if (u.nt == ntf) {
#pragma unroll
            for (int ai = 0; ai < 2; ++ai)
#pragma unroll
                for (int m = 0; m < 4; ++m) { const int row = row0 + ai * 128 + m * 16; const float* gp = gate + (size_t)bidx(row) * ADAC + col0;
#pragma unroll
                    for (int bj = 0; bj < 2; ++bj) { const int o = bj * 128; float x[8];
                        if (XF32) { const f32x4 a = *(const f32x4*)(XinF + (size_t)row * 1024 + col0 + o), b = *(const f32x4*)(XinF + (size_t)row * 1024 + col0 + o + 4);
#pragma unroll
                            for (int j = 0; j < 4; ++j) { x[j] = a[j]; x[4 + j] = b[j]; } }
                        else unpack8(*(const u32x4*)(XinB + (size_t)row * 1024 + col0 + o), x);
                        const f32x4 g0 = *(const f32x4*)(gp + o), g1 = *(const f32x4*)(gp + o + 4);
#pragma unroll
                        for (int j = 0; j < 4; ++j) { x[j] += coef * g0[j] * acc[ai][bj][m][0][j]; x[4 + j] += coef * g1[j] * acc[ai][bj][m][1][j]; }
                        *(u32x4*)(Xout + (size_t)row * 1024 + col0 + o) = pack8(x); } }
        } else {
            float* sl = XoutT + (size_t)(u.k0 / pk) * ((size_t)NSR * 1024);
#pragma unroll
            for (int ai = 0; ai < 2; ++ai)
#pragma unroll
                for (int m = 0; m < 4; ++m) { const int row = row0 + ai * 128 + m * 16;
                    const float* gp = gate + (size_t)bidx(row) * ADAC + col0; float* op = sl + (size_t)(row - NPR) * 1024 + col0;
#pragma unroll
                    for (int bj = 0; bj < 2; ++bj) { const int o = bj * 128;
                        *(f32x4*)(op + o) = coef * (*(const f32x4*)(gp + o)) * acc[ai][bj][m][0]; *(f32x4*)(op + o + 4) = coef * (*(const f32x4*)(gp + o + 4)) * acc[ai][bj][m][1]; } }
        }
    }
};
template <class Epi> __device__ __forceinline__ void run_gemm(LAS unsigned char* lds, const u16* A, const u16* Bt, int M, int N, int K, const Epi& E, int ppu = 0, int pnt = 0, int nMt = 0) {
    pg8::Gemm g; g.A = A; g.Bt = Bt; g.M = M; g.N = N; g.K = K;
    pg8::StaticOrder S; S.init(M, N, (int)gridDim.x, (int)blockIdx.x, K / 64, ppu, pnt, nMt);
    pg8::gemm_phase<Epi, pg8::StaticOrder, false>(lds, g, S, E, nullptr);
}

__device__ __forceinline__ void phase_convert(const Params& p, LAS unsigned char* lds, int t_begin, int t_end, int first_wg, int n_wg, bool extras) {
    const int tid = tid_opaque();
    LAS u16* T = (LAS u16*)lds;
    constexpr int NJ = 8;
    const int jn[NJ] = {5632, 1024, 8192, 1024, 5632, 1024, 9216, 2048};
    const int jk[NJ] = {1024, 2816, 1024, 1024, 1024, 2816, 1024, 1024};
    int total = 0;
#pragma unroll
    for (int j = 0; j < NJ; ++j) total += (jn[j] / 256) * (jk[j] / 64);
    (void)total;
    for (int t = t_begin + ((int)blockIdx.x - first_wg); (int)blockIdx.x >= first_wg && (int)blockIdx.x < first_wg + n_wg && t < t_end; t += n_wg) {
        int lt = t, job = 0;
#pragma unroll
        for (int j = 0; j < NJ - 1; ++j) { const int c = (jn[j] / 256) * (jk[j] / 64); if (job == j && lt >= c) { lt -= c; job = j + 1; } }
        const float* src; int ld, K, mode; u16* dst;
        switch (job) {
            case 0: src = p.in[11]; ld = 5632; K = 1024; mode = 1; dst = (u16*)(p.ws + W_WB1); break;
            case 1: src = p.in[12]; ld = 1024; K = 2816; mode = 0; dst = (u16*)(p.ws + W_WB2); break;
            case 2: src = p.in[14]; ld = 8200; K = 1024; mode = 2; dst = (u16*)(p.ws + W_WB3); break;
            case 3: src = p.in[23]; ld = 1024; K = 1024; mode = 0; dst = (u16*)(p.ws + W_WB4); break;
            case 4: src = p.in[25]; ld = 5632; K = 1024; mode = 1; dst = (u16*)(p.ws + W_WB5); break;
            case 5: src = p.in[26]; ld = 1024; K = 2816; mode = 0; dst = (u16*)(p.ws + W_WB6); break;
            case 6: src = p.in[8]; ld = 9216; K = 1024; mode = 0; dst = (u16*)(p.ws + W_WBA); break;
            default: src = p.in[27]; ld = 2048; K = 1024; mode = 0; dst = (u16*)(p.ws + W_WBA) + (size_t)9216 * 1024; break;
        }
        const int nk = K / 64, tn = lt / nk, tk = lt - tn * nk, n0 = tn * 256, k0 = tk * 64;
        const int c4 = (tid & 63) * 4, kr = tid >> 6;
        int sc;
        if (mode == 1) sc = (c4 < 128) ? tn * 128 + c4 : FF + tn * 128 + (c4 - 128);
        else if (mode == 2) sc = (n0 < 6144 ? n0 : n0 + 8) + c4;
        else sc = n0 + c4;
        f32x4 v[8];
#pragma unroll
        for (int i = 0; i < 8; ++i) v[i] = *(const f32x4*)(src + (size_t)(k0 + kr + 8 * i) * ld + sc);
#pragma unroll
        for (int i = 0; i < 8; ++i) { const int k = kr + 8 * i;
            const unsigned a = pk2(v[i][0], v[i][1]), b = pk2(v[i][2], v[i][3]);
            T[(c4 + 0) * 72 + k] = (u16)a; T[(c4 + 1) * 72 + k] = (u16)(a >> 16); T[(c4 + 2) * 72 + k] = (u16)b; T[(c4 + 3) * 72 + k] = (u16)(b >> 16); }
        __syncthreads();
#pragma unroll
        for (int i = 0; i < 4; ++i) { const int q = tid + 512 * i, n = q >> 3, k8 = (q & 7) * 8;
            *(u32x4*)(dst + (size_t)(n0 + n) * K + k0 + k8) = *(LAS const u32x4*)(T + n * 72 + k8); }
        __syncthreads();
    }
    if (!extras) return;
    const int gt = blockIdx.x * 512 + tid, gs = gridDim.x * 512;
    u16* CS = (u16*)(p.ws + W_CS);
    for (int i = gt; i < 256 * 1024; i += gs) { const int r = i >> 10, c = i & 1023; float v = 0.f;
        if (r < 8) v = p.in[2][r * 1024 + c]; else if (r < 136) v = p.in[3][(r - 8) * 1024 + c];
        v = v * sigm(v); CS[i] = (u16)(pk2(v, 0.f) & 0xffffu); }
    float* BIAS = (float*)(p.ws + W_BIAS);
    for (int i = gt; i < ADAC; i += gs) BIAS[i] = i < 9216 ? p.in[9][i] : p.in[28][i - 9216];
    float* WG = (float*)(p.ws + W_WG);
    for (int i = gt; i < 8192; i += gs) { const int j = i >> 10, k = i & 1023; WG[i] = p.in[14][(size_t)k * 8200 + 6144 + j]; }
}

template <int WHICH> __device__ __forceinline__ void phase_prep(const Params& p) {
    const int tid = tid_opaque(), lane = tid & 63, wid = tid >> 6;
    const float* ADA = (const float*)(p.ws + W_ADA);
    float* Y = p.out + O_Y;
    u16* H = (u16*)(p.ws + W_H);
    float* XS = (float*)(p.ws + W_XS);
    const float* gv = WHICH == 0 ? p.in[10] : WHICH == 1 ? p.in[13] : WHICH == 2 ? p.in[24] : p.in[29];
    const int jsh = WHICH == 3 ? 9 : 3 * WHICH, jsc = jsh + 1;
    const float* WG = (const float*)(p.ws + W_WG);
    for (int row = blockIdx.x * 8 + wid; row < MR; row += gridDim.x * 8) {
        const float* ab = ADA + (size_t)bidx(row) * ADAC;
        float v[2][8]; float ss = 0.f;
#pragma unroll
        for (int i = 0; i < 2; ++i) { const int c = i * 512 + lane * 8;
            if (WHICH == 0) { const float* xr = (row < NPR ? p.in[0] + (size_t)row * 1024 : p.in[1] + (size_t)(row - NPR) * 1024) + c;
                const f32x4 a = *(const f32x4*)xr, b = *(const f32x4*)(xr + 4);
#pragma unroll
                for (int j = 0; j < 4; ++j) { v[i][j] = a[j]; v[i][4 + j] = b[j]; } }
            else if (row < NPR) { const u16* xb = WHICH == 1 ? (const u16*)p.out : WHICH == 2 ? (const u16*)(p.ws + W_X2) : (const u16*)(p.ws + W_X3);
                unpack8(*(const u32x4*)(xb + (size_t)row * 1024 + c), v[i]); }
            else {
                float* xs = XS + (size_t)(row - NPR) * 1024 + c; f32x4 a = *(const f32x4*)xs, b = *(const f32x4*)(xs + 4);
                const float* sl = (const float*)(p.ws + W_SLAB) + (size_t)(row - NPR) * 1024 + c;
#pragma unroll
                for (int pi = 0; pi < (WHICH == 2 ? 4 : 5); ++pi) { a += *(const f32x4*)(sl + (size_t)pi * NSR * 1024); b += *(const f32x4*)(sl + (size_t)pi * NSR * 1024 + 4); }
                if (WHICH < 3) { *(f32x4*)xs = a; *(f32x4*)(xs + 4) = b; }
#pragma unroll
                for (int j = 0; j < 4; ++j) { v[i][j] = a[j]; v[i][4 + j] = b[j]; } }
#pragma unroll
            for (int j = 0; j < 8; ++j) ss += v[i][j] * v[i][j]; }
        ss = wsum(ss);
        const float rstd = rsqrtf(ss * (1.0f / 1024.0f) + 1e-6f);
        float ga[8];
#pragma unroll
        for (int j = 0; j < 8; ++j) ga[j] = 0.f;
#pragma unroll
        for (int i = 0; i < 2; ++i) { const int c = i * 512 + lane * 8; float h[8];
#pragma unroll
            for (int q = 0; q < 2; ++q) { const f32x4 g4 = *(const f32x4*)(gv + c + 4 * q), s4 = *(const f32x4*)(ab + jsc * 1024 + c + 4 * q), h4 = *(const f32x4*)(ab + jsh * 1024 + c + 4 * q);
#pragma unroll
                for (int j = 0; j < 4; ++j) h[4 * q + j] = v[i][4 * q + j] * rstd * g4[j] * (1.0f + s4[j]) + h4[j]; }
            if (WHICH == 0 && row >= NPR) { float* xs = XS + (size_t)(row - NPR) * 1024 + c;
                *(f32x4*)xs = (f32x4){v[i][0], v[i][1], v[i][2], v[i][3]}; *(f32x4*)(xs + 4) = (f32x4){v[i][4], v[i][5], v[i][6], v[i][7]}; }
            if (WHICH == 3) { float* y = Y + (size_t)row * 1024 + c; *(f32x4*)y = (f32x4){h[0], h[1], h[2], h[3]}; *(f32x4*)(y + 4) = (f32x4){h[4], h[5], h[6], h[7]}; }
            else *(u32x4*)(H + (size_t)row * 1024 + c) = pack8(h);
            if (WHICH == 1) {
#pragma unroll
                for (int j = 0; j < 8; ++j) { const f32x4 w0 = *(const f32x4*)(WG + j * 1024 + c), w1 = *(const f32x4*)(WG + j * 1024 + c + 4);
                    ga[j] += h[0] * w0[0] + h[1] * w0[1] + h[2] * w0[2] + h[3] * w0[3] + h[4] * w1[0] + h[5] * w1[1] + h[6] * w1[2] + h[7] * w1[3]; } }
        }
        if (WHICH == 1) {
            float mine = 0.f;
#pragma unroll
            for (int j = 0; j < 8; ++j) { const float s = wsum(ga[j]); if (lane == j) mine = s; }
            if (lane < 8) ((float*)(p.ws + W_GATES))[(size_t)row * 8 + lane] = mine + p.in[15][lane];
        }
    }
}

__device__ __forceinline__ void gmlp_prompt_unit(const Params& p, LAS unsigned char* lds, int b, int c, int g) {
    const int tid = tid_opaque(), lane = tid & 63, wid = tid >> 6;
    LAS float* mu = (LAS float*)lds; LAS float* rs = mu + 128;
    LAS u16* WL = (LAS u16*)(lds + 1024);
    LAS u16* VL = (LAS u16*)(lds + 1024 + 34816);
    u16* Z = (u16*)(p.ws + W_Z);
    const size_t R0 = (size_t)b * 2048 + c * 128;
    if (tid < 128) { const f32x4* q = (const f32x4*)((const float*)(p.ws + W_VST) + (R0 + tid) * 32); float s = 0.f, ss = 0.f;
#pragma unroll
        for (int i = 0; i < 8; ++i) { const f32x4 v = q[i]; s += v[0] + v[2]; ss += v[1] + v[3]; }
        const float m = s * (1.0f / 1024.0f); const float var = fmaxf(ss * (1.0f / 1024.0f) - m * m, 0.f); mu[tid] = m; rs[tid] = rsqrtf(var + 1e-6f); }
    {   const float* w = p.in[20] + (size_t)g * 16384;
#pragma unroll
        for (int i = 0; i < 8; ++i) { const int q = tid + 512 * i, t = q >> 5, s = (q & 31) * 4; const f32x4 v = *(const f32x4*)(w + t * 128 + s);
            u32x2 o; o.x = pk2(s <= t ? v[0] : 0.f, s + 1 <= t ? v[1] : 0.f); o.y = pk2(s + 2 <= t ? v[2] : 0.f, s + 3 <= t ? v[3] : 0.f);
            *(LAS u32x2*)(WL + t * 136 + s) = o; } }
    lds_barrier();
    {   const int cc = (tid & 31) * 8; float lg[8], lb[8];
#pragma unroll
        for (int j = 0; j < 8; ++j) { lg[j] = p.in[18][g * 256 + cc + j]; lb[j] = p.in[19][g * 256 + cc + j]; }
        u32x4 vv[8];
#pragma unroll
        for (int i = 0; i < 8; ++i) { const int r = (tid + 512 * i) >> 5; vv[i] = *(const u32x4*)(Z + zo(R0 + r, 1024 + g * 256 + cc)); }
#pragma unroll
        for (int i = 0; i < 8; ++i) { const int r = (tid + 512 * i) >> 5; const float m = mu[r], rsd = rs[r]; float f[8]; unpack8(vv[i], f);
#pragma unroll
            for (int j = 0; j < 8; ++j) f[j] = (f[j] - m) * rsd * lg[j] + lb[j];
            *(LAS u32x4*)(VL + r * 264 + cc) = pack8(f); } }
    lds_barrier();
    f32x4 acc[8][2];
#pragma unroll
    for (int i = 0; i < 8; ++i) { acc[i][0] = (f32x4){0.f, 0.f, 0.f, 0.f}; acc[i][1] = (f32x4){0.f, 0.f, 0.f, 0.f}; }
#pragma unroll
    for (int kk = 0; kk < 4; ++kk) {
        const bf16x8 B0 = frag_tr(VL, 264, 32 * wid, 32 * kk, lane), B1 = frag_tr(VL, 264, 32 * wid + 16, 32 * kk, lane);
#pragma unroll
        for (int i = 0; i < 8; ++i) if (32 * kk <= 16 * i + 15) { const bf16x8 A = frag_rm(WL, 136, 16 * i, 32 * kk, lane); MMA_T(acc[i][0], B0, A); MMA_T(acc[i][1], B1, A); }
    }
    const int cc = (tid & 31) * 8;
    u32x4 gu[8], ga[8];
#pragma unroll
    for (int i = 0; i < 8; ++i) { const int r = (tid + 512 * i) >> 5; gu[i] = *(const u32x4*)(Z + zo(R0 + r, g * 256 + cc)); ga[i] = *(const u32x4*)(Z + zo(R0 + r, 6 * 1024 + g * 256 + cc)); }
    lds_barrier();
    const float* bs = p.in[21] + g * 128;
#pragma unroll
    for (int i = 0; i < 8; ++i) { const int t = 16 * i + (lane & 15); const float bsv = bs[t];
#pragma unroll
        for (int nn = 0; nn < 2; ++nn) { const int d = 32 * wid + 16 * nn + (lane >> 4) * 4;
            u32x2 o; o.x = pk2(acc[i][nn][0] + bsv, acc[i][nn][1] + bsv); o.y = pk2(acc[i][nn][2] + bsv, acc[i][nn][3] + bsv); *(LAS u32x2*)(VL + t * 264 + d) = o; } }
    lds_barrier();
#pragma unroll
    for (int i = 0; i < 8; ++i) { const int r = (tid + 512 * i) >> 5; float o[8], u8[8], a8[8]; unpack8(*(LAS const u32x4*)(VL + r * 264 + cc), o); unpack8(gu[i], u8); unpack8(ga[i], a8);
#pragma unroll
        for (int j = 0; j < 8; ++j) o[j] = sigm(a8[j]) * gelu_t(u8[j]) * o[j];
        *(u32x4*)(Z + zo(R0 + r, g * 256 + cc)) = pack8(o); }
    lds_barrier();
}

__device__ __forceinline__ void gmlp_sample_unit(const Params& p, LAS unsigned char* lds, int b) {
    const int tid = tid_opaque(), lane = tid & 63, wid = tid >> 6;
    LAS float* VS = (LAS float*)lds;
    u16* Z = (u16*)(p.ws + W_Z);
    const size_t r0 = (size_t)NPR + b * 8;
    {   const int t = wid; const u16* src = Z + zo(r0 + t, 1024 + lane * 16);
        float f[16]; unpack8(*(const u32x4*)src, f); unpack8(*(const u32x4*)(src + 8), f + 8);
        float s = 0.f, ss = 0.f;
#pragma unroll
        for (int j = 0; j < 16; ++j) { s += f[j]; ss += f[j] * f[j]; }
        s = wsum(s); ss = wsum(ss);
        const float m = s * (1.0f / 1024.0f), rsd = rsqrtf(fmaxf(ss * (1.0f / 1024.0f) - m * m, 0.f) + 1e-6f);
        float* vo = p.out + O_VS + ((size_t)b * 8 + t) * 1024 + lane * 16;
#pragma unroll
        for (int j = 0; j < 16; ++j) { const float v = (f[j] - m) * rsd * p.in[18][lane * 16 + j] + p.in[19][lane * 16 + j]; VS[t * 1024 + lane * 16 + j] = v; vo[j] = v; } }
    lds_barrier();
    {   const int c = tid * 2, g = c >> 8; const float* ws = p.in[20] + (size_t)g * 16384; const float* bs = p.in[21] + g * 128;
#pragma unroll
        for (int t = 0; t < 8; ++t) { float a0 = bs[t], a1 = a0;
#pragma unroll
            for (int s = 0; s <= t; ++s) { const float w = ws[t * 128 + s]; a0 += w * VS[s * 1024 + c]; a1 += w * VS[s * 1024 + c + 1]; }
            const size_t row = r0 + t; const unsigned gu = *(const unsigned*)(Z + zo(row, c)), ga = *(const unsigned*)(Z + zo(row, 6 * 1024 + c));
            *(unsigned*)(Z + zo(row, c)) = pk2(sigm(bflo(ga)) * gelu_t(bflo(gu)) * a0, sigm(bfhi(ga)) * gelu_t(bfhi(gu)) * a1); } }
    lds_barrier();
}

__device__ __forceinline__ void conv_unit(const Params& p, size_t rowbase, int nrows, int histmode, const float* hist, float* outconv) {
    const int tid = tid_opaque(), c4 = tid * 4;
    const u16* Z = (const u16*)(p.ws + W_Z);
    u16* dst = c4 < 1024 ? (u16*)(p.ws + W_QB) : (u16*)(p.ws + W_KB); const int dc = c4 & 1023;
    const float osc = c4 < 1024 ? 1.0f : 0.0625f;
    f32x4 w[4];
#pragma unroll
    for (int j = 0; j < 4; ++j) w[j] = *(const f32x4*)(p.in[16] + j * 2048 + c4);
    const f32x4 cb = *(const f32x4*)(p.in[17] + c4);
    f32x4 x[3];
#pragma unroll
    for (int j = 0; j < 3; ++j) {
        if (histmode == 0) x[j] = (f32x4){0.f, 0.f, 0.f, 0.f};
        else if (histmode == 1) { const u32x2 v = *(const u32x2*)(Z + zo(rowbase - 3 + j, 2048 + c4)); x[j] = (f32x4){bflo(v.x), bfhi(v.x), bflo(v.y), bfhi(v.y)}; }
        else x[j] = *(const f32x4*)(hist + j * 2048 + c4);
    }
#pragma unroll 8
    for (int t = 0; t < nrows; ++t) {
        const u32x2 v = *(const u32x2*)(Z + zo(rowbase + t, 2048 + c4));
        const f32x4 xv = (f32x4){bflo(v.x), bfhi(v.x), bflo(v.y), bfhi(v.y)};
        f32x4 y = cb + w[0] * x[0] + w[1] * x[1] + w[2] * x[2] + w[3] * xv;
        u32x2 o; o.x = pk2(y[0] * sigm(y[0]) * osc, y[1] * sigm(y[1]) * osc); o.y = pk2(y[2] * sigm(y[2]) * osc, y[3] * sigm(y[3]) * osc);
        *(u32x2*)(dst + qo(rowbase + t, dc)) = o;
        if (outconv && t >= nrows - 3) *(f32x4*)(outconv + (size_t)(t - (nrows - 3)) * 2048 + c4) = xv;
        x[0] = x[1]; x[1] = x[2]; x[2] = xv;
    }
}

__device__ __forceinline__ void conv_unit64(const Params& p, size_t rowbase, bool zero_hist, float* outconv) {
    const int tid = tid_opaque(), c8 = (tid & 255) * 8, rh = tid >> 8;
    const u16* Z = (const u16*)(p.ws + W_Z); const int zc = 2048 + c8;
    u16* dst = c8 < 1024 ? (u16*)(p.ws + W_QB) : (u16*)(p.ws + W_KB); const int dc = c8 & 1023;
    const float osc = c8 < 1024 ? 1.0f : 0.0625f;
    float w[4][8], cb[8], x[3][8];
#pragma unroll
    for (int j = 0; j < 4; ++j) { const f32x4 a = *(const f32x4*)(p.in[16] + j * 2048 + c8), b = *(const f32x4*)(p.in[16] + j * 2048 + c8 + 4);
#pragma unroll
        for (int e = 0; e < 4; ++e) { w[j][e] = a[e]; w[j][4 + e] = b[e]; } }
    {   const f32x4 a = *(const f32x4*)(p.in[17] + c8), b = *(const f32x4*)(p.in[17] + c8 + 4);
#pragma unroll
        for (int e = 0; e < 4; ++e) { cb[e] = a[e]; cb[4 + e] = b[e]; } }
    const size_t r0 = rowbase + 32 * rh;
    u32x4 cur[8], nxt[8];
#pragma unroll
    for (int i = 0; i < 8; ++i) cur[i] = *(const u32x4*)(Z + zo(r0 + i, zc));
#pragma unroll
    for (int j = 0; j < 3; ++j) {
        if (zero_hist && rh == 0) {
#pragma unroll
            for (int e = 0; e < 8; ++e) x[j][e] = 0.f; }
        else unpack8(*(const u32x4*)(Z + zo(r0 - 3 + j, zc)), x[j]);
    }
#pragma unroll
    for (int blk = 0; blk < 4; ++blk) {
        if (blk < 3) {
#pragma unroll
            for (int i = 0; i < 8; ++i) nxt[i] = *(const u32x4*)(Z + zo(r0 + 8 * (blk + 1) + i, zc)); }
#pragma unroll
        for (int i = 0; i < 8; ++i) { const int t = 8 * blk + i; float xv[8], o[8]; unpack8(cur[i], xv);
#pragma unroll
            for (int e = 0; e < 8; ++e) { const float y = cb[e] + w[0][e] * x[0][e] + w[1][e] * x[1][e] + w[2][e] * x[2][e] + w[3][e] * xv[e]; o[e] = y * sigm(y) * osc; }
            *(u32x4*)(dst + qo(r0 + t, dc)) = pack8(o);
            if (outconv && rh == 1 && t >= 29) { float* oc = outconv + (size_t)(t - 29) * 2048 + c8; *(f32x4*)oc = (f32x4){xv[0], xv[1], xv[2], xv[3]}; *(f32x4*)(oc + 4) = (f32x4){xv[4], xv[5], xv[6], xv[7]}; }
#pragma unroll
            for (int e = 0; e < 8; ++e) { x[0][e] = x[1][e]; x[1][e] = x[2][e]; x[2][e] = xv[e]; } }
        if (blk < 3) {
#pragma unroll
            for (int i = 0; i < 8; ++i) cur[i] = nxt[i]; }
    }
}

__device__ __forceinline__ void phase_mix1(const Params& p, LAS unsigned char* lds) {
    for (int u = blockIdx.x; u < 1024; u += gridDim.x) {
        if (u < 512) gmlp_prompt_unit(p, lds, u >> 6, (u >> 2) & 15, u & 3);
        else if (u < 768) { const int v = u - 512, b = v >> 5, hc = v & 31; conv_unit64(p, (size_t)b * 2048 + hc * 64, hc == 0, hc == 31 ? p.out + O_CVP + (size_t)b * 6144 : nullptr); }
        else if (u < 896) gmlp_sample_unit(p, lds, u - 768);
        else { const int b = u - 896; conv_unit(p, (size_t)NPR + b * 8, 8, 2, p.in[7] + (size_t)b * 6144, p.out + O_CVS + (size_t)b * 6144); }
    }
}

__device__ __forceinline__ float logsig(float f) { return fminf(f, 0.f) - log1pf(__expf(-fabsf(f))); }

__device__ __forceinline__ void scan_prompt_unit(const Params& p, LAS unsigned char* lds, int b, int h, int slab) {
    const int tid = tid_opaque(), lane = tid & 63, wid = tid >> 6, bh = b * 4 + h;
    LAS float* ASl = (LAS float*)lds;
    LAS float* Mc = ASl + 2048;
    LAS float* mi = Mc + 16;
    LAS float* bL = mi + 16;
    LAS float* amx = bL + 16;
    LAS u16* KL = (LAS u16*)(lds + 16384);
    LAS u16* VWL = (LAS u16*)(lds + 16384 + 67584);
    const float* GATES = (const float*)(p.ws + W_GATES);
    const u16* Z = (const u16*)(p.ws + W_Z); const u16* KB = (const u16*)(p.ws + W_KB);
    u16* CT = (u16*)(p.ws + W_CT);
    const size_t Rb = (size_t)b * 2048;
    u32x4 kreg[8], vreg[2];
    const int vr = tid >> 2, vcc = (tid & 3) * 16;
#pragma unroll
    for (int i = 0; i < 8; ++i) { const int q = tid + 512 * i, r = q >> 5, cc = (q & 31) * 8; kreg[i] = *(const u32x4*)(KB + qo(Rb + r, h * 256 + cc)); }
    vreg[0] = *(const u32x4*)(Z + zo(Rb + vr, 4096 + h * 256 + slab * 64 + vcc)); vreg[1] = *(const u32x4*)(Z + zo(Rb + vr, 4096 + h * 256 + slab * 64 + vcc + 8));
    {   const int p0 = tid * 4; float iv[4], bv[4], av[4], cm[4];
        float run = 0.f;
#pragma unroll
        for (int j = 0; j < 4; ++j) { const float* gp = GATES + (Rb + p0 + j) * 8; iv[j] = gp[h]; run += logsig(gp[4 + h]); bv[j] = run; }
        float sc = run;
#pragma unroll
        for (int d = 1; d < 32; d <<= 1) { const float o = __shfl_up(sc, d, 32); if ((lane & 31) >= d) sc += o; }
        const float off = sc - run;
        float rm = -INFINITY;
#pragma unroll
        for (int j = 0; j < 4; ++j) { bv[j] += off; av[j] = iv[j] - bv[j]; rm = fmaxf(rm, av[j]); cm[j] = rm; }
        float sm = rm;
#pragma unroll
        for (int d = 1; d < 32; d <<= 1) { const float o = __shfl_up(sm, d, 32); if ((lane & 31) >= d) sm = fmaxf(sm, o); }
        float em = __shfl_up(sm, 1, 32); if ((lane & 31) == 0) em = -INFINITY;
#pragma unroll
        for (int j = 0; j < 4; ++j) { cm[j] = fmaxf(cm[j], em); ASl[p0 + j] = av[j]; }
        if (slab == 0) {
            *(f32x4*)((float*)(p.ws + W_BS) + (size_t)bh * 2048 + p0) = (f32x4){bv[0], bv[1], bv[2], bv[3]};
            *(f32x4*)((float*)(p.ws + W_AS) + (size_t)bh * 2048 + p0) = (f32x4){av[0], av[1], av[2], av[3]};
            *(f32x4*)((float*)(p.ws + W_CM) + (size_t)bh * 2048 + p0) = (f32x4){cm[0], cm[1], cm[2], cm[3]}; }
        if ((lane & 31) == 31) { bL[p0 >> 7] = bv[3]; amx[p0 >> 7] = cm[3]; } }
    lds_barrier();
    if (tid == 0) { float m = 0.f;
        for (int c = 0; c < 16; ++c) { mi[c] = m; const float M = fmaxf(m, amx[c]); Mc[c] = M; if (slab == 0) ((float*)(p.ws + W_MINIT))[bh * 16 + c] = m; m = bL[c] + M; }
        if (slab == 0) p.out[O_MP + bh] = m; }
    lds_barrier();
    f32x4 acc[5][2];
#pragma unroll
    for (int i = 0; i < 5; ++i) { acc[i][0] = (f32x4){0.f, 0.f, 0.f, 0.f}; acc[i][1] = (f32x4){0.f, 0.f, 0.f, 0.f}; }
    for (int c = 0; c < 16; ++c) {
        const float M = Mc[c], ap = __expf(mi[c] - M);
        const float w = __expf(ASl[c * 128 + vr] - M);
#pragma unroll
        for (int i = 0; i < 8; ++i) { const int q = tid + 512 * i, r = q >> 5, cc = (q & 31) * 8; *(LAS u32x4*)(KL + r * 264 + cc) = kreg[i]; }
        {   float f[8];
#pragma unroll
            for (int q = 0; q < 2; ++q) { unpack8(vreg[q], f);
#pragma unroll
                for (int j = 0; j < 8; ++j) f[j] *= w;
                *(LAS u32x4*)(VWL + vr * 88 + vcc + 8 * q) = pack8(f); }
            if ((tid & 3) == 0) { u32x4 e; e.x = pk2(w, 0.f); e.y = 0u; e.z = 0u; e.w = 0u; *(LAS u32x4*)(VWL + vr * 88 + 64) = e; e.x = 0u; *(LAS u32x4*)(VWL + vr * 88 + 72) = e; } }
        lds_barrier();
        if (c < 15) { const size_t R1 = Rb + (c + 1) * 128;
#pragma unroll
            for (int i = 0; i < 8; ++i) { const int q = tid + 512 * i, r = q >> 5, cc = (q & 31) * 8; kreg[i] = *(const u32x4*)(KB + qo(R1 + r, h * 256 + cc)); }
            vreg[0] = *(const u32x4*)(Z + zo(R1 + vr, 4096 + h * 256 + slab * 64 + vcc)); vreg[1] = *(const u32x4*)(Z + zo(R1 + vr, 4096 + h * 256 + slab * 64 + vcc + 8)); }
#pragma unroll
        for (int i = 0; i < 5; ++i) { acc[i][0] *= ap; acc[i][1] *= ap; }
#pragma unroll
        for (int kk = 0; kk < 4; ++kk) {
            const bf16x8 B0 = frag_tr(KL, 264, 32 * wid, 32 * kk, lane), B1 = frag_tr(KL, 264, 32 * wid + 16, 32 * kk, lane);
#pragma unroll
            for (int et = 0; et < 4; ++et) { const bf16x8 A = frag_tr(VWL, 88, 16 * et, 32 * kk, lane); MMA_T(acc[et][0], B0, A); MMA_T(acc[et][1], B1, A); }
            if (slab == 0) { const bf16x8 A4 = frag_tr(VWL, 88, 64, 32 * kk, lane); MMA_T(acc[4][0], B0, A4); MMA_T(acc[4][1], B1, A4); }
        }
        if (c < 15) {
#pragma unroll
            for (int et = 0; et < 4; ++et)
#pragma unroll
                for (int dt = 0; dt < 2; ++dt) { const int e = slab * 64 + 16 * et + (lane & 15), d = 32 * wid + 16 * dt + (lane >> 4) * 4;
                    u32x2 o; o.x = pk2(acc[et][dt][0], acc[et][dt][1]); o.y = pk2(acc[et][dt][2], acc[et][dt][3]);
                    *(u32x2*)(CT + (((size_t)bh * 16 + c + 1) * 256 + e) * 256 + d) = o; }
            if (slab == 0 && (lane & 15) == 0) {
#pragma unroll
                for (int dt = 0; dt < 2; ++dt) { const int d = 32 * wid + 16 * dt + (lane >> 4) * 4; *(f32x4*)((float*)(p.ws + W_NINIT) + ((size_t)bh * 16 + c + 1) * 256 + d) = acc[4][dt]; } } }
        lds_barrier();
    }
#pragma unroll
    for (int et = 0; et < 4; ++et)
#pragma unroll
        for (int dt = 0; dt < 2; ++dt) { const int e = slab * 64 + 16 * et + (lane & 15), d = 32 * wid + 16 * dt + (lane >> 4) * 4;
#pragma unroll
            for (int j = 0; j < 4; ++j) p.out[O_CP + ((size_t)bh * 256 + d + j) * 256 + e] = acc[et][dt][j]; }
    if (slab == 0 && (lane & 15) == 0) {
#pragma unroll
        for (int dt = 0; dt < 2; ++dt) { const int d = 32 * wid + 16 * dt + (lane >> 4) * 4; *(f32x4*)(p.out + O_NP + (size_t)bh * 256 + d) = acc[4][dt]; } }
    lds_barrier();
}

__device__ __forceinline__ void sample_unit(const Params& p, LAS unsigned char* lds, int b, int h) {
    const int tid = tid_opaque(), lane = tid & 63, wid = tid >> 6, bh = b * 4 + h;
    LAS float* QF = (LAS float*)lds;
    LAS float* KF = QF + 2048;
    LAS float* KWF = KF + 2048;
    LAS float* VF = KWF + 2048;
    LAS float* NUM = VF + 2048;
    LAS float* SC = NUM + 16384;
    LAS float* QN = SC + 64;
    LAS float* sa = QN + 8;
    LAS float* sM = sa + 8;
    LAS float* swi = sM + 8;
    LAS float* semt = swi + 8;
    LAS float* sw7 = semt + 8;
    LAS float* sden = sw7 + 8;
    LAS float* smisc = sden + 8;
    const float* GATES = (const float*)(p.ws + W_GATES);
    const u16* Z = (const u16*)(p.ws + W_Z); const u16* QB = (const u16*)(p.ws + W_QB); const u16* KB = (const u16*)(p.ws + W_KB);
    const size_t r0 = (size_t)NPR + b * 8;
    const float m0 = p.in[6][bh];
    const int e4 = lane * 4, dg = wid * 32;
    const float* C0 = p.in[4] + (size_t)bh * 65536 + e4; float* Co = p.out + O_CS + (size_t)bh * 65536 + e4;
    f32x4 cpre[4];
#pragma unroll
    for (int u = 0; u < 4; ++u) cpre[u] = __builtin_nontemporal_load((const f32x4*)(C0 + (size_t)(dg + u) * 256));
    if (tid == 0) { float bc = 0.f, cm = -INFINITY; float a[8];
        for (int t = 0; t < 8; ++t) { const float* gp = GATES + (r0 + t) * 8; bc += logsig(gp[4 + h]); a[t] = gp[h] - bc; cm = fmaxf(cm, a[t]); const float M = fmaxf(m0, cm);
            sa[t] = a[t]; sM[t] = M; swi[t] = __expf(m0 - M); semt[t] = __expf(-(bc + M)); if (t == 7) { smisc[0] = __expf(m0 - M); smisc[1] = bc + M; } }
        const float M7 = sM[7];
        for (int s = 0; s < 8; ++s) sw7[s] = __expf(a[s] - M7); }
    {   const int t = tid >> 6, d4 = (tid & 63) * 4;
        const u32x2 q = *(const u32x2*)(QB + qo(r0 + t, h * 256 + d4)), k = *(const u32x2*)(KB + qo(r0 + t, h * 256 + d4)), v = *(const u32x2*)(Z + zo(r0 + t, 4096 + h * 256 + d4));
        QF[(d4 + 0) * 8 + t] = bflo(q.x); QF[(d4 + 1) * 8 + t] = bfhi(q.x); QF[(d4 + 2) * 8 + t] = bflo(q.y); QF[(d4 + 3) * 8 + t] = bfhi(q.y);
        KF[(d4 + 0) * 8 + t] = bflo(k.x); KF[(d4 + 1) * 8 + t] = bfhi(k.x); KF[(d4 + 2) * 8 + t] = bflo(k.y); KF[(d4 + 3) * 8 + t] = bfhi(k.y);
        *(LAS f32x4*)(VF + t * 256 + d4) = (f32x4){bflo(v.x), bfhi(v.x), bflo(v.y), bfhi(v.y)}; }
    lds_barrier();
    {   const int pair = tid >> 3, t = pair >> 3, s = pair & 7, sub = tid & 7; float dot = 0.f, qn = 0.f;
        const float* n0 = p.in[5] + (size_t)bh * 256;
#pragma unroll 8
        for (int i = 0; i < 32; ++i) { const int d = sub * 32 + i; const float q = QF[d * 8 + t]; dot += q * KF[d * 8 + s]; qn += q * n0[d]; }
        dot += __shfl_xor(dot, 1); dot += __shfl_xor(dot, 2); dot += __shfl_xor(dot, 4);
        qn += __shfl_xor(qn, 1); qn += __shfl_xor(qn, 2); qn += __shfl_xor(qn, 4);
        if (sub == 0) { SC[t * 8 + s] = s <= t ? dot * __expf(fminf(sa[s] - sM[t], 0.f)) : 0.f; if (s == 0) QN[t] = qn; }
        const int d = tid >> 1, s4 = (tid & 1) * 4;
#pragma unroll
        for (int j = 0; j < 4; ++j) KWF[d * 8 + s4 + j] = KF[d * 8 + s4 + j] * sw7[s4 + j]; }
    lds_barrier();
    if (tid < 8) { float dn = swi[tid] * QN[tid];
        for (int s = 0; s < 8; ++s) dn += SC[tid * 8 + s];
        sden[tid] = dn; }
    const float ap = smisc[0];
    {   f32x4 vv[8], num[8];
#pragma unroll
        for (int s = 0; s < 8; ++s) { vv[s] = *(LAS const f32x4*)(VF + s * 256 + e4); num[s] = (f32x4){0.f, 0.f, 0.f, 0.f}; }
#pragma unroll 1
        for (int i = 0; i < 32; i += 4) {
            f32x4 cnx[4];
            if (i + 4 < 32) {
#pragma unroll
                for (int u = 0; u < 4; ++u) cnx[u] = __builtin_nontemporal_load((const f32x4*)(C0 + (size_t)(dg + i + 4 + u) * 256)); }
#pragma unroll
            for (int u = 0; u < 4; ++u) { const int d = dg + i + u; const f32x4 c0 = cpre[u];
                const f32x4 q0 = *(LAS const f32x4*)(QF + d * 8), q1 = *(LAS const f32x4*)(QF + d * 8 + 4), k0 = *(LAS const f32x4*)(KWF + d * 8), k1 = *(LAS const f32x4*)(KWF + d * 8 + 4);
                f32x4 cn = ap * c0;
#pragma unroll
                for (int j = 0; j < 4; ++j) { num[j] += q0[j] * c0; num[4 + j] += q1[j] * c0; cn += k0[j] * vv[j] + k1[j] * vv[4 + j]; }
                __builtin_nontemporal_store(cn, (f32x4*)(Co + (size_t)d * 256)); }
            if (i + 4 < 32) {
#pragma unroll
                for (int u = 0; u < 4; ++u) cpre[u] = cnx[u]; }
        }
#pragma unroll
        for (int t = 0; t < 8; ++t) *(LAS f32x4*)(NUM + (wid * 8 + t) * 256 + e4) = num[t];
        if (tid < 256) { const int d = tid; float s = ap * p.in[5][(size_t)bh * 256 + d];
#pragma unroll
            for (int j = 0; j < 8; ++j) s += KWF[d * 8 + j];
            p.out[O_NS + (size_t)bh * 256 + d] = s; }
        if (tid == 0) p.out[O_MS + bh] = smisc[1]; }
    lds_barrier();
    {   const int t = wid; const float wi = swi[t], dn = fmaxf(fabsf(sden[t]), semt[t]);
        f32x4 n = (f32x4){0.f, 0.f, 0.f, 0.f};
#pragma unroll
        for (int g = 0; g < 8; ++g) n += *(LAS const f32x4*)(NUM + (g * 8 + t) * 256 + e4);
        n *= wi;
#pragma unroll
        for (int s = 0; s < 8; ++s) n += SC[t * 8 + s] * (*(LAS const f32x4*)(VF + s * 256 + e4));
        float hv[4]; float s1 = 0.f, s2 = 0.f;
#pragma unroll
        for (int j = 0; j < 4; ++j) { hv[j] = n[j] / dn; s1 += hv[j]; s2 += hv[j] * hv[j]; }
        s1 = wsum(s1); s2 = wsum(s2);
        const float mean = s1 * (1.0f / 256.0f), rstd = rsqrtf(fmaxf(s2 * (1.0f / 256.0f) - mean * mean, 0.f) + 1e-6f);
        const size_t row = r0 + t; const int col = h * 256 + e4;
        const u32x2 ma = *(const u32x2*)(Z + zo(row, col)), so = *(const u32x2*)(Z + zo(row, 5 * 1024 + col)), gb = *(const u32x2*)(Z + zo(row, 7 * 1024 + col));
        const f32x4 ng = *(const f32x4*)(p.in[22] + col);
        const float o0 = bflo(ma.x) + sigm(bflo(gb.x)) * sigm(bflo(so.x)) * (hv[0] - mean) * rstd * ng[0], o1 = bfhi(ma.x) + sigm(bfhi(gb.x)) * sigm(bfhi(so.x)) * (hv[1] - mean) * rstd * ng[1];
        const float o2 = bflo(ma.y) + sigm(bflo(gb.y)) * sigm(bflo(so.y)) * (hv[2] - mean) * rstd * ng[2], o3 = bfhi(ma.y) + sigm(bfhi(gb.y)) * sigm(bfhi(so.y)) * (hv[3] - mean) * rstd * ng[3];
        u32x2 o; o.x = pk2(o0, o1); o.y = pk2(o2, o3); *(u32x2*)((u16*)(p.ws + W_H) + row * 1024 + col) = o; }
    lds_barrier();
}

__device__ __forceinline__ void phase_mix2(const Params& p, LAS unsigned char* lds) {
    const int nscan = (int)gridDim.x / 2;
    if ((int)blockIdx.x < nscan) {
#pragma unroll 1
        for (int u = blockIdx.x; u < 128; u += nscan) { const int x = u & 7, j = u >> 3, bh = x * 4 + (j >> 2);
            scan_prompt_unit(p, lds, bh >> 2, bh & 3, j & 3); }
    }
    unsigned* ctr = (unsigned*)(p.ws + W_BAR) + 3584;
    LAS unsigned* slot = (LAS unsigned*)(lds + LDS_BYTES) + 2;
#pragma unroll 1
    for (;;) {
        if (tid_opaque() == 0) *slot = __hip_atomic_fetch_add(ctr, 1u, __ATOMIC_RELAXED, __HIP_MEMORY_SCOPE_AGENT);
        lds_barrier();
        const unsigned v = *slot;
        lds_barrier();
        if (v >= 512u) break;
        sample_unit(p, lds, (int)(v >> 2), (int)(v & 3));
    }
}

__device__ __forceinline__ void out_prompt_unit(const Params& p, LAS unsigned char* lds, int b, int h, int c) {
    const int tid = tid_opaque(), lane = tid & 63, wid = __builtin_amdgcn_readfirstlane(tid >> 6), bh = b * 4 + h;
    LAS u16* QL = (LAS u16*)lds;
    LAS u16* KVL = (LAS u16*)(lds + 67584);
    LAS float* al = (LAS float*)(lds + 135168);
    LAS float* Ml = al + 128;
    LAS float* wil = Ml + 128;
    LAS float* emtl = wil + 128;
    LAS float* RS = emtl + 128;
    LAS float* DEN = RS + 1024;
    LAS float* QN = DEN + 128;
    LAS float* nin = QN + 128;
    LAS float* LNS = nin + 256;
    const u16* Z = (const u16*)(p.ws + W_Z); const u16* QB = (const u16*)(p.ws + W_QB); const u16* KB = (const u16*)(p.ws + W_KB);
    const u16* CT = (const u16*)(p.ws + W_CT);
    const size_t R0 = (size_t)b * 2048 + c * 128;
    const int sr = tid >> 5, scc = (tid & 31) * 8;
    u32x4 vreg[8];
#pragma unroll
    for (int i = 0; i < 8; ++i) { const int r = sr + 16 * i;
        *(LAS u32x4*)(QL + r * 264 + scc) = *(const u32x4*)(QB + qo(R0 + r, h * 256 + scc));
        *(LAS u32x4*)(KVL + r * 264 + scc) = *(const u32x4*)(KB + qo(R0 + r, h * 256 + scc)); }
#pragma unroll
    for (int i = 0; i < 8; ++i) vreg[i] = *(const u32x4*)(Z + zo(R0 + sr + 16 * i, 4096 + h * 256 + scc));
    if (tid < 128) { const size_t gi = (size_t)bh * 2048 + c * 128 + tid; const float a = ((const float*)(p.ws + W_AS))[gi], cm = ((const float*)(p.ws + W_CM))[gi], bt = ((const float*)(p.ws + W_BS))[gi];
        const float mi = ((const float*)(p.ws + W_MINIT))[bh * 16 + c]; const float M = fmaxf(mi, cm);
        al[tid] = a; Ml[tid] = M; wil[tid] = __expf(mi - M); emtl[tid] = __expf(-(bt + M)); }
    if (tid < 256) nin[tid] = c > 0 ? ((const float*)(p.ws + W_NINIT))[((size_t)bh * 16 + c) * 256 + tid] : 0.f;
    RS[wid * 128 + lane] = 0.f; RS[wid * 128 + 64 + lane] = 0.f;
    lds_barrier();
    u32x2 preg[5];
#pragma unroll
    for (int it = 0; it < 5; ++it) {
        const int idx = wid + 8 * it;
        preg[it] = (u32x2){0u, 0u};
        if (idx < 36) {
            int tt = 0; while (idx >= (tt + 1) * (tt + 2) / 2) ++tt;
            const int st = idx - tt * (tt + 1) / 2;
            f32x4 sacc = (f32x4){0.f, 0.f, 0.f, 0.f};
#pragma unroll
            for (int kk = 0; kk < 8; ++kk) { const bf16x8 B = frag_rm(KVL, 264, 16 * st, 32 * kk, lane), A = frag_rm(QL, 264, 16 * tt, 32 * kk, lane); MMA_T(sacc, B, A); }
            const int t = 16 * tt + (lane & 15), s0 = 16 * st + (lane >> 4) * 4; const float M = Ml[t]; float pv[4]; float ps = 0.f;
#pragma unroll
            for (int j = 0; j < 4; ++j) { const int s = s0 + j; pv[j] = s <= t ? sacc[j] * __expf(fminf(al[s] - M, 0.f)) : 0.f; ps += pv[j]; }
            ps += __shfl_xor(ps, 16); ps += __shfl_xor(ps, 32);
            if (lane < 16) RS[wid * 128 + t] += ps;
            preg[it].x = pk2(pv[0], pv[1]); preg[it].y = pk2(pv[2], pv[3]);
        }
    }
    {   const int t = tid >> 2, sub = tid & 3; float qn = 0.f;
#pragma unroll 8
        for (int i = 0; i < 64; ++i) { const int d = sub * 64 + i; qn += bf2f(QL[t * 264 + d]) * nin[d]; }
        qn += __shfl_xor(qn, 1); qn += __shfl_xor(qn, 2);
        if (sub == 0) QN[t] = qn; }
    f32x4 acc[8][2];
#pragma unroll
    for (int i = 0; i < 8; ++i) { acc[i][0] = (f32x4){0.f, 0.f, 0.f, 0.f}; acc[i][1] = (f32x4){0.f, 0.f, 0.f, 0.f}; }
    if (c > 0) {
        const u16* cb = CT + (((size_t)bh * 16 + c) * 256 + 32 * wid + (lane & 15)) * 256 + (lane >> 4) * 8;
#pragma unroll
        for (int kk = 0; kk < 8; ++kk) { const bf16x8 B0 = *(const bf16x8*)(cb + 32 * kk), B1 = *(const bf16x8*)(cb + 16 * 256 + 32 * kk);
#pragma unroll
            for (int tt = 0; tt < 8; ++tt) { const bf16x8 A = frag_rm(QL, 264, 16 * tt, 32 * kk, lane); MMA_T(acc[tt][0], B0, A); MMA_T(acc[tt][1], B1, A); } }
#pragma unroll
        for (int tt = 0; tt < 8; ++tt) { const float w = wil[16 * tt + (lane & 15)]; acc[tt][0] *= w; acc[tt][1] *= w; }
    }
    lds_barrier();
    LAS u16* PL = QL;
#pragma unroll
    for (int it = 0; it < 5; ++it) {
        const int idx = wid + 8 * it;
        if (idx < 36) {
            int tt = 0; while (idx >= (tt + 1) * (tt + 2) / 2) ++tt;
            const int st = idx - tt * (tt + 1) / 2;
            const int t = 16 * tt + (lane & 15), s0 = 16 * st + (lane >> 4) * 4;
            *(LAS u32x2*)(PL + t * 136 + s0) = preg[it];
            if (st == tt && (tt & 1) == 0) *(LAS u32x2*)(PL + t * 136 + s0 + 16) = (u32x2){0u, 0u};
        }
    }
#pragma unroll
    for (int i = 0; i < 8; ++i) *(LAS u32x4*)(KVL + (sr + 16 * i) * 264 + scc) = vreg[i];
    if (tid < 128) { float dn = wil[tid] * QN[tid];
#pragma unroll
        for (int w = 0; w < 8; ++w) dn += RS[w * 128 + tid];
        DEN[tid] = dn; }
    lds_barrier();
#pragma unroll
    for (int kk = 0; kk < 4; ++kk) { const bf16x8 B0 = frag_tr(KVL, 264, 32 * wid, 32 * kk, lane), B1 = frag_tr(KVL, 264, 32 * wid + 16, 32 * kk, lane);
#pragma unroll
        for (int tt = 2 * kk; tt < 8; ++tt) { const bf16x8 A = frag_rm(PL, 136, 16 * tt, 32 * kk, lane); MMA_T(acc[tt][0], B0, A); MMA_T(acc[tt][1], B1, A); } }
#pragma unroll
    for (int tt = 0; tt < 8; ++tt) { const int tl = 16 * tt + (lane & 15); const float inv = 1.0f / fmaxf(fabsf(DEN[tl]), emtl[tl]); float s1 = 0.f, s2 = 0.f;
#pragma unroll
        for (int et = 0; et < 2; ++et) { acc[tt][et] *= inv;
#pragma unroll
            for (int j = 0; j < 4; ++j) { s1 += acc[tt][et][j]; s2 += acc[tt][et][j] * acc[tt][et][j]; } }
        s1 += __shfl_xor(s1, 16); s1 += __shfl_xor(s1, 32); s2 += __shfl_xor(s2, 16); s2 += __shfl_xor(s2, 32);
        if (lane < 16) { LNS[(wid * 128 + tl) * 2] = s1; LNS[(wid * 128 + tl) * 2 + 1] = s2; } }
    lds_barrier();
#pragma unroll
    for (int tt = 0; tt < 8; ++tt) { const int tl = 16 * tt + (lane & 15); float s1 = 0.f, s2 = 0.f;
#pragma unroll
        for (int w = 0; w < 8; ++w) { s1 += LNS[(w * 128 + tl) * 2]; s2 += LNS[(w * 128 + tl) * 2 + 1]; }
        const float mean = s1 * (1.0f / 256.0f), rstd = rsqrtf(fmaxf(s2 * (1.0f / 256.0f) - mean * mean, 0.f) + 1e-6f);
#pragma unroll
        for (int et = 0; et < 2; ++et) { const int e = 32 * wid + 16 * et + (lane >> 4) * 4;
            u32x2 o; o.x = pk2((acc[tt][et][0] - mean) * rstd, (acc[tt][et][1] - mean) * rstd); o.y = pk2((acc[tt][et][2] - mean) * rstd, (acc[tt][et][3] - mean) * rstd);
            *(LAS u32x2*)(KVL + tl * 264 + e) = o; } }
    lds_barrier();
    {   u16* H = (u16*)(p.ws + W_H); float ng[8];
#pragma unroll
        for (int j = 0; j < 8; ++j) ng[j] = p.in[22][h * 256 + scc + j];
        u32x4 ma[8], so[8], gb[8];
#pragma unroll
        for (int i = 0; i < 8; ++i) { const size_t zr = R0 + sr + 16 * i; ma[i] = *(const u32x4*)(Z + zo(zr, h * 256 + scc)); so[i] = *(const u32x4*)(Z + zo(zr, 5 * 1024 + h * 256 + scc)); gb[i] = *(const u32x4*)(Z + zo(zr, 7 * 1024 + h * 256 + scc)); }
#pragma unroll
        for (int i = 0; i < 8; ++i) { const int r = sr + 16 * i; float hn[8], m8[8], s8[8], g8[8]; unpack8(*(LAS const u32x4*)(KVL + r * 264 + scc), hn); unpack8(ma[i], m8); unpack8(so[i], s8); unpack8(gb[i], g8);
#pragma unroll
            for (int j = 0; j < 8; ++j) hn[j] = m8[j] + sigm(g8[j]) * sigm(s8[j]) * hn[j] * ng[j];
            *(u32x4*)(H + (R0 + r) * 1024 + h * 256 + scc) = pack8(hn); } }
    lds_barrier();
}

__device__ __forceinline__ void phase_mix3(const Params& p, LAS unsigned char* lds) {
#pragma unroll 1
    for (int u = blockIdx.x; u < 512; u += gridDim.x) { const int c = u & 15, bh = u >> 4; out_prompt_unit(p, lds, bh >> 2, bh & 3, c); }
}

#define XB_TMO      128
#define XB_XCNT(j)  (256  + 64 * (j))
#define XB_XSUB(j)  (1280 + 64 * (j))
#define XB_XGEN(j)  (2304 + 64 * (j))
#define XB_TOP      3328
#define XB_TOPGEN   3392
#define XCD_BAR_WORDS 3456
#define XB_SPIN_CAP (1u << 18)
__device__ __forceinline__ unsigned xb_ld(unsigned* p)              { return __hip_atomic_load(p, __ATOMIC_RELAXED, __HIP_MEMORY_SCOPE_AGENT); }
__device__ __forceinline__ unsigned xb_add(unsigned* p, unsigned v) { return __hip_atomic_fetch_add(p, v, __ATOMIC_RELAXED, __HIP_MEMORY_SCOPE_AGENT); }
__device__ __forceinline__ unsigned xb_xcc_id() { return (unsigned)__builtin_amdgcn_s_getreg((3 << 11) | 20) & 0xFu; }
#define XB_SPIN(cond, bar) do { unsigned _sp = 0; while (cond) { __builtin_amdgcn_s_sleep(1); \
    if ((++_sp & 255u) == 0u) { if (xb_ld(&(bar)[XB_TMO])) break; if (_sp > XB_SPIN_CAP) { atomicAdd(&(bar)[XB_TMO], 1u); break; } } } } while (0)
struct XcdBarrier { unsigned* bar; unsigned x; volatile LAS unsigned* st; };
__device__ __forceinline__ XcdBarrier xcd_barrier_post(unsigned* bar, volatile LAS unsigned* st) {
    XcdBarrier b; b.bar = bar; b.x = xb_xcc_id(); b.st = st;
    if (threadIdx.x == 0) (void)xb_add(&bar[XB_XCNT(b.x)], 1u);
    return b;
}
__device__ __forceinline__ void xcd_barrier_complete(unsigned* bar, unsigned x, unsigned& nloc, unsigned& nx) {
    const unsigned G = gridDim.x * gridDim.y * gridDim.z;
    unsigned sum, cnt, mine, sp = 0u;
    for (;;) {
        sum = 0u; cnt = 0u; mine = 0u;
#pragma unroll
        for (unsigned j = 0; j < 16; ++j) { const unsigned c = xb_ld(&bar[XB_XCNT(j)]); sum += c; cnt += (c > 0u) ? 1u : 0u; mine = (j == x) ? c : mine; }
        if (sum == G) break;
        __builtin_amdgcn_s_sleep(1);
        if ((++sp & 255u) == 0u) { if (xb_ld(&bar[XB_TMO])) break; if (sp > XB_SPIN_CAP) { atomicAdd(&bar[XB_TMO], 1u); break; } }
    }
    nloc = mine > 0u ? mine : 1u; nx = cnt > 0u ? cnt : 1u;
}
__device__ __forceinline__ void xcd_barrier(const XcdBarrier& b) {
    asm volatile("s_waitcnt vmcnt(0)" ::: "memory");
    __syncthreads();
    if (threadIdx.x == 0) {
        unsigned* bar = b.bar;
        __builtin_amdgcn_s_waitcnt(0);
        unsigned nloc = b.st[0], nx = b.st[1];
        if (nloc == 0u) { xcd_barrier_complete(bar, b.x, nloc, nx); b.st[0] = nloc; b.st[1] = nx; }
        const unsigned old = xb_add(&bar[XB_XSUB(b.x)], 1u);
        const unsigned gen = old / nloc;
        if (old + 1u == (gen + 1u) * nloc) {
            __builtin_amdgcn_fence(__ATOMIC_RELEASE, "agent");
            asm volatile("s_waitcnt vmcnt(0)" ::: "memory");
            const unsigned og = xb_add(&bar[XB_TOP], 1u);
            const unsigned tg = og / nx;
            if (og + 1u == (tg + 1u) * nx) xb_add(&bar[XB_TOPGEN], 1u);
            else XB_SPIN(xb_ld(&bar[XB_TOPGEN]) == tg, bar);
            __builtin_amdgcn_fence(__ATOMIC_ACQUIRE, "agent");
            xb_add(&bar[XB_XGEN(b.x)], 1u);
            asm volatile("s_waitcnt vmcnt(0)" ::: "memory");
        } else {
            XB_SPIN(xb_ld(&bar[XB_XGEN(b.x)]) == gen, bar);
            __builtin_amdgcn_fence(__ATOMIC_ACQUIRE, "agent");
            asm volatile("s_waitcnt vmcnt(0)" ::: "memory");
        }
    }
    __syncthreads();
}

constexpr int NPHASE = 14;
__device__ __forceinline__ void run_phase(int ph, const Params& p, LAS unsigned char* lds) {
    unsigned char* ws = p.ws; const float* ADA = (const float*)(ws + W_ADA); float* X = p.out + O_Y;
    u16* H = (u16*)(ws + W_H); u16* ACT = (u16*)(ws + W_ACT);
    switch (ph) {
        case 0: phase_convert(p, lds, 1632, 2336, 0, (int)gridDim.x, true); break;
        case 1: { EpiF32B E; E.C = (float*)(ws + W_ADA); E.ldc = ADAC; E.bias = (const float*)(ws + W_BIAS); run_gemm(lds, (const u16*)(ws + W_CS), (const u16*)(ws + W_WBA), 256, ADAC, 1024, E);
                  const int nb = (int)gridDim.x - 44;
                  phase_convert(p, lds, 0, 7 * nb, 44, nb, false); phase_convert(p, lds, 7 * nb, 1632, 0, 44, false); } break;
        case 2: phase_prep<0>(p); break;
        case 3: { EpiSwiglu E; E.O = ACT; run_gemm(lds, H, (const u16*)(ws + W_WB1), MR, 5632, 1024, E); } break;
        case 4: { EpiResid<true> E; E.XinF = p.in[0]; E.XinB = nullptr; E.Xout = (u16*)p.out; E.XoutT = (float*)(ws + W_SLAB); E.gate = ADA + 2 * 1024; E.coef = 0.5f; E.ntf = FF / 64; E.pk = 8 * 64; run_gemm(lds, ACT, (const u16*)(ws + W_WB2), MR, 1024, FF, E, 5, 8, 4); } break;
        case 5: phase_prep<1>(p); break;
        case 6: { EpiZ E; E.O = (u16*)(ws + W_Z); E.vst = (float*)(ws + W_VST); run_gemm(lds, H, (const u16*)(ws + W_WB3), MR, ZC, 1024, E); } break;
        case 7: phase_mix1(p, lds); break;
        case 8: phase_mix2(p, lds); break;
        case 9: phase_mix3(p, lds); break;
        case 10: { EpiResid<false> E; E.XinF = nullptr; E.XinB = (const u16*)p.out; E.Xout = (u16*)(ws + W_X2); E.XoutT = (float*)(ws + W_SLAB); E.gate = ADA + 5 * 1024; E.coef = 1.0f; E.ntf = 16; E.pk = 4 * 64; run_gemm(lds, H, (const u16*)(ws + W_WB4), MR, 1024, 1024, E, 4, 4, 4); } break;
        case 11: phase_prep<2>(p); break;
        case 12: { EpiSwiglu E; E.O = ACT; run_gemm(lds, H, (const u16*)(ws + W_WB5), MR, 5632, 1024, E); } break;
        case 13: { EpiResid<false> E; E.XinF = nullptr; E.XinB = (const u16*)(ws + W_X2); E.Xout = (u16*)(ws + W_X3); E.XoutT = (float*)(ws + W_SLAB); E.gate = ADA + 8 * 1024; E.coef = 0.5f; E.ntf = FF / 64; E.pk = 8 * 64; run_gemm(lds, ACT, (const u16*)(ws + W_WB6), MR, 1024, FF, E, 5, 8, 4); } break;
        default: phase_prep<3>(p); break;
    }
}

#if FUSED
__global__ void __launch_bounds__(512, 2) mega_kernel(Params p) {
    extern __shared__ __attribute__((aligned(16))) unsigned char shm[];
    cg::grid_group grid = cg::this_grid();
    LAS unsigned char* lds = (LAS unsigned char*)shm;
    volatile LAS unsigned* st = (volatile LAS unsigned*)(lds + LDS_BYTES);
    if (threadIdx.x == 0) { st[0] = 0u; st[1] = 0u; st[2] = 0u; st[3] = 0u; }
    __syncthreads();
    const XcdBarrier xb = xcd_barrier_post((unsigned*)(p.ws + W_BAR), st);
    run_phase(0, p, lds); grid.sync();
    run_phase(1, p, lds); xcd_barrier(xb); run_phase(2, p, lds); xcd_barrier(xb); run_phase(3, p, lds); xcd_barrier(xb);
    run_phase(4, p, lds); xcd_barrier(xb); run_phase(5, p, lds); xcd_barrier(xb); run_phase(6, p, lds); xcd_barrier(xb); run_phase(7, p, lds); xcd_barrier(xb);
    run_phase(8, p, lds); xcd_barrier(xb); run_phase(9, p, lds); xcd_barrier(xb); run_phase(10, p, lds); xcd_barrier(xb); run_phase(11, p, lds); xcd_barrier(xb);
    run_phase(12, p, lds); xcd_barrier(xb); run_phase(13, p, lds); xcd_barrier(xb); run_phase(14, p, lds);
}
#else
template <int PH> __global__ void __launch_bounds__(512, 2) phase_kernel(Params p) {
    extern __shared__ __attribute__((aligned(16))) unsigned char shm[];
    run_phase(PH, p, (LAS unsigned char*)shm);
}
template <int PH> static void launch_phase(const Params& p, int grid, hipStream_t stream) {
    static bool attr = false;
    if (!attr) { hipFuncSetAttribute((const void*)phase_kernel<PH>, hipFuncAttributeMaxDynamicSharedMemorySize, LDS_BYTES); attr = true; }
    hipLaunchKernelGGL(phase_kernel<PH>, dim3(grid), dim3(512), LDS_BYTES, stream, p);
}
#endif

extern "C" void kernel_launch(void* const* d_in, const int* in_sizes, int n_in, void* d_out, int out_size, void* d_ws, size_t ws_size, hipStream_t stream) {
    static int grid = 0;
    if (grid == 0) {
        if (n_in != 30 || ws_size < W_END) { fprintf(stderr, "kernel_launch: need 30 inputs and %zu workspace bytes; got %d, %zu\n", (size_t)W_END, n_in, ws_size); grid = -1; return; }
        int dev = 0, cus = 0;
        hipGetDevice(&dev); hipDeviceGetAttribute(&cus, hipDeviceAttributeMultiprocessorCount, dev);
#if FUSED
        int per_cu = 0;
        hipFuncSetAttribute((const void*)mega_kernel, hipFuncAttributeMaxDynamicSharedMemorySize, LDS_BYTES + 16);
        hipOccupancyMaxActiveBlocksPerMultiprocessor(&per_cu, (const void*)mega_kernel, 512, LDS_BYTES + 16);
        if (per_cu < 1) { fprintf(stderr, "kernel_launch: occupancy query says %d blocks per CU\n", per_cu); grid = -1; return; }
        grid = cus;
#else
        grid = cus;
#endif
    }
    if (grid < 0) return;
    Params p{};
    for (int i = 0; i < 30; ++i) p.in[i] = (const float*)d_in[i];
    p.out = (float*)d_out; p.ws = (unsigned char*)d_ws;
#if FUSED
    hipMemsetAsync((unsigned char*)d_ws + W_BAR, 0, 16384, stream);
    void* args[] = {&p};
    hipError_t e = hipLaunchCooperativeKernel((const void*)mega_kernel, dim3(grid), dim3(512), args, LDS_BYTES + 16, stream);
    if (e != hipSuccess) fprintf(stderr, "cooperative launch failed: %s (grid %d)\n", hipGetErrorString(e), grid);
#else
    launch_phase<0>(p, grid, stream); launch_phase<1>(p, grid, stream); launch_phase<2>(p, grid, stream); launch_phase<3>(p, grid, stream); launch_phase<4>(p, grid, stream);
    launch_phase<5>(p, grid, stream); launch_phase<6>(p, grid, stream); launch_phase<7>(p, grid, stream); launch_phase<8>(p, grid, stream); launch_phase<9>(p, grid, stream);
    launch_phase<10>(p, grid, stream); launch_phase<11>(p, grid, stream); launch_phase<12>(p, grid, stream); launch_phase<13>(p, grid, stream); launch_phase<14>(p, grid, stream);
#endif
}
```

```cpp
#include <hip/hip_runtime.h>
#include <hip/hip_cooperative_groups.h>
#include <cstdio>
namespace cg = cooperative_groups;
#ifndef FUSED
#define FUSED 1
#endif
__device__ __forceinline__ int tid_opaque() { int t = (int)threadIdx.x; asm volatile("" : "+v"(t)); return t; }
namespace pg8 {
#define PG8_LAS __attribute__((address_space(3)))
typedef unsigned short bf16_t;
typedef short bf16x8 __attribute__((ext_vector_type(8)));
typedef float f32x4 __attribute__((ext_vector_type(4)));
typedef unsigned u32x4 __attribute__((ext_vector_type(4)));
constexpr int BM = 256, BK = 64, HALF = 128, HTB = HALF * BK * 2  , STAGE_BYTES = 8 * HTB, NXCD = 8, WGM = 8;

__host__ __device__ __forceinline__ int lds_byte(int r, int c) { const int st = (r >> 4) * 2 + (c >> 5), rr = r & 15, cc = c & 31, ob = rr * 64 + cc * 2; return st * 1024 + (ob ^ (((ob >> 9) & 1) << 5)); }
__host__ __device__ __forceinline__ void stage_rc(int b, int& R, int& C) { const int st = b / 1024, sb = b % 1024, swz = sb ^ (((sb >> 9) & 1) << 5); R = (st >> 1) * 16 + swz / 64; C = (st & 1) * 32 + (swz % 64) / 2; }
__host__ __device__ __forceinline__ int perm32(int rho) { const int n = rho >> 4, i = rho & 15; return 8 * (i >> 2) + 4 * n + (i & 3); }

struct Unit { int pm, pn, k0, nt; };
struct Gemm { const bf16_t* A; const bf16_t* Bt; int M, N, K; };

struct StaticOrder {
    int nM, nN, nwg, G, c, ntf, ppu, pnt, nMt;
    __host__ __device__ void init(int M, int N, int G_, int c_, int ntf_ = 0, int ppu_ = 0, int pnt_ = 0, int nMt_ = 0) { nM = M / BM - (ppu_ > 0 ? nMt_ : 0); nN = N / BM; nwg = nM * nN; G = G_; c = c_; ntf = ntf_; ppu = ppu_; pnt = pnt_; nMt = nMt_; }
    __host__ __device__ void map(int wgid, Unit& u) const {
        { const int q = nwg / NXCD, r = nwg % NXCD, xcd = wgid % NXCD, off = wgid / NXCD; wgid = (xcd < r ? xcd * (q + 1) : r * (q + 1) + (xcd - r) * q) + off; }
        const int nig = WGM * nN, gid = wgid / nig, fm = gid * WGM, gsz = (nM - fm) < WGM ? (nM - fm) : WGM;
        u.pm = fm + ((wgid % nig) % gsz); u.pn = (wgid % nig) / gsz;
    }
    __host__ __device__ bool next(int i, Unit& u) const {
        const long L = (long)i * G + c;
        if (L < nwg) { map((int)L, u); u.k0 = 0; u.nt = ntf; return true; }
        if (ppu == 0) return false;
        const int full = ((nwg + G - 1) / G) * G; if (L < full) return false;
        const int q = (int)(L - full); if (q >= nMt * nN * ppu) return false;
        const int pi = q % ppu, j = q / ppu; u.pm = nM + j % nMt; u.pn = j / nMt; u.k0 = pi * pnt * BK; u.nt = (pi == ppu - 1) ? ntf - pnt * (ppu - 1) : pnt; return true;
    }
    __device__ __forceinline__ void a_ready(const Unit&) const {}
    __device__ __forceinline__ void done(const Unit&) const {}
};
__device__ __forceinline__ unsigned cvt_pk_bf16(float lo, float hi) { unsigned r; asm volatile("v_cvt_pk_bf16_f32 %0, %1, %2" : "=v"(r) : "v"(lo), "v"(hi)); return r; }
template <class Epi, class Sched, bool STAMP = false>
__device__ __forceinline__ void gemm_phase(PG8_LAS unsigned char* lds, const Gemm g, const Sched& S, const Epi& E, unsigned long long* stamps) {
    const int tid = tid_opaque(), wid = __builtin_amdgcn_readfirstlane(tid >> 6), lane = tid & 63, wr = wid >> 2, wc = wid & 3, fr = lane & 15, fq = lane >> 4;
    const int K = g.K;
    int ts_lo = 0, ts_hi = 0, nts = 0; const unsigned long long rt_entry = STAMP ? (unsigned long long)wall_clock64() : 0ull;
#define PG8_STAMP() do { if (STAMP && wid == 0 && nts < 64) { const unsigned long long _c = (unsigned long long)clock64(); \
        ts_lo = (lane == nts) ? (int)(unsigned)_c : ts_lo; ts_hi = (lane == nts) ? (int)(unsigned)(_c >> 32) : ts_hi; ++nts; } } while (0)
    PG8_STAMP();
    unsigned voffA[2], voffB[2];
#pragma unroll
    for (int i = 0; i < 2; ++i) { int R, C; stage_rc(tid * 16 + i * 8192, R, C); const int Rb = Epi::PERM ? ((R & ~31) + perm32(R & 31)) : R;
        voffA[i] = (unsigned)(R * K + C) * 2u; voffB[i] = (unsigned)(Rb * K + C) * 2u; }
    const size_t kstep = (size_t)(BK * 2);
    const size_t hstep = (size_t)HALF * K * 2;
    const size_t tstep = 2 * hstep;
    const unsigned ldsw = (unsigned)wid * 1024u;
    const int aoff = lds_byte(wr * 64 + fr, fq * 8), boff = lds_byte(wc * 32 + fr, fq * 8);
#define PG8_SA(b, h) (((b) * 2 + (h)) * HTB)
#define PG8_SB(b, h) ((4 + (b) * 2 + (h)) * HTB)
#define PG8_STAGE(bufoff, gbase, voff) do { _Pragma("unroll") for (int _i = 0; _i < 2; ++_i) \
        __builtin_amdgcn_global_load_lds((const unsigned*)((const char*)(gbase) + (voff)[_i]), (PG8_LAS unsigned*)(lds + (bufoff) + ldsw + _i * 8192), 16, 0, 0); } while (0)
#define PG8_LDA(dst, b, h) do { _Pragma("unroll") for (int m = 0; m < 4; ++m) _Pragma("unroll") for (int k = 0; k < 2; ++k) dst[m][k] = *(const PG8_LAS bf16x8*)(lds + PG8_SA(b, h) + aoff + m * 2048 + k * 1024); } while (0)
#define PG8_LDB(dst, b, h) do { _Pragma("unroll") for (int n = 0; n < 2; ++n) _Pragma("unroll") for (int k = 0; k < 2; ++k) dst[n][k] = *(const PG8_LAS bf16x8*)(lds + PG8_SB(b, h) + boff + n * 2048 + k * 1024); } while (0)
#define PG8_MMA(ai, bj, At, Bt) do { __builtin_amdgcn_s_setprio(1); _Pragma("unroll") for (int m = 0; m < 4; ++m) _Pragma("unroll") for (int n = 0; n < 2; ++n) _Pragma("unroll") for (int k = 0; k < 2; ++k) \
        acc[ai][bj][m][n] = __builtin_amdgcn_mfma_f32_16x16x32_bf16(Bt[n][k], At[m][k], acc[ai][bj][m][n], 0, 0, 0); __builtin_amdgcn_s_setprio(0); } while (0)
#define PG8_WAIT_V(n) asm volatile("s_waitcnt vmcnt(" #n ")" ::: "memory")
#define PG8_WAIT_L(n) asm volatile("s_waitcnt lgkmcnt(" #n ")" ::: "memory")
#define PG8_BAR __builtin_amdgcn_s_barrier()
#define PG8_SCHED __builtin_amdgcn_sched_barrier(0)
    Unit cur, nxt; int ui = 0;
    if (!S.next(0, cur)) return;
    f32x4 acc[2][2][4][2];
#pragma unroll
    for (int a = 0; a < 2; ++a)
#pragma unroll
        for (int b = 0; b < 2; ++b)
#pragma unroll
            for (int m = 0; m < 4; ++m)
#pragma unroll
                for (int n = 0; n < 2; ++n) acc[a][b][m][n] = (f32x4){0.f, 0.f, 0.f, 0.f};
    bf16x8 At[4][2], B0[2][2], B1[2][2];
    const char* cA = (const char*)g.A + (size_t)cur.pm * tstep + (size_t)cur.k0 * 2; const char* cB = (const char*)g.Bt + (size_t)cur.pn * tstep + (size_t)cur.k0 * 2;
    S.a_ready(cur);
    PG8_STAGE(PG8_SB(0, 0), cB, voffB); PG8_STAGE(PG8_SA(0, 0), cA, voffA); PG8_STAGE(PG8_SB(0, 1), cB + hstep, voffB); PG8_STAGE(PG8_SA(0, 1), cA + hstep, voffA);
    if (wr == 1) PG8_BAR;
    PG8_WAIT_V(4); PG8_BAR;
    PG8_STAGE(PG8_SB(1, 0), cB + kstep, voffB); PG8_STAGE(PG8_SA(1, 0), cA + kstep, voffA); PG8_STAGE(PG8_SB(1, 1), cB + hstep + kstep, voffB);
    PG8_WAIT_V(6); PG8_BAR;
    PG8_STAMP();
    for (;;) {
        const bool has_next = S.next(ui + 1, nxt);
        const char* nA = has_next ? (const char*)g.A + (size_t)nxt.pm * tstep + (size_t)nxt.k0 * 2 : cA; const char* nB = has_next ? (const char*)g.Bt + (size_t)nxt.pn * tstep + (size_t)nxt.k0 * 2 : cB;
        const int nt = cur.nt;
        for (int t = 0; t < nt; t += 2) {
            const bool last = (t == nt - 2);
            const char* a1 = cA + (size_t)(t + 1) * kstep;
            const char* a2 = last ? nA : cA + (size_t)(t + 2) * kstep; const char* b2 = last ? nB : cB + (size_t)(t + 2) * kstep;
            const char* a3 = a2 + kstep; const char* b3 = b2 + kstep;
            if (last && has_next) S.a_ready(nxt);
            PG8_LDB(B0, 0, 0); PG8_SCHED; PG8_LDA(At, 0, 0); PG8_STAGE(PG8_SA(1, 1), a1 + hstep, voffA);
            PG8_WAIT_L(8); PG8_BAR; PG8_WAIT_L(0); PG8_MMA(0, 0, At, B0); PG8_BAR; PG8_SCHED;
            PG8_LDB(B1, 0, 1); PG8_STAGE(PG8_SB(0, 0), b2, voffB);
            PG8_BAR; PG8_WAIT_L(0); PG8_MMA(0, 1, At, B1); PG8_BAR;
            PG8_LDA(At, 0, 1); PG8_STAGE(PG8_SA(0, 0), a2, voffA);
            PG8_BAR; PG8_WAIT_L(0); PG8_MMA(1, 0, At, B0); PG8_BAR; PG8_SCHED;
            PG8_STAGE(PG8_SB(0, 1), b2 + hstep, voffB);
            PG8_WAIT_V(6); PG8_BAR; PG8_MMA(1, 1, At, B1); PG8_BAR;
            PG8_LDB(B0, 1, 0); PG8_SCHED; PG8_LDA(At, 1, 0); PG8_STAGE(PG8_SA(0, 1), a2 + hstep, voffA);
            PG8_WAIT_L(8); PG8_BAR; PG8_WAIT_L(0); PG8_MMA(0, 0, At, B0); PG8_BAR; PG8_SCHED;
            PG8_LDB(B1, 1, 1); PG8_STAGE(PG8_SB(1, 0), b3, voffB);
            PG8_BAR; PG8_WAIT_L(0); PG8_MMA(0, 1, At, B1); PG8_BAR;
            PG8_LDA(At, 1, 1); PG8_STAGE(PG8_SA(1, 0), a3, voffA);
            PG8_BAR; PG8_WAIT_L(0); PG8_MMA(1, 0, At, B0); PG8_BAR; PG8_SCHED;
            PG8_STAGE(PG8_SB(1, 1), b3 + hstep, voffB);
            PG8_WAIT_V(6); PG8_BAR; PG8_MMA(1, 1, At, B1); PG8_BAR;
        }
        PG8_STAMP();
        if constexpr (!Epi::AFTER_DRAIN) { E(acc, cur, wr, wc, fr, fq); S.done(cur); }
        PG8_STAMP();
        if (!has_next) break;
#pragma unroll
        for (int a = 0; a < 2; ++a)
#pragma unroll
            for (int b = 0; b < 2; ++b)
#pragma unroll
                for (int m = 0; m < 4; ++m)
#pragma unroll
                    for (int n = 0; n < 2; ++n) acc[a][b][m][n] = (f32x4){0.f, 0.f, 0.f, 0.f};
        cur = nxt; cA = nA; cB = nB; ++ui;
    }
    PG8_WAIT_V(0);
    if (wr == 0) PG8_BAR;
    PG8_BAR;
    if constexpr (Epi::AFTER_DRAIN) { E.fused(acc, cur, wr, wc, fr, fq, lds, wid, lane); S.done(cur); }
    PG8_STAMP();
    if (STAMP && wid == 0) { stamps[lane] = lane < nts ? (((unsigned long long)(unsigned)ts_hi << 32) | (unsigned)ts_lo) : 0ull;
        if (lane == 62) stamps[62] = rt_entry; if (lane == 63) stamps[63] = (unsigned long long)wall_clock64(); }
#undef PG8_STAMP
#undef PG8_SA
#undef PG8_SB
#undef PG8_STAGE
#undef PG8_LDA
#undef PG8_LDB
#undef PG8_MMA
#undef PG8_WAIT_V
#undef PG8_WAIT_L
#undef PG8_BAR
#undef PG8_SCHED
}
}

#define LAS __attribute__((address_space(3)))
typedef unsigned short u16;
typedef short bf16x8 __attribute__((ext_vector_type(8)));
typedef short s16x4 __attribute__((ext_vector_type(4)));
typedef float f32x4 __attribute__((ext_vector_type(4)));
typedef unsigned u32x4 __attribute__((ext_vector_type(4)));
typedef unsigned u32x2 __attribute__((ext_vector_type(2)));

constexpr int DM = 1024, NPR = 16384, NSR = 1024, MR = NPR + NSR, FF = 2816, ZC = 8192, ADAC = 11264;
constexpr int LDS_BYTES = 151552;
constexpr size_t W_WB1 = 0;
constexpr size_t W_WB2 = W_WB1 + (size_t)5632 * 1024 * 2;
constexpr size_t W_WB3 = W_WB2 + (size_t)1024 * 2816 * 2;
constexpr size_t W_WB4 = W_WB3 + (size_t)8192 * 1024 * 2;
constexpr size_t W_WB5 = W_WB4 + (size_t)1024 * 1024 * 2;
constexpr size_t W_WB6 = W_WB5 + (size_t)5632 * 1024 * 2;
constexpr size_t W_CS = W_WB6 + (size_t)1024 * 2816 * 2;
constexpr size_t W_BIAS = W_CS + (size_t)256 * 1024 * 2;
constexpr size_t W_WG = W_BIAS + (size_t)ADAC * 4;
constexpr size_t W_ADA = W_WG + (size_t)8 * 1024 * 4;
constexpr size_t W_H = W_ADA + (size_t)256 * ADAC * 4;
constexpr size_t W_GATES = W_H + (size_t)MR * 1024 * 2;
constexpr size_t W_BS = W_GATES + (size_t)MR * 8 * 4;
constexpr size_t W_AS = W_BS + (size_t)32 * 2048 * 4;
constexpr size_t W_CM = W_AS + (size_t)32 * 2048 * 4;
constexpr size_t W_MINIT = W_CM + (size_t)32 * 2048 * 4;
constexpr size_t W_NINIT = W_MINIT + 4096;
constexpr size_t W_Z = W_NINIT + (size_t)32 * 16 * 256 * 4;
constexpr size_t W_ACT = W_Z;
constexpr size_t W_SLAB = W_Z + (size_t)200 * 1024 * 1024;
constexpr size_t W_X3 = W_Z + (size_t)164 * 1024 * 1024;
constexpr size_t W_X2 = W_Z + (size_t)128 * 1024 * 1024;
constexpr size_t W_QB = W_Z + (size_t)MR * ZC * 2;
constexpr size_t W_KB = W_QB + (size_t)MR * 1024 * 2;
constexpr size_t W_CT = W_KB + (size_t)MR * 1024 * 2;
constexpr size_t W_WBA = W_CT;
constexpr size_t W_BAR = W_CT + (size_t)32 * 16 * 65536 * 2;
constexpr size_t W_VST = W_BAR + 16384;
constexpr size_t W_XS = W_VST + (size_t)MR * 32 * 4;
constexpr size_t W_END = W_XS + (size_t)NSR * 1024 * 4;
constexpr size_t O_Y = 0;
constexpr size_t O_CP = (size_t)MR * 1024;
constexpr size_t O_NP = O_CP + (size_t)8 * 4 * 65536;
constexpr size_t O_MP = O_NP + 8 * 4 * 256;
constexpr size_t O_CVP = O_MP + 32;
constexpr size_t O_CS = O_CVP + 8 * 3 * 2048;
constexpr size_t O_NS = O_CS + (size_t)128 * 4 * 65536;
constexpr size_t O_MS = O_NS + 128 * 4 * 256;
constexpr size_t O_CVS = O_MS + 512;
constexpr size_t O_VS = O_CVS + 128 * 3 * 2048;

struct Params { const float* in[30]; float* out; unsigned char* ws; };

__device__ __forceinline__ float bf2f(u16 b) { return __uint_as_float(((unsigned)b) << 16); }
__device__ __forceinline__ float bflo(unsigned w) { return __uint_as_float(w << 16); }
__device__ __forceinline__ float bfhi(unsigned w) { return __uint_as_float(w & 0xffff0000u); }
__device__ __forceinline__ unsigned pk2(float lo, float hi) { return pg8::cvt_pk_bf16(lo, hi); }
__device__ __forceinline__ float sigm(float x) { return __builtin_amdgcn_rcpf(1.0f + __builtin_amdgcn_exp2f(-1.4426950408889634f * x)); }
__device__ __forceinline__ float gelu_t(float x) { return x * sigm(1.5957691216057308f * (x + 0.044715f * x * x * x)); }
__device__ __forceinline__ size_t zo(size_t row, int col) { return ((size_t)(col >> 8) * MR + row) * 256 + (col & 255); }
__device__ __forceinline__ size_t qo(size_t row, int col) { return ((size_t)(col >> 8) * MR + row) * 256 + (col & 255); }
__device__ __forceinline__ int bidx(int row) { return row < NPR ? (row >> 11) : 8 + ((row - NPR) >> 3); }
__device__ __forceinline__ float wsum(float v) {
#pragma unroll
    for (int o = 32; o > 0; o >>= 1) v += __shfl_xor(v, o);
    return v;
}
__device__ __forceinline__ void unpack8(const u32x4 v, float* f) { f[0] = bflo(v.x); f[1] = bfhi(v.x); f[2] = bflo(v.y); f[3] = bfhi(v.y); f[4] = bflo(v.z); f[5] = bfhi(v.z); f[6] = bflo(v.w); f[7] = bfhi(v.w); }
__device__ __forceinline__ u32x4 pack8(const float* f) { u32x4 r; r.x = pk2(f[0], f[1]); r.y = pk2(f[2], f[3]); r.z = pk2(f[4], f[5]); r.w = pk2(f[6], f[7]); return r; }

__device__ __forceinline__ void lds_barrier() { asm volatile("s_waitcnt lgkmcnt(0)\n\ts_barrier" ::: "memory"); }
__device__ __forceinline__ bf16x8 frag_rm(LAS const u16* base, int stride, int r0, int k0, int lane) {
    return *(LAS const bf16x8*)(base + (r0 + (lane & 15)) * stride + k0 + (lane >> 4) * 8);
}
__device__ __forceinline__ bf16x8 frag_tr(LAS const u16* base, int stride, int n0, int k0, int lane) {
    const int g = lane >> 4, li = lane & 15, q = li >> 2, pp = li & 3;
    LAS const u16* a = base + (k0 + g * 8 + q) * stride + n0 + 4 * pp;
    const s16x4 lo = __builtin_amdgcn_ds_read_tr16_b64_v4i16((LAS s16x4*)a);
    const s16x4 hi = __builtin_amdgcn_ds_read_tr16_b64_v4i16((LAS s16x4*)(a + 4 * stride));
    return (bf16x8){lo[0], lo[1], lo[2], lo[3], hi[0], hi[1], hi[2], hi[3]};
}
#define MMA_T(acc, Bf, Af) acc = __builtin_amdgcn_mfma_f32_16x16x32_bf16(Bf, Af, acc, 0, 0, 0)

struct EpiF32B {
    static constexpr bool PERM = false, AFTER_DRAIN = false;
    float* C; int ldc; const float* bias;
    __device__ __forceinline__ void operator()(const f32x4 (&acc)[2][2][4][2], const pg8::Unit& u, int wr, int wc, int fr, int fq) const {
        const int row0 = u.pm * 256 + wr * 64 + fr, col0 = u.pn * 256 + wc * 32 + 4 * fq;
#pragma unroll
        for (int ai = 0; ai < 2; ++ai)
#pragma unroll
            for (int m = 0; m < 4; ++m) { float* rowp = C + (size_t)(row0 + ai * 128 + m * 16) * ldc + col0;
#pragma unroll
                for (int bj = 0; bj < 2; ++bj)
#pragma unroll
                    for (int n = 0; n < 2; ++n) *(f32x4*)(rowp + bj * 128 + n * 16) = acc[ai][bj][m][n] + *(const f32x4*)(bias + col0 + bj * 128 + n * 16); }
    }
};
struct EpiSwiglu {
    static constexpr bool PERM = true, AFTER_DRAIN = false;
    u16* O;
    __device__ __forceinline__ void operator()(const f32x4 (&acc)[2][2][4][2], const pg8::Unit& u, int wr, int wc, int fr, int fq) const {
        const int row0 = u.pm * 256 + wr * 64 + fr, col0 = u.pn * 128 + wc * 32 + 8 * fq;
#pragma unroll
        for (int ai = 0; ai < 2; ++ai)
#pragma unroll
            for (int m = 0; m < 4; ++m) { u16* rowp = O + (size_t)(row0 + ai * 128 + m * 16) * FF + col0;
                float o[8];
#pragma unroll
                for (int n = 0; n < 2; ++n)
#pragma unroll
                    for (int j = 0; j < 4; ++j) { const float a = acc[ai][0][m][n][j], b = acc[ai][1][m][n][j]; o[n * 4 + j] = a * sigm(a) * b; }
                *(u32x4*)rowp = pack8(o); }
    }
};
struct EpiZ {
    static constexpr bool PERM = true, AFTER_DRAIN = false;
    u16* O; float* vst;
    template <bool GELU> __device__ __forceinline__ void body(const f32x4 (&acc)[2][2][4][2], const pg8::Unit& u, int wr, int wc, int fr, int fq) const {
        const int row0 = u.pm * 256 + wr * 64 + fr, col0 = u.pn * 256 + wc * 32 + 8 * fq;
#pragma unroll
        for (int ai = 0; ai < 2; ++ai)
#pragma unroll
            for (int m = 0; m < 4; ++m) { u16* rowp = O + zo((size_t)(row0 + ai * 128 + m * 16), col0); float s1 = 0.f, s2 = 0.f;
#pragma unroll
                for (int bj = 0; bj < 2; ++bj) { float o[8];
#pragma unroll
                    for (int n = 0; n < 2; ++n)
#pragma unroll
                        for (int j = 0; j < 4; ++j) { const float v = acc[ai][bj][m][n][j]; o[n * 4 + j] = GELU ? gelu_t(v) : v; if (GELU) { s1 += o[n * 4 + j]; s2 += o[n * 4 + j] * o[n * 4 + j]; } }
                    *(u32x4*)(rowp + bj * 128) = pack8(o); }
                if (GELU) { s1 += __shfl_xor(s1, 16); s1 += __shfl_xor(s1, 32); s2 += __shfl_xor(s2, 16); s2 += __shfl_xor(s2, 32);
                    if (fq == 0) { float* q = vst + ((size_t)(row0 + ai * 128 + m * 16) * 16 + (u.pn & 3) * 4 + wc) * 2; q[0] = s1; q[1] = s2; } } }
    }
    __device__ __forceinline__ void operator()(const f32x4 (&acc)[2][2][4][2], const pg8::Unit& u, int wr, int wc, int fr, int fq) const {
        if ((u.pn >> 2) == 1) body<true>(acc, u, wr, wc, fr, fq); else body<false>(acc, u, wr, wc, fr, fq);
    }
};
template <bool XF32> struct EpiResid {
    static constexpr bool PERM = true, AFTER_DRAIN = false;
    const float* __restrict__ XinF; const u16* __restrict__ XinB; u16* __restrict__ Xout; float* __restrict__ XoutT; const float* __restrict__ gate; float coef; int ntf, pk;
    __device__ __forceinline__ void operator()(const f32x4 (&acc)[2][2][4][2], const pg8::Unit& u, int wr, int wc, int fr, int fq) const {
        const int row0 = u.pm * 256 + wr * 64 + fr, col0 = u.pn * 256 + wc * 32 + 8 * fq;
        if (u.nt == ntf) {
#pragma unroll
            for (int ai = 0; ai < 2; ++ai)
#pragma unroll
                for (int m = 0; m < 4; ++m) { const int row = row0 + ai * 128 + m * 16; const float* gp = gate + (size_t)bidx(row) * ADAC + col0;
#pragma unroll
                    for (int bj = 0; bj < 2; ++bj) { const int o = bj * 128; float x[8];
                        if (XF32) { const f32x4 a = *(const f32x4*)(XinF + (size_t)row * 1024 + col0 + o), b = *(const f32x4*)(XinF + (size_t)row * 1024 + col0 + o + 4);
#pragma unroll
                            for (int j = 0; j < 4; ++j) { x[j] = a[j]; x[4 + j] = b[j]; } }
                        else unpack8(*(const u32x4*)(XinB + (size_t)row * 1024 + col0 + o), x);
                        const f32x4 g0 = *(const f32x4*)(gp + o), g1 = *(const f32x4*)(gp + o + 4);
#pragma unroll
                        for (int j = 0; j < 4; ++j) { x[j] += coef * g0[j] * acc[ai][bj][m][0][j]; x[4 + j] += coef * g1[j] * acc[ai][bj][m][1][j]; }
                        *(u32x4*)(Xout + (size_t)row * 1024 + col0 + o) = pack8(x); } }
        } else {
            float* sl = XoutT + (size_t)(u.k0 / pk) * ((size_t)NSR * 1024);
#pragma unroll
            for (int ai = 0; ai < 2; ++ai)
#pragma unroll
                for (int m = 0; m < 4; ++m) { const int row = row0 + ai * 128 + m * 16;
                    const float* gp = gate + (size_t)bidx(row) * ADAC + col0; float* op = sl + (size_t)(row - NPR) * 1024 + col0;
#pragma unroll
                    for (int bj = 0; bj < 2; ++bj) { const int o = bj * 128;
                        *(f32x4*)(op + o) = coef * (*(const f32x4*)(gp + o)) * acc[ai][bj][m][0]; *(f32x4*)(op + o + 4) = coef * (*(const f32x4*)(gp + o + 4)) * acc[ai][bj][m][1]; } }
        }
    }
};
template <class Epi> __device__ __forceinline__ void run_gemm(LAS unsigned char* lds, const u16* A, const u16* Bt, int M, int N, int K, const Epi& E, int ppu = 0, int pnt = 0, int nMt = 0) {
    pg8::Gemm g; g.A = A; g.Bt = Bt; g.M = M; g.N = N; g.K = K;
    pg8::StaticOrder S; S.init(M, N, (int)gridDim.x, (int)blockIdx.x, K / 64, ppu, pnt, nMt);
    pg8::gemm_phase<Epi, pg8::StaticOrder, false>(lds, g, S, E, nullptr);
}

__device__ __forceinline__ void phase_convert(const Params& p, LAS unsigned char* lds, int t_begin, int t_end, int first_wg, int n_wg, bool extras) {
    const int tid = tid_opaque();
    LAS u16* T = (LAS u16*)lds;
    constexpr int NJ = 8;
    const int jn[NJ] = {5632, 1024, 8192, 1024, 5632, 1024, 9216, 2048};
    const int jk[NJ] = {1024, 2816, 1024, 1024, 1024, 2816, 1024, 1024};
    int total = 0;
#pragma unroll
    for (int j = 0; j < NJ; ++j) total += (jn[j] / 256) * (jk[j] / 64);
    (void)total;
    for (int t = t_begin + ((int)blockIdx.x - first_wg); (int)blockIdx.x >= first_wg && (int)blockIdx.x < first_wg + n_wg && t < t_end; t += n_wg) {
        int lt = t, job = 0;
#pragma unroll
        for (int j = 0; j < NJ - 1; ++j) { const int c = (jn[j] / 256) * (jk[j] / 64); if (job == j && lt >= c) { lt -= c; job = j + 1; } }
        const float* src; int ld, K, mode; u16* dst;
        switch (job) {
            case 0: src = p.in[11]; ld = 5632; K = 1024; mode = 1; dst = (u16*)(p.ws + W_WB1); break;
            case 1: src = p.in[12]; ld = 1024; K = 2816; mode = 0; dst = (u16*)(p.ws + W_WB2); break;
            case 2: src = p.in[14]; ld = 8200; K = 1024; mode = 2; dst = (u16*)(p.ws + W_WB3); break;
            case 3: src = p.in[23]; ld = 1024; K = 1024; mode = 0; dst = (u16*)(p.ws + W_WB4); break;
            case 4: src = p.in[25]; ld = 5632; K = 1024; mode = 1; dst = (u16*)(p.ws + W_WB5); break;
            case 5: src = p.in[26]; ld = 1024; K = 2816; mode = 0; dst = (u16*)(p.ws + W_WB6); break;
            case 6: src = p.in[8]; ld = 9216; K = 1024; mode = 0; dst = (u16*)(p.ws + W_WBA); break;
            default: src = p.in[27]; ld = 2048; K = 1024; mode = 0; dst = (u16*)(p.ws + W_WBA) + (size_t)9216 * 1024; break;
        }
        const int nk = K / 64, tn = lt / nk, tk = lt - tn * nk, n0 = tn * 256, k0 = tk * 64;
        const int c4 = (tid & 63) * 4, kr = tid >> 6;
        int sc;
        if (mode == 1) sc = (c4 < 128) ? tn * 128 + c4 : FF + tn * 128 + (c4 - 128);
        else if (mode == 2) sc = (n0 < 6144 ? n0 : n0 + 8) + c4;
        else sc = n0 + c4;
        f32x4 v[8];
#pragma unroll
        for (int i = 0; i < 8; ++i) v[i] = *(const f32x4*)(src + (size_t)(k0 + kr + 8 * i) * ld + sc);
#pragma unroll
        for (int i = 0; i < 8; ++i) { const int k = kr + 8 * i;
            const unsigned a = pk2(v[i][0], v[i][1]), b = pk2(v[i][2], v[i][3]);
            T[(c4 + 0) * 72 + k] = (u16)a; T[(c4 + 1) * 72 + k] = (u16)(a >> 16); T[(c4 + 2) * 72 + k] = (u16)b; T[(c4 + 3) * 72 + k] = (u16)(b >> 16); }
        __syncthreads();
#pragma unroll
        for (int i = 0; i < 4; ++i) { const int q = tid + 512 * i, n = q >> 3, k8 = (q & 7) * 8;
            *(u32x4*)(dst + (size_t)(n0 + n) * K + k0 + k8) = *(LAS const u32x4*)(T + n * 72 + k8); }
        __syncthreads();
    }
    if (!extras) return;
    const int gt = blockIdx.x * 512 + tid, gs = gridDim.x * 512;
    u16* CS = (u16*)(p.ws + W_CS);
    for (int i = gt; i < 256 * 1024; i += gs) { const int r = i >> 10, c = i & 1023; float v = 0.f;
        if (r < 8) v = p.in[2][r * 1024 + c]; else if (r < 136) v = p.in[3][(r - 8) * 1024 + c];
        v = v * sigm(v); CS[i] = (u16)(pk2(v, 0.f) & 0xffffu); }
    float* BIAS = (float*)(p.ws + W_BIAS);
    for (int i = gt; i < ADAC; i += gs) BIAS[i] = i < 9216 ? p.in[9][i] : p.in[28][i - 9216];
    float* WG = (float*)(p.ws + W_WG);
    for (int i = gt; i < 8192; i += gs) { const int j = i >> 10, k = i & 1023; WG[i] = p.in[14][(size_t)k * 8200 + 6144 + j]; }
}

template <int WHICH> __device__ __forceinline__ void phase_prep(const Params& p, LAS unsigned char* lds) {
    const int tid = tid_opaque(), lane = tid & 63, wid = tid >> 6;
    const float* ADA = (const float*)(p.ws + W_ADA);
    float* Y = p.out + O_Y;
    u16* H = (u16*)(p.ws + W_H);
    float* XS = (float*)(p.ws + W_XS);
    const float* gv = WHICH == 0 ? p.in[10] : WHICH == 1 ? p.in[13] : WHICH == 2 ? p.in[24] : p.in[29];
    const int jsh = WHICH == 3 ? 9 : 3 * WHICH, jsc = jsh + 1;
    LAS float* WGL = (LAS float*)lds;
    if (WHICH == 1) { const f32x4* wg = (const f32x4*)(p.ws + W_WG);
#pragma unroll
        for (int i = 0; i < 4; ++i) *(LAS f32x4*)(WGL + (tid + 512 * i) * 4) = wg[tid + 512 * i];
        lds_barrier(); }
    for (int row = blockIdx.x * 8 + wid; row < MR; row += gridDim.x * 8) {
        const float* ab = ADA + (size_t)bidx(row) * ADAC;
        float v[2][8]; float ss = 0.f;
#pragma unroll
        for (int i = 0; i < 2; ++i) { const int c = i * 512 + lane * 8;
            if (WHICH == 0) { const float* xr = (row < NPR ? p.in[0] + (size_t)row * 1024 : p.in[1] + (size_t)(row - NPR) * 1024) + c;
                const f32x4 a = *(const f32x4*)xr, b = *(const f32x4*)(xr + 4);
#pragma unroll
                for (int j = 0; j < 4; ++j) { v[i][j] = a[j]; v[i][4 + j] = b[j]; } }
            else if (row < NPR) { const u16* xb = WHICH == 1 ? (const u16*)p.out : WHICH == 2 ? (const u16*)(p.ws + W_X2) : (const u16*)(p.ws + W_X3);
                unpack8(*(const u32x4*)(xb + (size_t)row * 1024 + c), v[i]); }
            else {
                float* xs = XS + (size_t)(row - NPR) * 1024 + c; f32x4 a = *(const f32x4*)xs, b = *(const f32x4*)(xs + 4);
                const float* sl = (const float*)(p.ws + W_SLAB) + (size_t)(row - NPR) * 1024 + c;
#pragma unroll
                for (int pi = 0; pi < (WHICH == 2 ? 4 : 5); ++pi) { a += *(const f32x4*)(sl + (size_t)pi * NSR * 1024); b += *(const f32x4*)(sl + (size_t)pi * NSR * 1024 + 4); }
                if (WHICH < 3) { *(f32x4*)xs = a; *(f32x4*)(xs + 4) = b; }
#pragma unroll
                for (int j = 0; j < 4; ++j) { v[i][j] = a[j]; v[i][4 + j] = b[j]; } }
#pragma unroll
            for (int j = 0; j < 8; ++j) ss += v[i][j] * v[i][j]; }
        ss = wsum(ss);
        const float rstd = rsqrtf(ss * (1.0f / 1024.0f) + 1e-6f);
        float ga[8];
#pragma unroll
        for (int j = 0; j < 8; ++j) ga[j] = 0.f;
#pragma unroll
        for (int i = 0; i < 2; ++i) { const int c = i * 512 + lane * 8; float h[8];
#pragma unroll
            for (int q = 0; q < 2; ++q) { const f32x4 g4 = *(const f32x4*)(gv + c + 4 * q), s4 = *(const f32x4*)(ab + jsc * 1024 + c + 4 * q), h4 = *(const f32x4*)(ab + jsh * 1024 + c + 4 * q);
#pragma unroll
                for (int j = 0; j < 4; ++j) h[4 * q + j] = v[i][4 * q + j] * rstd * g4[j] * (1.0f + s4[j]) + h4[j]; }
            if (WHICH == 0 && row >= NPR) { float* xs = XS + (size_t)(row - NPR) * 1024 + c;
                *(f32x4*)xs = (f32x4){v[i][0], v[i][1], v[i][2], v[i][3]}; *(f32x4*)(xs + 4) = (f32x4){v[i][4], v[i][5], v[i][6], v[i][7]}; }
            if (WHICH == 3) { float* y = Y + (size_t)row * 1024 + c; *(f32x4*)y = (f32x4){h[0], h[1], h[2], h[3]}; *(f32x4*)(y + 4) = (f32x4){h[4], h[5], h[6], h[7]}; }
            else *(u32x4*)(H + (size_t)row * 1024 + c) = pack8(h);
            if (WHICH == 1) {
#pragma unroll
                for (int j = 0; j < 8; ++j) { const f32x4 w0 = *(LAS const f32x4*)(WGL + j * 1024 + c), w1 = *(LAS const f32x4*)(WGL + j * 1024 + c + 4);
                    ga[j] += h[0] * w0[0] + h[1] * w0[1] + h[2] * w0[2] + h[3] * w0[3] + h[4] * w1[0] + h[5] * w1[1] + h[6] * w1[2] + h[7] * w1[3]; } }
        }
        if (WHICH == 1) {
            float mine = 0.f;
#pragma unroll
            for (int j = 0; j < 8; ++j) { const float s = wsum(ga[j]); if (lane == j) mine = s; }
            if (lane < 8) ((float*)(p.ws + W_GATES))[(size_t)row * 8 + lane] = mine + p.in[15][lane];
        }
    }
}

__device__ __forceinline__ void gmlp_prompt_unit(const Params& p, LAS unsigned char* lds, int b, int c, int g) {
    const int tid = tid_opaque(), lane = tid & 63, wid = tid >> 6;
    LAS float* mu = (LAS float*)lds; LAS float* rs = mu + 128;
    LAS u16* WL = (LAS u16*)(lds + 1024);
    LAS u16* VL = (LAS u16*)(lds + 1024 + 34816);
    u16* Z = (u16*)(p.ws + W_Z);
    const size_t R0 = (size_t)b * 2048 + c * 128;
    if (tid < 128) { const f32x4* q = (const f32x4*)((const float*)(p.ws + W_VST) + (R0 + tid) * 32); float s = 0.f, ss = 0.f;
#pragma unroll
        for (int i = 0; i < 8; ++i) { const f32x4 v = q[i]; s += v[0] + v[2]; ss += v[1] + v[3]; }
        const float m = s * (1.0f / 1024.0f); const float var = fmaxf(ss * (1.0f / 1024.0f) - m * m, 0.f); mu[tid] = m; rs[tid] = rsqrtf(var + 1e-6f); }
    {   const float* w = p.in[20] + (size_t)g * 16384;
#pragma unroll
        for (int i = 0; i < 8; ++i) { const int q = tid + 512 * i, t = q >> 5, s = (q & 31) * 4; const f32x4 v = *(const f32x4*)(w + t * 128 + s);
            u32x2 o; o.x = pk2(s <= t ? v[0] : 0.f, s + 1 <= t ? v[1] : 0.f); o.y = pk2(s + 2 <= t ? v[2] : 0.f, s + 3 <= t ? v[3] : 0.f);
            *(LAS u32x2*)(WL + t * 136 + s) = o; } }
    lds_barrier();
    {   const int cc = (tid & 31) * 8; float lg[8], lb[8];
#pragma unroll
        for (int j = 0; j < 8; ++j) { lg[j] = p.in[18][g * 256 + cc + j]; lb[j] = p.in[19][g * 256 + cc + j]; }
        u32x4 vv[8];
#pragma unroll
        for (int i = 0; i < 8; ++i) { const int r = (tid + 512 * i) >> 5; vv[i] = *(const u32x4*)(Z + zo(R0 + r, 1024 + g * 256 + cc)); }
#pragma unroll
        for (int i = 0; i < 8; ++i) { const int r = (tid + 512 * i) >> 5; const float m = mu[r], rsd = rs[r]; float f[8]; unpack8(vv[i], f);
#pragma unroll
            for (int j = 0; j < 8; ++j) f[j] = (f[j] - m) * rsd * lg[j] + lb[j];
            *(LAS u32x4*)(VL + r * 264 + cc) = pack8(f); } }
    lds_barrier();
    f32x4 acc[8][2];
#pragma unroll
    for (int i = 0; i < 8; ++i) { acc[i][0] = (f32x4){0.f, 0.f, 0.f, 0.f}; acc[i][1] = (f32x4){0.f, 0.f, 0.f, 0.f}; }
#pragma unroll
    for (int kk = 0; kk < 4; ++kk) {
        const bf16x8 B0 = frag_tr(VL, 264, 32 * wid, 32 * kk, lane), B1 = frag_tr(VL, 264, 32 * wid + 16, 32 * kk, lane);
#pragma unroll
        for (int i = 0; i < 8; ++i) if (32 * kk <= 16 * i + 15) { const bf16x8 A = frag_rm(WL, 136, 16 * i, 32 * kk, lane); MMA_T(acc[i][0], B0, A); MMA_T(acc[i][1], B1, A); }
    }
    const int cc = (tid & 31) * 8;
    u32x4 gu[8], ga[8];
#pragma unroll
    for (int i = 0; i < 8; ++i) { const int r = (tid + 512 * i) >> 5; gu[i] = *(const u32x4*)(Z + zo(R0 + r, g * 256 + cc)); ga[i] = *(const u32x4*)(Z + zo(R0 + r, 6 * 1024 + g * 256 + cc)); }
    lds_barrier();
    const float* bs = p.in[21] + g * 128;
#pragma unroll
    for (int i = 0; i < 8; ++i) { const int t = 16 * i + (lane & 15); const float bsv = bs[t];
#pragma unroll
        for (int nn = 0; nn < 2; ++nn) { const int d = 32 * wid + 16 * nn + (lane >> 4) * 4;
            u32x2 o; o.x = pk2(acc[i][nn][0] + bsv, acc[i][nn][1] + bsv); o.y = pk2(acc[i][nn][2] + bsv, acc[i][nn][3] + bsv); *(LAS u32x2*)(VL + t * 264 + d) = o; } }
    lds_barrier();
#pragma unroll
    for (int i = 0; i < 8; ++i) { const int r = (tid + 512 * i) >> 5; float o[8], u8[8], a8[8]; unpack8(*(LAS const u32x4*)(VL + r * 264 + cc), o); unpack8(gu[i], u8); unpack8(ga[i], a8);
#pragma unroll
        for (int j = 0; j < 8; ++j) o[j] = sigm(a8[j]) * gelu_t(u8[j]) * o[j];
        *(u32x4*)(Z + zo(R0 + r, g * 256 + cc)) = pack8(o); }
    lds_barrier();
}

__device__ __forceinline__ void gmlp_sample_unit(const Params& p, LAS unsigned char* lds, int b) {
    const int tid = tid_opaque(), lane = tid & 63, wid = tid >> 6;
    LAS float* VS = (LAS float*)lds;
    u16* Z = (u16*)(p.ws + W_Z);
    const size_t r0 = (size_t)NPR + b * 8;
    {   const int t = wid; const u16* src = Z + zo(r0 + t, 1024 + lane * 16);
        float f[16]; unpack8(*(const u32x4*)src, f); unpack8(*(const u32x4*)(src + 8), f + 8);
        float s = 0.f, ss = 0.f;
#pragma unroll
        for (int j = 0; j < 16; ++j) { s += f[j]; ss += f[j] * f[j]; }
        s = wsum(s); ss = wsum(ss);
        const float m = s * (1.0f / 1024.0f), rsd = rsqrtf(fmaxf(ss * (1.0f / 1024.0f) - m * m, 0.f) + 1e-6f);
        float* vo = p.out + O_VS + ((size_t)b * 8 + t) * 1024 + lane * 16;
#pragma unroll
        for (int j = 0; j < 16; ++j) { const float v = (f[j] - m) * rsd * p.in[18][lane * 16 + j] + p.in[19][lane * 16 + j]; VS[t * 1024 + lane * 16 + j] = v; vo[j] = v; } }
    lds_barrier();
    {   const int c = tid * 2, g = c >> 8; const float* ws = p.in[20] + (size_t)g * 16384; const float* bs = p.in[21] + g * 128;
#pragma unroll
        for (int t = 0; t < 8; ++t) { float a0 = bs[t], a1 = a0;
#pragma unroll
            for (int s = 0; s <= t; ++s) { const float w = ws[t * 128 + s]; a0 += w * VS[s * 1024 + c]; a1 += w * VS[s * 1024 + c + 1]; }
            const size_t row = r0 + t; const unsigned gu = *(const unsigned*)(Z + zo(row, c)), ga = *(const unsigned*)(Z + zo(row, 6 * 1024 + c));
            *(unsigned*)(Z + zo(row, c)) = pk2(sigm(bflo(ga)) * gelu_t(bflo(gu)) * a0, sigm(bfhi(ga)) * gelu_t(bfhi(gu)) * a1); } }
    lds_barrier();
}

__device__ __forceinline__ void conv_unit(const Params& p, size_t rowbase, int nrows, int histmode, const float* hist, float* outconv) {
    const int tid = tid_opaque(), c4 = tid * 4;
    const u16* Z = (const u16*)(p.ws + W_Z);
    u16* dst = c4 < 1024 ? (u16*)(p.ws + W_QB) : (u16*)(p.ws + W_KB); const int dc = c4 & 1023;
    const float osc = c4 < 1024 ? 1.0f : 0.0625f;
    f32x4 w[4];
#pragma unroll
    for (int j = 0; j < 4; ++j) w[j] = *(const f32x4*)(p.in[16] + j * 2048 + c4);
    const f32x4 cb = *(const f32x4*)(p.in[17] + c4);
    f32x4 x[3];
#pragma unroll
    for (int j = 0; j < 3; ++j) {
        if (histmode == 0) x[j] = (f32x4){0.f, 0.f, 0.f, 0.f};
        else if (histmode == 1) { const u32x2 v = *(const u32x2*)(Z + zo(rowbase - 3 + j, 2048 + c4)); x[j] = (f32x4){bflo(v.x), bfhi(v.x), bflo(v.y), bfhi(v.y)}; }
        else x[j] = *(const f32x4*)(hist + j * 2048 + c4);
    }
#pragma unroll 8
    for (int t = 0; t < nrows; ++t) {
        const u32x2 v = *(const u32x2*)(Z + zo(rowbase + t, 2048 + c4));
        const f32x4 xv = (f32x4){bflo(v.x), bfhi(v.x), bflo(v.y), bfhi(v.y)};
        f32x4 y = cb + w[0] * x[0] + w[1] * x[1] + w[2] * x[2] + w[3] * xv;
        u32x2 o; o.x = pk2(y[0] * sigm(y[0]) * osc, y[1] * sigm(y[1]) * osc); o.y = pk2(y[2] * sigm(y[2]) * osc, y[3] * sigm(y[3]) * osc);
        *(u32x2*)(dst + qo(rowbase + t, dc)) = o;
        if (outconv && t >= nrows - 3) *(f32x4*)(outconv + (size_t)(t - (nrows - 3)) * 2048 + c4) = xv;
        x[0] = x[1]; x[1] = x[2]; x[2] = xv;
    }
}

__device__ __forceinline__ void conv_unit64(const Params& p, size_t rowbase, bool zero_hist, float* outconv) {
    const int tid = tid_opaque(), c8 = (tid & 255) * 8, rh = tid >> 8;
    const u16* Z = (const u16*)(p.ws + W_Z); const int zc = 2048 + c8;
    u16* dst = c8 < 1024 ? (u16*)(p.ws + W_QB) : (u16*)(p.ws + W_KB); const int dc = c8 & 1023;
    const float osc = c8 < 1024 ? 1.0f : 0.0625f;
    float w[4][8], cb[8], x[3][8];
#pragma unroll
    for (int j = 0; j < 4; ++j) { const f32x4 a = *(const f32x4*)(p.in[16] + j * 2048 + c8), b = *(const f32x4*)(p.in[16] + j * 2048 + c8 + 4);
#pragma unroll
        for (int e = 0; e < 4; ++e) { w[j][e] = a[e]; w[j][4 + e] = b[e]; } }
    {   const f32x4 a = *(const f32x4*)(p.in[17] + c8), b = *(const f32x4*)(p.in[17] + c8 + 4);
#pragma unroll
        for (int e = 0; e < 4; ++e) { cb[e] = a[e]; cb[4 + e] = b[e]; } }
    const size_t r0 = rowbase + 32 * rh;
    u32x4 cur[8], nxt[8];
#pragma unroll
    for (int i = 0; i < 8; ++i) cur[i] = *(const u32x4*)(Z + zo(r0 + i, zc));
#pragma unroll
    for (int j = 0; j < 3; ++j) {
        if (zero_hist && rh == 0) {
#pragma unroll
            for (int e = 0; e < 8; ++e) x[j][e] = 0.f; }
        else unpack8(*(const u32x4*)(Z + zo(r0 - 3 + j, zc)), x[j]);
    }
#pragma unroll
    for (int blk = 0; blk < 4; ++blk) {
        if (blk < 3) {
#pragma unroll
            for (int i = 0; i < 8; ++i) nxt[i] = *(const u32x4*)(Z + zo(r0 + 8 * (blk + 1) + i, zc)); }
#pragma unroll
        for (int i = 0; i < 8; ++i) { const int t = 8 * blk + i; float xv[8], o[8]; unpack8(cur[i], xv);
#pragma unroll
            for (int e = 0; e < 8; ++e) { const float y = cb[e] + w[0][e] * x[0][e] + w[1][e] * x[1][e] + w[2][e] * x[2][e] + w[3][e] * xv[e]; o[e] = y * sigm(y) * osc; }
            *(u32x4*)(dst + qo(r0 + t, dc)) = pack8(o);
            if (outconv && rh == 1 && t >= 29) { float* oc = outconv + (size_t)(t - 29) * 2048 + c8; *(f32x4*)oc = (f32x4){xv[0], xv[1], xv[2], xv[3]}; *(f32x4*)(oc + 4) = (f32x4){xv[4], xv[5], xv[6], xv[7]}; }
#pragma unroll
            for (int e = 0; e < 8; ++e) { x[0][e] = x[1][e]; x[1][e] = x[2][e]; x[2][e] = xv[e]; } }
        if (blk < 3) {
#pragma unroll
            for (int i = 0; i < 8; ++i) cur[i] = nxt[i]; }
    }
}

__device__ __forceinline__ void phase_mix1(const Params& p, LAS unsigned char* lds) {
    for (int u = blockIdx.x; u < 1024; u += gridDim.x) {
        if (u < 512) gmlp_prompt_unit(p, lds, u >> 6, (u >> 2) & 15, u & 3);
        else if (u < 768) { const int v = u - 512, b = v >> 5, hc = v & 31; conv_unit64(p, (size_t)b * 2048 + hc * 64, hc == 0, hc == 31 ? p.out + O_CVP + (size_t)b * 6144 : nullptr); }
        else if (u < 896) gmlp_sample_unit(p, lds, u - 768);
        else { const int b = u - 896; conv_unit(p, (size_t)NPR + b * 8, 8, 2, p.in[7] + (size_t)b * 6144, p.out + O_CVS + (size_t)b * 6144); }
    }
}

__device__ __forceinline__ float logsig(float f) { return fminf(f, 0.f) - log1pf(__expf(-fabsf(f))); }

__device__ __forceinline__ void scan_prompt_unit(const Params& p, LAS unsigned char* lds, int b, int h, int slab) {
    const int tid = tid_opaque(), lane = tid & 63, wid = tid >> 6, bh = b * 4 + h;
    LAS float* ASl = (LAS float*)lds;
    LAS float* Mc = ASl + 2048;
    LAS float* mi = Mc + 16;
    LAS float* bL = mi + 16;
    LAS float* amx = bL + 16;
    LAS u16* KL = (LAS u16*)(lds + 16384);
    LAS u16* VWL = (LAS u16*)(lds + 16384 + 67584);
    const float* GATES = (const float*)(p.ws + W_GATES);
    const u16* Z = (const u16*)(p.ws + W_Z); const u16* KB = (const u16*)(p.ws + W_KB);
    u16* CT = (u16*)(p.ws + W_CT);
    const size_t Rb = (size_t)b * 2048;
    u32x4 kreg[8], vreg[2];
    const int vr = tid >> 2, vcc = (tid & 3) * 16;
#pragma unroll
    for (int i = 0; i < 8; ++i) { const int q = tid + 512 * i, r = q >> 5, cc = (q & 31) * 8; kreg[i] = *(const u32x4*)(KB + qo(Rb + r, h * 256 + cc)); }
    vreg[0] = *(const u32x4*)(Z + zo(Rb + vr, 4096 + h * 256 + slab * 64 + vcc)); vreg[1] = *(const u32x4*)(Z + zo(Rb + vr, 4096 + h * 256 + slab * 64 + vcc + 8));
    {   const int p0 = tid * 4; float iv[4], bv[4], av[4], cm[4];
        float run = 0.f;
#pragma unroll
        for (int j = 0; j < 4; ++j) { const float* gp = GATES + (Rb + p0 + j) * 8; iv[j] = gp[h]; run += logsig(gp[4 + h]); bv[j] = run; }
        float sc = run;
#pragma unroll
        for (int d = 1; d < 32; d <<= 1) { const float o = __shfl_up(sc, d, 32); if ((lane & 31) >= d) sc += o; }
        const float off = sc - run;
        float rm = -INFINITY;
#pragma unroll
        for (int j = 0; j < 4; ++j) { bv[j] += off; av[j] = iv[j] - bv[j]; rm = fmaxf(rm, av[j]); cm[j] = rm; }
        float sm = rm;
#pragma unroll
        for (int d = 1; d < 32; d <<= 1) { const float o = __shfl_up(sm, d, 32); if ((lane & 31) >= d) sm = fmaxf(sm, o); }
        float em = __shfl_up(sm, 1, 32); if ((lane & 31) == 0) em = -INFINITY;
#pragma unroll
        for (int j = 0; j < 4; ++j) { cm[j] = fmaxf(cm[j], em); ASl[p0 + j] = av[j]; }
        if (slab == 0) {
            *(f32x4*)((float*)(p.ws + W_BS) + (size_t)bh * 2048 + p0) = (f32x4){bv[0], bv[1], bv[2], bv[3]};
            *(f32x4*)((float*)(p.ws + W_AS) + (size_t)bh * 2048 + p0) = (f32x4){av[0], av[1], av[2], av[3]};
            *(f32x4*)((float*)(p.ws + W_CM) + (size_t)bh * 2048 + p0) = (f32x4){cm[0], cm[1], cm[2], cm[3]}; }
        if ((lane & 31) == 31) { bL[p0 >> 7] = bv[3]; amx[p0 >> 7] = cm[3]; } }
    lds_barrier();
    if (tid == 0) { float m = 0.f;
        for (int c = 0; c < 16; ++c) { mi[c] = m; const float M = fmaxf(m, amx[c]); Mc[c] = M; if (slab == 0) ((float*)(p.ws + W_MINIT))[bh * 16 + c] = m; m = bL[c] + M; }
        if (slab == 0) p.out[O_MP + bh] = m; }
    lds_barrier();
    f32x4 acc[5][2];
#pragma unroll
    for (int i = 0; i < 5; ++i) { acc[i][0] = (f32x4){0.f, 0.f, 0.f, 0.f}; acc[i][1] = (f32x4){0.f, 0.f, 0.f, 0.f}; }
    for (int c = 0; c < 16; ++c) {
        const float M = Mc[c], ap = __expf(mi[c] - M);
        const float w = __expf(ASl[c * 128 + vr] - M);
#pragma unroll
        for (int i = 0; i < 8; ++i) { const int q = tid + 512 * i, r = q >> 5, cc = (q & 31) * 8; *(LAS u32x4*)(KL + r * 264 + cc) = kreg[i]; }
        {   float f[8];
#pragma unroll
            for (int q = 0; q < 2; ++q) { unpack8(vreg[q], f);
#pragma unroll
                for (int j = 0; j < 8; ++j) f[j] *= w;
                *(LAS u32x4*)(VWL + vr * 88 + vcc + 8 * q) = pack8(f); }
            if ((tid & 3) == 0) { u32x4 e; e.x = pk2(w, 0.f); e.y = 0u; e.z = 0u; e.w = 0u; *(LAS u32x4*)(VWL + vr * 88 + 64) = e; e.x = 0u; *(LAS u32x4*)(VWL + vr * 88 + 72) = e; } }
        lds_barrier();
        if (c < 15) { const size_t R1 = Rb + (c + 1) * 128;
#pragma unroll
            for (int i = 0; i < 8; ++i) { const int q = tid + 512 * i, r = q >> 5, cc = (q & 31) * 8; kreg[i] = *(const u32x4*)(KB + qo(R1 + r, h * 256 + cc)); }
            vreg[0] = *(const u32x4*)(Z + zo(R1 + vr, 4096 + h * 256 + slab * 64 + vcc)); vreg[1] = *(const u32x4*)(Z + zo(R1 + vr, 4096 + h * 256 + slab * 64 + vcc + 8)); }
#pragma unroll
        for (int i = 0; i < 5; ++i) { acc[i][0] *= ap; acc[i][1] *= ap; }
#pragma unroll
        for (int kk = 0; kk < 4; ++kk) {
            const bf16x8 B0 = frag_tr(KL, 264, 32 * wid, 32 * kk, lane), B1 = frag_tr(KL, 264, 32 * wid + 16, 32 * kk, lane);
#pragma unroll
            for (int et = 0; et < 4; ++et) { const bf16x8 A = frag_tr(VWL, 88, 16 * et, 32 * kk, lane); MMA_T(acc[et][0], B0, A); MMA_T(acc[et][1], B1, A); }
            if (slab == 0) { const bf16x8 A4 = frag_tr(VWL, 88, 64, 32 * kk, lane); MMA_T(acc[4][0], B0, A4); MMA_T(acc[4][1], B1, A4); }
        }
        if (c < 15) {
#pragma unroll
            for (int et = 0; et < 4; ++et)
#pragma unroll
                for (int dt = 0; dt < 2; ++dt) { const int e = slab * 64 + 16 * et + (lane & 15), d = 32 * wid + 16 * dt + (lane >> 4) * 4;
                    u32x2 o; o.x = pk2(acc[et][dt][0], acc[et][dt][1]); o.y = pk2(acc[et][dt][2], acc[et][dt][3]);
                    *(u32x2*)(CT + (((size_t)bh * 16 + c + 1) * 256 + e) * 256 + d) = o; }
            if (slab == 0 && (lane & 15) == 0) {
#pragma unroll
                for (int dt = 0; dt < 2; ++dt) { const int d = 32 * wid + 16 * dt + (lane >> 4) * 4; *(f32x4*)((float*)(p.ws + W_NINIT) + ((size_t)bh * 16 + c + 1) * 256 + d) = acc[4][dt]; } } }
        lds_barrier();
    }
#pragma unroll
    for (int et = 0; et < 4; ++et)
#pragma unroll
        for (int dt = 0; dt < 2; ++dt) { const int e = slab * 64 + 16 * et + (lane & 15), d = 32 * wid + 16 * dt + (lane >> 4) * 4;
#pragma unroll
            for (int j = 0; j < 4; ++j) p.out[O_CP + ((size_t)bh * 256 + d + j) * 256 + e] = acc[et][dt][j]; }
    if (slab == 0 && (lane & 15) == 0) {
#pragma unroll
        for (int dt = 0; dt < 2; ++dt) { const int d = 32 * wid + 16 * dt + (lane >> 4) * 4; *(f32x4*)(p.out + O_NP + (size_t)bh * 256 + d) = acc[4][dt]; } }
    lds_barrier();
}

__device__ __forceinline__ void sample_unit(const Params& p, LAS unsigned char* lds, int b, int h) {
    const int tid = tid_opaque(), lane = tid & 63, wid = tid >> 6, bh = b * 4 + h;
    LAS float* QF = (LAS float*)lds;
    LAS float* KF = QF + 2048;
    LAS float* KWF = KF + 2048;
    LAS float* VF = KWF + 2048;
    LAS float* NUM = VF + 2048;
    LAS float* SC = NUM + 16384;
    LAS float* QN = SC + 64;
    LAS float* sa = QN + 8;
    LAS float* sM = sa + 8;
    LAS float* swi = sM + 8;
    LAS float* semt = swi + 8;
    LAS float* sw7 = semt + 8;
    LAS float* sden = sw7 + 8;
    LAS float* smisc = sden + 8;
    const float* GATES = (const float*)(p.ws + W_GATES);
    const u16* Z = (const u16*)(p.ws + W_Z); const u16* QB = (const u16*)(p.ws + W_QB); const u16* KB = (const u16*)(p.ws + W_KB);
    const size_t r0 = (size_t)NPR + b * 8;
    const float m0 = p.in[6][bh];
    const int e4 = lane * 4, dg = wid * 32;
    const float* C0 = p.in[4] + (size_t)bh * 65536 + e4; float* Co = p.out + O_CS + (size_t)bh * 65536 + e4;
    f32x4 cpre[4];
#pragma unroll
    for (int u = 0; u < 4; ++u) cpre[u] = __builtin_nontemporal_load((const f32x4*)(C0 + (size_t)(dg + u) * 256));
    if (tid == 0) { float bc = 0.f, cm = -INFINITY; float a[8];
        for (int t = 0; t < 8; ++t) { const float* gp = GATES + (r0 + t) * 8; bc += logsig(gp[4 + h]); a[t] = gp[h] - bc; cm = fmaxf(cm, a[t]); const float M = fmaxf(m0, cm);
            sa[t] = a[t]; sM[t] = M; swi[t] = __expf(m0 - M); semt[t] = __expf(-(bc + M)); if (t == 7) { smisc[0] = __expf(m0 - M); smisc[1] = bc + M; } }
        const float M7 = sM[7];
        for (int s = 0; s < 8; ++s) sw7[s] = __expf(a[s] - M7); }
    {   const int t = tid >> 6, d4 = (tid & 63) * 4;
        const u32x2 q = *(const u32x2*)(QB + qo(r0 + t, h * 256 + d4)), k = *(const u32x2*)(KB + qo(r0 + t, h * 256 + d4)), v = *(const u32x2*)(Z + zo(r0 + t, 4096 + h * 256 + d4));
        QF[(d4 + 0) * 8 + t] = bflo(q.x); QF[(d4 + 1) * 8 + t] = bfhi(q.x); QF[(d4 + 2) * 8 + t] = bflo(q.y); QF[(d4 + 3) * 8 + t] = bfhi(q.y);
        KF[(d4 + 0) * 8 + t] = bflo(k.x); KF[(d4 + 1) * 8 + t] = bfhi(k.x); KF[(d4 + 2) * 8 + t] = bflo(k.y); KF[(d4 + 3) * 8 + t] = bfhi(k.y);
        *(LAS f32x4*)(VF + t * 256 + d4) = (f32x4){bflo(v.x), bfhi(v.x), bflo(v.y), bfhi(v.y)}; }
    lds_barrier();
    {   const int pair = tid >> 3, t = pair >> 3, s = pair & 7, sub = tid & 7; float dot = 0.f, qn = 0.f;
        const float* n0 = p.in[5] + (size_t)bh * 256;
#pragma unroll 8
        for (int i = 0; i < 32; ++i) { const int d = sub * 32 + i; const float q = QF[d * 8 + t]; dot += q * KF[d * 8 + s]; qn += q * n0[d]; }
        dot += __shfl_xor(dot, 1); dot += __shfl_xor(dot, 2); dot += __shfl_xor(dot, 4);
        qn += __shfl_xor(qn, 1); qn += __shfl_xor(qn, 2); qn += __shfl_xor(qn, 4);
        if (sub == 0) { SC[t * 8 + s] = s <= t ? dot * __expf(fminf(sa[s] - sM[t], 0.f)) : 0.f; if (s == 0) QN[t] = qn; }
        const int d = tid >> 1, s4 = (tid & 1) * 4;
#pragma unroll
        for (int j = 0; j < 4; ++j) KWF[d * 8 + s4 + j] = KF[d * 8 + s4 + j] * sw7[s4 + j]; }
    lds_barrier();
    if (tid < 8) { float dn = swi[tid] * QN[tid];
        for (int s = 0; s < 8; ++s) dn += SC[tid * 8 + s];
        sden[tid] = dn; }
    const float ap = smisc[0];
    {   f32x4 vv[8], num[8];
#pragma unroll
        for (int s = 0; s < 8; ++s) { vv[s] = *(LAS const f32x4*)(VF + s * 256 + e4); num[s] = (f32x4){0.f, 0.f, 0.f, 0.f}; }
#pragma unroll 1
        for (int i = 0; i < 32; i += 4) {
            f32x4 cnx[4];
            if (i + 4 < 32) {
#pragma unroll
                for (int u = 0; u < 4; ++u) cnx[u] = __builtin_nontemporal_load((const f32x4*)(C0 + (size_t)(dg + i + 4 + u) * 256)); }
#pragma unroll
            for (int u = 0; u < 4; ++u) { const int d = dg + i + u; const f32x4 c0 = cpre[u];
                const f32x4 q0 = *(LAS const f32x4*)(QF + d * 8), q1 = *(LAS const f32x4*)(QF + d * 8 + 4), k0 = *(LAS const f32x4*)(KWF + d * 8), k1 = *(LAS const f32x4*)(KWF + d * 8 + 4);
                f32x4 cn = ap * c0;
#pragma unroll
                for (int j = 0; j < 4; ++j) { num[j] += q0[j] * c0; num[4 + j] += q1[j] * c0; cn += k0[j] * vv[j] + k1[j] * vv[4 + j]; }
                __builtin_nontemporal_store(cn, (f32x4*)(Co + (size_t)d * 256)); }
            if (i + 4 < 32) {
#pragma unroll
                for (int u = 0; u < 4; ++u) cpre[u] = cnx[u]; }
        }
#pragma unroll
        for (int t = 0; t < 8; ++t) *(LAS f32x4*)(NUM + (wid * 8 + t) * 256 + e4) = num[t];
        if (tid < 256) { const int d = tid; float s = ap * p.in[5][(size_t)bh * 256 + d];
#pragma unroll
            for (int j = 0; j < 8; ++j) s += KWF[d * 8 + j];
            p.out[O_NS + (size_t)bh * 256 + d] = s; }
        if (tid == 0) p.out[O_MS + bh] = smisc[1]; }
    lds_barrier();
    {   const int t = wid; const float wi = swi[t], dn = fmaxf(fabsf(sden[t]), semt[t]);
        f32x4 n = (f32x4){0.f, 0.f, 0.f, 0.f};
#pragma unroll
        for (int g = 0; g < 8; ++g) n += *(LAS const f32x4*)(NUM + (g * 8 + t) * 256 + e4);
        n *= wi;
#pragma unroll
        for (int s = 0; s < 8; ++s) n += SC[t * 8 + s] * (*(LAS const f32x4*)(VF + s * 256 + e4));
        float hv[4]; float s1 = 0.f, s2 = 0.f;
#pragma unroll
        for (int j = 0; j < 4; ++j) { hv[j] = n[j] / dn; s1 += hv[j]; s2 += hv[j] * hv[j]; }
        s1 = wsum(s1); s2 = wsum(s2);
        const float mean = s1 * (1.0f / 256.0f), rstd = rsqrtf(fmaxf(s2 * (1.0f / 256.0f) - mean * mean, 0.f) + 1e-6f);
        const size_t row = r0 + t; const int col = h * 256 + e4;
        const u32x2 ma = *(const u32x2*)(Z + zo(row, col)), so = *(const u32x2*)(Z + zo(row, 5 * 1024 + col)), gb = *(const u32x2*)(Z + zo(row, 7 * 1024 + col));
        const f32x4 ng = *(const f32x4*)(p.in[22] + col);
        const float o0 = bflo(ma.x) + sigm(bflo(gb.x)) * sigm(bflo(so.x)) * (hv[0] - mean) * rstd * ng[0], o1 = bfhi(ma.x) + sigm(bfhi(gb.x)) * sigm(bfhi(so.x)) * (hv[1] - mean) * rstd * ng[1];
        const float o2 = bflo(ma.y) + sigm(bflo(gb.y)) * sigm(bflo(so.y)) * (hv[2] - mean) * rstd * ng[2], o3 = bfhi(ma.y) + sigm(bfhi(gb.y)) * sigm(bfhi(so.y)) * (hv[3] - mean) * rstd * ng[3];
        u32x2 o; o.x = pk2(o0, o1); o.y = pk2(o2, o3); *(u32x2*)((u16*)(p.ws + W_H) + row * 1024 + col) = o; }
    lds_barrier();
}

__device__ __forceinline__ void phase_mix2(const Params& p, LAS unsigned char* lds) {
    const int nscan = (int)gridDim.x / 2;
    if ((int)blockIdx.x < nscan) {
#pragma unroll 1
        for (int u = blockIdx.x; u < 128; u += nscan) { const int x = u & 7, j = u >> 3, bh = x * 4 + (j >> 2);
            scan_prompt_unit(p, lds, bh >> 2, bh & 3, j & 3); }
    }
    unsigned* ctr = (unsigned*)(p.ws + W_BAR) + 3584;
    LAS unsigned* slot = (LAS unsigned*)(lds + LDS_BYTES) + 2;
#pragma unroll 1
    for (;;) {
        if (tid_opaque() == 0) *slot = __hip_atomic_fetch_add(ctr, 1u, __ATOMIC_RELAXED, __HIP_MEMORY_SCOPE_AGENT);
        lds_barrier();
        const unsigned v = *slot;
        lds_barrier();
        if (v >= 512u) break;
        sample_unit(p, lds, (int)(v >> 2), (int)(v & 3));
    }
}

__device__ __forceinline__ void out_prompt_unit(const Params& p, LAS unsigned char* lds, int b, int h, int c) {
    const int tid = tid_opaque(), lane = tid & 63, wid = __builtin_amdgcn_readfirstlane(tid >> 6), bh = b * 4 + h;
    LAS u16* QL = (LAS u16*)lds;
    LAS u16* KVL = (LAS u16*)(lds + 67584);
    LAS float* al = (LAS float*)(lds + 135168);
    LAS float* Ml = al + 128;
    LAS float* wil = Ml + 128;
    LAS float* emtl = wil + 128;
    LAS float* RS = emtl + 128;
    LAS float* DEN = RS + 1024;
    LAS float* QN = DEN + 128;
    LAS float* nin = QN + 128;
    LAS float* LNS = nin + 256;
    const u16* Z = (const u16*)(p.ws + W_Z); const u16* QB = (const u16*)(p.ws + W_QB); const u16* KB = (const u16*)(p.ws + W_KB);
    const u16* CT = (const u16*)(p.ws + W_CT);
    const size_t R0 = (size_t)b * 2048 + c * 128;
    const int sr = tid >> 5, scc = (tid & 31) * 8;
    u32x4 vreg[8];
#pragma unroll
    for (int i = 0; i < 8; ++i) { const int r = sr + 16 * i;
        *(LAS u32x4*)(QL + r * 264 + scc) = *(const u32x4*)(QB + qo(R0 + r, h * 256 + scc));
        *(LAS u32x4*)(KVL + r * 264 + scc) = *(const u32x4*)(KB + qo(R0 + r, h * 256 + scc)); }
#pragma unroll
    for (int i = 0; i < 8; ++i) vreg[i] = *(const u32x4*)(Z + zo(R0 + sr + 16 * i, 4096 + h * 256 + scc));
    if (tid < 128) { const size_t gi = (size_t)bh * 2048 + c * 128 + tid; const float a = ((const float*)(p.ws + W_AS))[gi], cm = ((const float*)(p.ws + W_CM))[gi], bt = ((const float*)(p.ws + W_BS))[gi];
        const float mi = ((const float*)(p.ws + W_MINIT))[bh * 16 + c]; const float M = fmaxf(mi, cm);
        al[tid] = a; Ml[tid] = M; wil[tid] = __expf(mi - M); emtl[tid] = __expf(-(bt + M)); }
    if (tid < 256) nin[tid] = c > 0 ? ((const float*)(p.ws + W_NINIT))[((size_t)bh * 16 + c) * 256 + tid] : 0.f;
    RS[wid * 128 + lane] = 0.f; RS[wid * 128 + 64 + lane] = 0.f;
    lds_barrier();
    u32x2 preg[5];
#pragma unroll
    for (int it = 0; it < 5; ++it) {
        const int idx = wid + 8 * it;
        preg[it] = (u32x2){0u, 0u};
        if (idx < 36) {
            int tt = 0; while (idx >= (tt + 1) * (tt + 2) / 2) ++tt;
            const int st = idx - tt * (tt + 1) / 2;
            f32x4 sacc = (f32x4){0.f, 0.f, 0.f, 0.f};
#pragma unroll
            for (int kk = 0; kk < 8; ++kk) { const bf16x8 B = frag_rm(KVL, 264, 16 * st, 32 * kk, lane), A = frag_rm(QL, 264, 16 * tt, 32 * kk, lane); MMA_T(sacc, B, A); }
            const int t = 16 * tt + (lane & 15), s0 = 16 * st + (lane >> 4) * 4; const float M = Ml[t]; float pv[4]; float ps = 0.f;
#pragma unroll
            for (int j = 0; j < 4; ++j) { const int s = s0 + j; pv[j] = s <= t ? sacc[j] * __expf(fminf(al[s] - M, 0.f)) : 0.f; ps += pv[j]; }
            ps += __shfl_xor(ps, 16); ps += __shfl_xor(ps, 32);
            if (lane < 16) RS[wid * 128 + t] += ps;
            preg[it].x = pk2(pv[0], pv[1]); preg[it].y = pk2(pv[2], pv[3]);
        }
    }
    {   const int t = tid >> 2, sub = tid & 3; float qn = 0.f;
#pragma unroll 8
        for (int i = 0; i < 64; ++i) { const int d = sub * 64 + i; qn += bf2f(QL[t * 264 + d]) * nin[d]; }
        qn += __shfl_xor(qn, 1); qn += __shfl_xor(qn, 2);
        if (sub == 0) QN[t] = qn; }
    f32x4 acc[8][2];
#pragma unroll
    for (int i = 0; i < 8; ++i) { acc[i][0] = (f32x4){0.f, 0.f, 0.f, 0.f}; acc[i][1] = (f32x4){0.f, 0.f, 0.f, 0.f}; }
    if (c > 0) {
        const u16* cb = CT + (((size_t)bh * 16 + c) * 256 + 32 * wid + (lane & 15)) * 256 + (lane >> 4) * 8;
#pragma unroll
        for (int kk = 0; kk < 8; ++kk) { const bf16x8 B0 = *(const bf16x8*)(cb + 32 * kk), B1 = *(const bf16x8*)(cb + 16 * 256 + 32 * kk);
#pragma unroll
            for (int tt = 0; tt < 8; ++tt) { const bf16x8 A = frag_rm(QL, 264, 16 * tt, 32 * kk, lane); MMA_T(acc[tt][0], B0, A); MMA_T(acc[tt][1], B1, A); } }
#pragma unroll
        for (int tt = 0; tt < 8; ++tt) { const float w = wil[16 * tt + (lane & 15)]; acc[tt][0] *= w; acc[tt][1] *= w; }
    }
    lds_barrier();
    LAS u16* PL = QL;
#pragma unroll
    for (int it = 0; it < 5; ++it) {
        const int idx = wid + 8 * it;
        if (idx < 36) {
            int tt = 0; while (idx >= (tt + 1) * (tt + 2) / 2) ++tt;
            const int st = idx - tt * (tt + 1) / 2;
            const int t = 16 * tt + (lane & 15), s0 = 16 * st + (lane >> 4) * 4;
            *(LAS u32x2*)(PL + t * 136 + s0) = preg[it];
            if (st == tt && (tt & 1) == 0) *(LAS u32x2*)(PL + t * 136 + s0 + 16) = (u32x2){0u, 0u};
        }
    }
#pragma unroll
    for (int i = 0; i < 8; ++i) *(LAS u32x4*)(KVL + (sr + 16 * i) * 264 + scc) = vreg[i];
    if (tid < 128) { float dn = wil[tid] * QN[tid];
#pragma unroll
        for (int w = 0; w < 8; ++w) dn += RS[w * 128 + tid];
        DEN[tid] = dn; }
    lds_barrier();
#pragma unroll
    for (int kk = 0; kk < 4; ++kk) { const bf16x8 B0 = frag_tr(KVL, 264, 32 * wid, 32 * kk, lane), B1 = frag_tr(KVL, 264, 32 * wid + 16, 32 * kk, lane);
#pragma unroll
        for (int tt = 2 * kk; tt < 8; ++tt) { const bf16x8 A = frag_rm(PL, 136, 16 * tt, 32 * kk, lane); MMA_T(acc[tt][0], B0, A); MMA_T(acc[tt][1], B1, A); } }
#pragma unroll
    for (int tt = 0; tt < 8; ++tt) { const int tl = 16 * tt + (lane & 15); const float inv = 1.0f / fmaxf(fabsf(DEN[tl]), emtl[tl]); float s1 = 0.f, s2 = 0.f;
#pragma unroll
        for (int et = 0; et < 2; ++et) { acc[tt][et] *= inv;
#pragma unroll
            for (int j = 0; j < 4; ++j) { s1 += acc[tt][et][j]; s2 += acc[tt][et][j] * acc[tt][et][j]; } }
        s1 += __shfl_xor(s1, 16); s1 += __shfl_xor(s1, 32); s2 += __shfl_xor(s2, 16); s2 += __shfl_xor(s2, 32);
        if (lane < 16) { LNS[(wid * 128 + tl) * 2] = s1; LNS[(wid * 128 + tl) * 2 + 1] = s2; } }
    lds_barrier();
#pragma unroll
    for (int tt = 0; tt < 8; ++tt) { const int tl = 16 * tt + (lane & 15); float s1 = 0.f, s2 = 0.f;
#pragma unroll
        for (int w = 0; w < 8; ++w) { s1 += LNS[(w * 128 + tl) * 2]; s2 += LNS[(w * 128 + tl) * 2 + 1]; }
        const float mean = s1 * (1.0f / 256.0f), rstd = rsqrtf(fmaxf(s2 * (1.0f / 256.0f) - mean * mean, 0.f) + 1e-6f);
#pragma unroll
        for (int et = 0; et < 2; ++et) { const int e = 32 * wid + 16 * et + (lane >> 4) * 4;
            u32x2 o; o.x = pk2((acc[tt][et][0] - mean) * rstd, (acc[tt][et][1] - mean) * rstd); o.y = pk2((acc[tt][et][2] - mean) * rstd, (acc[tt][et][3] - mean) * rstd);
            *(LAS u32x2*)(KVL + tl * 264 + e) = o; } }
    lds_barrier();
    {   u16* H = (u16*)(p.ws + W_H); float ng[8];
#pragma unroll
        for (int j = 0; j < 8; ++j) ng[j] = p.in[22][h * 256 + scc + j];
        u32x4 ma[8], so[8], gb[8];
#pragma unroll
        for (int i = 0; i < 8; ++i) { const size_t zr = R0 + sr + 16 * i; ma[i] = *(const u32x4*)(Z + zo(zr, h * 256 + scc)); so[i] = *(const u32x4*)(Z + zo(zr, 5 * 1024 + h * 256 + scc)); gb[i] = *(const u32x4*)(Z + zo(zr, 7 * 1024 + h * 256 + scc)); }
#pragma unroll
        for (int i = 0; i < 8; ++i) { const int r = sr + 16 * i; float hn[8], m8[8], s8[8], g8[8]; unpack8(*(LAS const u32x4*)(KVL + r * 264 + scc), hn); unpack8(ma[i], m8); unpack8(so[i], s8); unpack8(gb[i], g8);
#pragma unroll
            for (int j = 0; j < 8; ++j) hn[j] = m8[j] + sigm(g8[j]) * sigm(s8[j]) * hn[j] * ng[j];
            *(u32x4*)(H + (R0 + r) * 1024 + h * 256 + scc) = pack8(hn); } }
    lds_barrier();
}

__device__ __forceinline__ void phase_mix3(const Params& p, LAS unsigned char* lds) {
#pragma unroll 1
    for (int u = blockIdx.x; u < 512; u += gridDim.x) { const int c = u & 15, bh = u >> 4; out_prompt_unit(p, lds, bh >> 2, bh & 3, c); }
}

#define XB_TMO      128
#define XB_XCNT(j)  (256  + 64 * (j))
#define XB_XSUB(j)  (1280 + 64 * (j))
#define XB_XGEN(j)  (2304 + 64 * (j))
#define XB_TOP      3328
#define XB_TOPGEN   3392
#define XCD_BAR_WORDS 3456
#define XB_SPIN_CAP (1u << 18)
__device__ __forceinline__ unsigned xb_ld(unsigned* p)              { return __hip_atomic_load(p, __ATOMIC_RELAXED, __HIP_MEMORY_SCOPE_AGENT); }
__device__ __forceinline__ unsigned xb_add(unsigned* p, unsigned v) { return __hip_atomic_fetch_add(p, v, __ATOMIC_RELAXED, __HIP_MEMORY_SCOPE_AGENT); }
__device__ __forceinline__ unsigned xb_xcc_id() { return (unsigned)__builtin_amdgcn_s_getreg((3 << 11) | 20) & 0xFu; }
#define XB_SPIN(cond, bar) do { unsigned _sp = 0; while (cond) { __builtin_amdgcn_s_sleep(1); \
    if ((++_sp & 255u) == 0u) { if (xb_ld(&(bar)[XB_TMO])) break; if (_sp > XB_SPIN_CAP) { atomicAdd(&(bar)[XB_TMO], 1u); break; } } } } while (0)
struct XcdBarrier { unsigned* bar; unsigned x; volatile LAS unsigned* st; };
__device__ __forceinline__ XcdBarrier xcd_barrier_post(unsigned* bar, volatile LAS unsigned* st) {
    XcdBarrier b; b.bar = bar; b.x = xb_xcc_id(); b.st = st;
    if (threadIdx.x == 0) (void)xb_add(&bar[XB_XCNT(b.x)], 1u);
    return b;
}
__device__ __forceinline__ void xcd_barrier_complete(unsigned* bar, unsigned x, unsigned& nloc, unsigned& nx) {
    const unsigned G = gridDim.x * gridDim.y * gridDim.z;
    unsigned sum, cnt, mine, sp = 0u;
    for (;;) {
        sum = 0u; cnt = 0u; mine = 0u;
#pragma unroll
        for (unsigned j = 0; j < 16; ++j) { const unsigned c = xb_ld(&bar[XB_XCNT(j)]); sum += c; cnt += (c > 0u) ? 1u : 0u; mine = (j == x) ? c : mine; }
        if (sum == G) break;
        __builtin_amdgcn_s_sleep(1);
        if ((++sp & 255u) == 0u) { if (xb_ld(&bar[XB_TMO])) break; if (sp > XB_SPIN_CAP) { atomicAdd(&bar[XB_TMO], 1u); break; } }
    }
    nloc = mine > 0u ? mine : 1u; nx = cnt > 0u ? cnt : 1u;
}
__device__ __forceinline__ void xcd_barrier(const XcdBarrier& b) {
    asm volatile("s_waitcnt vmcnt(0)" ::: "memory");
    __syncthreads();
    if (threadIdx.x == 0) {
        unsigned* bar = b.bar;
        __builtin_amdgcn_s_waitcnt(0);
        unsigned nloc = b.st[0], nx = b.st[1];
        if (nloc == 0u) { xcd_barrier_complete(bar, b.x, nloc, nx); b.st[0] = nloc; b.st[1] = nx; }
        const unsigned old = xb_add(&bar[XB_XSUB(b.x)], 1u);
        const unsigned gen = old / nloc;
        if (old + 1u == (gen + 1u) * nloc) {
            __builtin_amdgcn_fence(__ATOMIC_RELEASE, "agent");
            asm volatile("s_waitcnt vmcnt(0)" ::: "memory");
            const unsigned og = xb_add(&bar[XB_TOP], 1u);
            const unsigned tg = og / nx;
            if (og + 1u == (tg + 1u) * nx) xb_add(&bar[XB_TOPGEN], 1u);
            else XB_SPIN(xb_ld(&bar[XB_TOPGEN]) == tg, bar);
            __builtin_amdgcn_fence(__ATOMIC_ACQUIRE, "agent");
            xb_add(&bar[XB_XGEN(b.x)], 1u);
            asm volatile("s_waitcnt vmcnt(0)" ::: "memory");
        } else {
            XB_SPIN(xb_ld(&bar[XB_XGEN(b.x)]) == gen, bar);
            __builtin_amdgcn_fence(__ATOMIC_ACQUIRE, "agent");
            asm volatile("s_waitcnt vmcnt(0)" ::: "memory");
        }
    }
    __syncthreads();
}

constexpr int NPHASE = 14;
__device__ __forceinline__ void run_phase(int ph, const Params& p, LAS unsigned char* lds) {
    unsigned char* ws = p.ws; const float* ADA = (const float*)(ws + W_ADA); float* X = p.out + O_Y;
    u16* H = (u16*)(ws + W_H); u16* ACT = (u16*)(ws + W_ACT);
    switch (ph) {
        case 0: phase_convert(p, lds, 1632, 2336, 0, (int)gridDim.x, true); break;
        case 1: { EpiF32B E; E.C = (float*)(ws + W_ADA); E.ldc = ADAC; E.bias = (const float*)(ws + W_BIAS); run_gemm(lds, (const u16*)(ws + W_CS), (const u16*)(ws + W_WBA), 256, ADAC, 1024, E);
                  const int nb = (int)gridDim.x - 44;
                  phase_convert(p, lds, 0, 7 * nb, 44, nb, false); phase_convert(p, lds, 7 * nb, 1632, 0, 44, false); } break;
        case 2: phase_prep<0>(p, lds); break;
        case 3: { EpiSwiglu E; E.O = ACT; run_gemm(lds, H, (const u16*)(ws + W_WB1), MR, 5632, 1024, E); } break;
        case 4: { EpiResid<true> E; E.XinF = p.in[0]; E.XinB = nullptr; E.Xout = (u16*)p.out; E.XoutT = (float*)(ws + W_SLAB); E.gate = ADA + 2 * 1024; E.coef = 0.5f; E.ntf = FF / 64; E.pk = 8 * 64; run_gemm(lds, ACT, (const u16*)(ws + W_WB2), MR, 1024, FF, E, 5, 8, 4); } break;
        case 5: phase_prep<1>(p, lds); break;
        case 6: { EpiZ E; E.O = (u16*)(ws + W_Z); E.vst = (float*)(ws + W_VST); run_gemm(lds, H, (const u16*)(ws + W_WB3), MR, ZC, 1024, E); } break;
        case 7: phase_mix1(p, lds); break;
        case 8: phase_mix2(p, lds); break;
        case 9: phase_mix3(p, lds); break;
        case 10: { EpiResid<false> E; E.XinF = nullptr; E.XinB = (const u16*)p.out; E.Xout = (u16*)(ws + W_X2); E.XoutT = (float*)(ws + W_SLAB); E.gate = ADA + 5 * 1024; E.coef = 1.0f; E.ntf = 16; E.pk = 4 * 64; run_gemm(lds, H, (const u16*)(ws + W_WB4), MR, 1024, 1024, E, 4, 4, 4); } break;
        case 11: phase_prep<2>(p, lds); break;
        case 12: { EpiSwiglu E; E.O = ACT; run_gemm(lds, H, (const u16*)(ws + W_WB5), MR, 5632, 1024, E); } break;
        case 13: { EpiResid<false> E; E.XinF = nullptr; E.XinB = (const u16*)(ws + W_X2); E.Xout = (u16*)(ws + W_X3); E.XoutT = (float*)(ws + W_SLAB); E.gate = ADA + 8 * 1024; E.coef = 0.5f; E.ntf = FF / 64; E.pk = 8 * 64; run_gemm(lds, ACT, (const u16*)(ws + W_WB6), MR, 1024, FF, E, 5, 8, 4); } break;
        default: phase_prep<3>(p, lds); break;
    }
}

#if FUSED
__global__ void __launch_bounds__(512, 2) mega_kernel(Params p) {
    extern __shared__ __attribute__((aligned(16))) unsigned char shm[];
    cg::grid_group grid = cg::this_grid();
    LAS unsigned char* lds = (LAS unsigned char*)shm;
    volatile LAS unsigned* st = (volatile LAS unsigned*)(lds + LDS_BYTES);
    if (threadIdx.x == 0) { st[0] = 0u; st[1] = 0u; st[2] = 0u; st[3] = 0u; }
    __syncthreads();
    const XcdBarrier xb = xcd_barrier_post((unsigned*)(p.ws + W_BAR), st);
    run_phase(0, p, lds); grid.sync();
    run_phase(1, p, lds); xcd_barrier(xb); run_phase(2, p, lds); xcd_barrier(xb); run_phase(3, p, lds); xcd_barrier(xb);
    run_phase(4, p, lds); xcd_barrier(xb); run_phase(5, p, lds); xcd_barrier(xb); run_phase(6, p, lds); xcd_barrier(xb); run_phase(7, p, lds); xcd_barrier(xb);
    run_phase(8, p, lds); xcd_barrier(xb); run_phase(9, p, lds); xcd_barrier(xb); run_phase(10, p, lds); xcd_barrier(xb); run_phase(11, p, lds); xcd_barrier(xb);
    run_phase(12, p, lds); xcd_barrier(xb); run_phase(13, p, lds); xcd_barrier(xb); run_phase(14, p, lds);
}
#else
template <int PH> __global__ void __launch_bounds__(512, 2) phase_kernel(Params p) {
    extern __shared__ __attribute__((aligned(16))) unsigned char shm[];
    run_phase(PH, p, (LAS unsigned char*)shm);
}
template <int PH> static void launch_phase(const Params& p, int grid, hipStream_t stream) {
    static bool attr = false;
    if (!attr) { hipFuncSetAttribute((const void*)phase_kernel<PH>, hipFuncAttributeMaxDynamicSharedMemorySize, LDS_BYTES); attr = true; }
    hipLaunchKernelGGL(phase_kernel<PH>, dim3(grid), dim3(512), LDS_BYTES, stream, p);
}
#endif

extern "C" void kernel_launch(void* const* d_in, const int* in_sizes, int n_in, void* d_out, int out_size, void* d_ws, size_t ws_size, hipStream_t stream) {
    static int grid = 0;
    if (grid == 0) {
        if (n_in != 30 || ws_size < W_END) { fprintf(stderr, "kernel_launch: need 30 inputs and %zu workspace bytes; got %d, %zu\n", (size_t)W_END, n_in, ws_size); grid = -1; return; }
        int dev = 0, cus = 0;
        hipGetDevice(&dev); hipDeviceGetAttribute(&cus, hipDeviceAttributeMultiprocessorCount, dev);
#if FUSED
        int per_cu = 0;
        hipFuncSetAttribute((const void*)mega_kernel, hipFuncAttributeMaxDynamicSharedMemorySize, LDS_BYTES + 16);
        hipOccupancyMaxActiveBlocksPerMultiprocessor(&per_cu, (const void*)mega_kernel, 512, LDS_BYTES + 16);
        if (per_cu < 1) { fprintf(stderr, "kernel_launch: occupancy query says %d blocks per CU\n", per_cu); grid = -1; return; }
        grid = cus;
#else
        grid = cus;
#endif
    }
    if (grid < 0) return;
    Params p{};
    for (int i = 0; i < 30; ++i) p.in[i] = (const float*)d_in[i];
    p.out = (float*)d_out; p.ws = (unsigned char*)d_ws;
#if FUSED
    hipMemsetAsync((unsigned char*)d_ws + W_BAR, 0, 16384, stream);
    void* args[] = {&p};
    hipError_t e = hipLaunchCooperativeKernel((const void*)mega_kernel, dim3(grid), dim3(512), args, LDS_BYTES + 16, stream);
    if (e != hipSuccess) fprintf(stderr, "cooperative launch failed: %s (grid %d)\n", hipGetErrorString(e), grid);
#else
    launch_phase<0>(p, grid, stream); launch_phase<1>(p, grid, stream); launch_phase<2>(p, grid, stream); launch_phase<3>(p, grid, stream); launch_phase<4>(p, grid, stream);
    launch_phase<5>(p, grid, stream); launch_phase<6>(p, grid, stream); launch_phase<7>(p, grid, stream); launch_phase<8>(p, grid, stream); launch_phase<9>(p, grid, stream);
    launch_phase<10>(p, grid, stream); launch_phase<11>(p, grid, stream); launch_phase<12>(p, grid, stream); launch_phase<13>(p, grid, stream); launch_phase<14>(p, grid, stream);
#endif
}
```

```cpp
#include <hip/hip_runtime.h>
#include <hip/hip_cooperative_groups.h>
#include <cstdio>
namespace cg = cooperative_groups;
#ifndef FUSED
#define FUSED 1
#endif
__device__ __forceinline__ int tid_opaque() { int t = (int)threadIdx.x; asm volatile("" : "+v"(t)); return t; }
namespace pg8 {
#define PG8_LAS __attribute__((address_space(3)))
typedef unsigned short bf16_t;
typedef short bf16x8 __attribute__((ext_vector_type(8)));
typedef float f32x4 __attribute__((ext_vector_type(4)));
typedef unsigned u32x4 __attribute__((ext_vector_type(4)));
constexpr int BM = 256, BK = 64, HALF = 128, HTB = HALF * BK * 2  , STAGE_BYTES = 8 * HTB, NXCD = 8, WGM = 8;

__host__ __device__ __forceinline__ int lds_byte(int r, int c) { const int st = (r >> 4) * 2 + (c >> 5), rr = r & 15, cc = c & 31, ob = rr * 64 + cc * 2; return st * 1024 + (ob ^ (((ob >> 9) & 1) << 5)); }
__host__ __device__ __forceinline__ void stage_rc(int b, int& R, int& C) { const int st = b / 1024, sb = b % 1024, swz = sb ^ (((sb >> 9) & 1) << 5); R = (st >> 1) * 16 + swz / 64; C = (st & 1) * 32 + (swz % 64) / 2; }
__host__ __device__ __forceinline__ int perm32(int rho) { const int n = rho >> 4, i = rho & 15; return 8 * (i >> 2) + 4 * n + (i & 3); }

struct Unit { int pm, pn, k0, nt; };
struct Gemm { const bf16_t* A; const bf16_t* Bt; int M, N, K; };

struct StaticOrder {
    int nM, nN, nwg, G, c, ntf, ppu, pnt, nMt;
    __host__ __device__ void init(int M, int N, int G_, int c_, int ntf_ = 0, int ppu_ = 0, int pnt_ = 0, int nMt_ = 0) { nM = M / BM - (ppu_ > 0 ? nMt_ : 0); nN = N / BM; nwg = nM * nN; G = G_; c = c_; ntf = ntf_; ppu = ppu_; pnt = pnt_; nMt = nMt_; }
    __host__ __device__ void map(int wgid, Unit& u) const {
        { const int q = nwg / NXCD, r = nwg % NXCD, xcd = wgid % NXCD, off = wgid / NXCD; wgid = (xcd < r ? xcd * (q + 1) : r * (q + 1) + (xcd - r) * q) + off; }
        const int nig = WGM * nN, gid = wgid / nig, fm = gid * WGM, gsz = (nM - fm) < WGM ? (nM - fm) : WGM;
        u.pm = fm + ((wgid % nig) % gsz); u.pn = (wgid % nig) / gsz;
    }
    __host__ __device__ bool next(int i, Unit& u) const {
        const long L = (long)i * G + c;
        if (L < nwg) { map((int)L, u); u.k0 = 0; u.nt = ntf; return true; }
        if (ppu == 0) return false;
        const int full = ((nwg + G - 1) / G) * G; if (L < full) return false;
        const int q = (int)(L - full); if (q >= nMt * nN * ppu) return false;
        const int pi = q % ppu, j = q / ppu; u.pm = nM + j % nMt; u.pn = j / nMt; u.k0 = pi * pnt * BK; u.nt = (pi == ppu - 1) ? ntf - pnt * (ppu - 1) : pnt; return true;
    }
    __device__ __forceinline__ void a_ready(const Unit&) const {}
    __device__ __forceinline__ void done(const Unit&) const {}
};
typedef __bf16 bf16x2_t __attribute__((ext_vector_type(2)));
typedef float f32x2_t __attribute__((ext_vector_type(2)));
__device__ __forceinline__ unsigned cvt_pk_bf16(float lo, float hi) { return __builtin_bit_cast(unsigned, __builtin_convertvector((f32x2_t){lo, hi}, bf16x2_t)); }
template <class Epi, class Sched, bool STAMP = false>
__device__ __forceinline__ void gemm_phase(PG8_LAS unsigned char* lds, const Gemm g, const Sched& S, const Epi& E, unsigned long long* stamps) {
    const int tid = tid_opaque(), wid = __builtin_amdgcn_readfirstlane(tid >> 6), lane = tid & 63, wr = wid >> 2, wc = wid & 3, fr = lane & 15, fq = lane >> 4;
    const int K = g.K;
    int ts_lo = 0, ts_hi = 0, nts = 0; const unsigned long long rt_entry = STAMP ? (unsigned long long)wall_clock64() : 0ull;
#define PG8_STAMP() do { if (STAMP && wid == 0 && nts < 64) { const unsigned long long _c = (unsigned long long)clock64(); \
        ts_lo = (lane == nts) ? (int)(unsigned)_c : ts_lo; ts_hi = (lane == nts) ? (int)(unsigned)(_c >> 32) : ts_hi; ++nts; } } while (0)
    PG8_STAMP();
    unsigned voffA[2], voffB[2];
#pragma unroll
    for (int i = 0; i < 2; ++i) { int R, C; stage_rc(tid * 16 + i * 8192, R, C); const int Rb = Epi::PERM ? ((R & ~31) + perm32(R & 31)) : R;
        voffA[i] = (unsigned)(R * K + C) * 2u; voffB[i] = (unsigned)(Rb * K + C) * 2u; }
    const size_t kstep = (size_t)(BK * 2);
    const size_t hstep = (size_t)HALF * K * 2;
    const size_t tstep = 2 * hstep;
    const unsigned ldsw = (unsigned)wid * 1024u;
    const int aoff = lds_byte(wr * 64 + fr, fq * 8), boff = lds_byte(wc * 32 + fr, fq * 8);
#define PG8_SA(b, h) (((b) * 2 + (h)) * HTB)
#define PG8_SB(b, h) ((4 + (b) * 2 + (h)) * HTB)
#define PG8_STAGE(bufoff, gbase, voff) do { _Pragma("unroll") for (int _i = 0; _i < 2; ++_i) \
        __builtin_amdgcn_global_load_lds((const unsigned*)((const char*)(gbase) + (voff)[_i]), (PG8_LAS unsigned*)(lds + (bufoff) + ldsw + _i * 8192), 16, 0, 0); } while (0)
#define PG8_LDA(dst, b, h) do { _Pragma("unroll") for (int m = 0; m < 4; ++m) _Pragma("unroll") for (int k = 0; k < 2; ++k) dst[m][k] = *(const PG8_LAS bf16x8*)(lds + PG8_SA(b, h) + aoff + m * 2048 + k * 1024); } while (0)
#define PG8_LDB(dst, b, h) do { _Pragma("unroll") for (int n = 0; n < 2; ++n) _Pragma("unroll") for (int k = 0; k < 2; ++k) dst[n][k] = *(const PG8_LAS bf16x8*)(lds + PG8_SB(b, h) + boff + n * 2048 + k * 1024); } while (0)
#define PG8_MMA(ai, bj, At, Bt) do { __builtin_amdgcn_s_setprio(1); _Pragma("unroll") for (int m = 0; m < 4; ++m) _Pragma("unroll") for (int n = 0; n < 2; ++n) _Pragma("unroll") for (int k = 0; k < 2; ++k) \
        acc[ai][bj][m][n] = __builtin_amdgcn_mfma_f32_16x16x32_bf16(Bt[n][k], At[m][k], acc[ai][bj][m][n], 0, 0, 0); __builtin_amdgcn_s_setprio(0); } while (0)
#define PG8_WAIT_V(n) asm volatile("s_waitcnt vmcnt(" #n ")" ::: "memory")
#define PG8_WAIT_L(n) asm volatile("s_waitcnt lgkmcnt(" #n ")" ::: "memory")
#define PG8_BAR __builtin_amdgcn_s_barrier()
#define PG8_SCHED __builtin_amdgcn_sched_barrier(0)
    Unit cur, nxt; int ui = 0;
    if (!S.next(0, cur)) return;
    f32x4 acc[2][2][4][2];
#pragma unroll
    for (int a = 0; a < 2; ++a)
#pragma unroll
        for (int b = 0; b < 2; ++b)
#pragma unroll
            for (int m = 0; m < 4; ++m)
#pragma unroll
                for (int n = 0; n < 2; ++n) acc[a][b][m][n] = (f32x4){0.f, 0.f, 0.f, 0.f};
    bf16x8 At[4][2], B0[2][2], B1[2][2];
    const char* cA = (const char*)g.A + (size_t)cur.pm * tstep + (size_t)cur.k0 * 2; const char* cB = (const char*)g.Bt + (size_t)cur.pn * tstep + (size_t)cur.k0 * 2;
    S.a_ready(cur);
    PG8_STAGE(PG8_SB(0, 0), cB, voffB); PG8_STAGE(PG8_SA(0, 0), cA, voffA); PG8_STAGE(PG8_SB(0, 1), cB + hstep, voffB); PG8_STAGE(PG8_SA(0, 1), cA + hstep, voffA);
    if (wr == 1) PG8_BAR;
    PG8_WAIT_V(4); PG8_BAR;
    PG8_STAGE(PG8_SB(1, 0), cB + kstep, voffB); PG8_STAGE(PG8_SA(1, 0), cA + kstep, voffA); PG8_STAGE(PG8_SB(1, 1), cB + hstep + kstep, voffB);
    PG8_WAIT_V(6); PG8_BAR;
    PG8_STAMP();
    for (;;) {
        const bool has_next = S.next(ui + 1, nxt);
        const char* nA = has_next ? (const char*)g.A + (size_t)nxt.pm * tstep + (size_t)nxt.k0 * 2 : cA; const char* nB = has_next ? (const char*)g.Bt + (size_t)nxt.pn * tstep + (size_t)nxt.k0 * 2 : cB;
        const int nt = cur.nt;
        for (int t = 0; t < nt; t += 2) {
            const bool last = (t == nt - 2);
            const char* a1 = cA + (size_t)(t + 1) * kstep;
            const char* a2 = last ? nA : cA + (size_t)(t + 2) * kstep; const char* b2 = last ? nB : cB + (size_t)(t + 2) * kstep;
            const char* a3 = a2 + kstep; const char* b3 = b2 + kstep;
            if (last && has_next) S.a_ready(nxt);
            PG8_LDB(B0, 0, 0); PG8_SCHED; PG8_LDA(At, 0, 0); PG8_STAGE(PG8_SA(1, 1), a1 + hstep, voffA);
            PG8_WAIT_L(8); PG8_BAR; PG8_WAIT_L(0); PG8_MMA(0, 0, At, B0); PG8_BAR; PG8_SCHED;
            PG8_LDB(B1, 0, 1); PG8_STAGE(PG8_SB(0, 0), b2, voffB);
            PG8_BAR; PG8_WAIT_L(0); PG8_MMA(0, 1, At, B1); PG8_BAR;
            PG8_LDA(At, 0, 1); PG8_STAGE(PG8_SA(0, 0), a2, voffA);
            PG8_BAR; PG8_WAIT_L(0); PG8_MMA(1, 0, At, B0); PG8_BAR; PG8_SCHED;
            PG8_STAGE(PG8_SB(0, 1), b2 + hstep, voffB);
            PG8_WAIT_V(6); PG8_BAR; PG8_MMA(1, 1, At, B1); PG8_BAR;
            PG8_LDB(B0, 1, 0); PG8_SCHED; PG8_LDA(At, 1, 0); PG8_STAGE(PG8_SA(0, 1), a2 + hstep, voffA);
            PG8_WAIT_L(8); PG8_BAR; PG8_WAIT_L(0); PG8_MMA(0, 0, At, B0); PG8_BAR; PG8_SCHED;
            PG8_LDB(B1, 1, 1); PG8_STAGE(PG8_SB(1, 0), b3, voffB);
            PG8_BAR; PG8_WAIT_L(0); PG8_MMA(0, 1, At, B1); PG8_BAR;
            PG8_LDA(At, 1, 1); PG8_STAGE(PG8_SA(1, 0), a3, voffA);
            PG8_BAR; PG8_WAIT_L(0); PG8_MMA(1, 0, At, B0); PG8_BAR; PG8_SCHED;
            PG8_STAGE(PG8_SB(1, 1), b3 + hstep, voffB);
            PG8_WAIT_V(6); PG8_BAR; PG8_MMA(1, 1, At, B1); PG8_BAR;
        }
        PG8_STAMP();
        if constexpr (!Epi::AFTER_DRAIN) { E(acc, cur, wr, wc, fr, fq); S.done(cur); }
        PG8_STAMP();
        if (!has_next) break;
#pragma unroll
        for (int a = 0; a < 2; ++a)
#pragma unroll
            for (int b = 0; b < 2; ++b)
#pragma unroll
                for (int m = 0; m < 4; ++m)
#pragma unroll
                    for (int n = 0; n < 2; ++n) acc[a][b][m][n] = (f32x4){0.f, 0.f, 0.f, 0.f};
        cur = nxt; cA = nA; cB = nB; ++ui;
    }
    PG8_WAIT_V(0);
    if (wr == 0) PG8_BAR;
    PG8_BAR;
    if constexpr (Epi::AFTER_DRAIN) { E.fused(acc, cur, wr, wc, fr, fq, lds, wid, lane); S.done(cur); }
    PG8_STAMP();
    if (STAMP && wid == 0) { stamps[lane] = lane < nts ? (((unsigned long long)(unsigned)ts_hi << 32) | (unsigned)ts_lo) : 0ull;
        if (lane == 62) stamps[62] = rt_entry; if (lane == 63) stamps[63] = (unsigned long long)wall_clock64(); }
#undef PG8_STAMP
#undef PG8_SA
#undef PG8_SB
#undef PG8_STAGE
#undef PG8_LDA
#undef PG8_LDB
#undef PG8_MMA
#undef PG8_WAIT_V
#undef PG8_WAIT_L
#undef PG8_BAR
#undef PG8_SCHED
}
}

#define LAS __attribute__((address_space(3)))
typedef unsigned short u16;
typedef short bf16x8 __attribute__((ext_vector_type(8)));
typedef short s16x4 __attribute__((ext_vector_type(4)));
typedef float f32x4 __attribute__((ext_vector_type(4)));
typedef unsigned u32x4 __attribute__((ext_vector_type(4)));
typedef unsigned u32x2 __attribute__((ext_vector_type(2)));

constexpr int DM = 1024, NPR = 16384, NSR = 1024, MR = NPR + NSR, FF = 2816, ZC = 8192, ADAC = 11264;
constexpr int LDS_BYTES = 151552;
constexpr size_t W_WB1 = 0;
constexpr size_t W_WB2 = W_WB1 + (size_t)5632 * 1024 * 2;
constexpr size_t W_WB3 = W_WB2 + (size_t)1024 * 2816 * 2;
constexpr size_t W_WB4 = W_WB3 + (size_t)8192 * 1024 * 2;
constexpr size_t W_WB5 = W_WB4 + (size_t)1024 * 1024 * 2;
constexpr size_t W_WB6 = W_WB5 + (size_t)5632 * 1024 * 2;
constexpr size_t W_CS = W_WB6 + (size_t)1024 * 2816 * 2;
constexpr size_t W_BIAS = W_CS + (size_t)256 * 1024 * 2;
constexpr size_t W_WG = W_BIAS + (size_t)ADAC * 4;
constexpr size_t W_ADA = W_WG + (size_t)8 * 1024 * 4;
constexpr size_t W_H = W_ADA + (size_t)256 * ADAC * 4;
constexpr size_t W_GATES = W_H + (size_t)MR * 1024 * 2;
constexpr size_t W_BS = W_GATES + (size_t)MR * 8 * 4;
constexpr size_t W_AS = W_BS + (size_t)32 * 2048 * 4;
constexpr size_t W_CM = W_AS + (size_t)32 * 2048 * 4;
constexpr size_t W_MINIT = W_CM + (size_t)32 * 2048 * 4;
constexpr size_t W_NINIT = W_MINIT + 4096;
constexpr size_t W_Z = W_NINIT + (size_t)32 * 16 * 256 * 4;
constexpr size_t W_ACT = W_Z;
constexpr size_t W_SLAB = W_Z + (size_t)200 * 1024 * 1024;
constexpr size_t W_X3 = W_Z + (size_t)164 * 1024 * 1024;
constexpr size_t W_X2 = W_Z + (size_t)128 * 1024 * 1024;
constexpr size_t W_QB = W_Z + (size_t)MR * ZC * 2;
constexpr size_t W_KB = W_QB + (size_t)MR * 1024 * 2;
constexpr size_t W_CT = W_KB + (size_t)MR * 1024 * 2;
constexpr size_t W_WBA = W_CT;
constexpr size_t W_BAR = W_CT + (size_t)32 * 16 * 65536 * 2;
constexpr size_t W_VST = W_BAR + 16384;
constexpr size_t W_XS = W_VST + (size_t)MR * 32 * 4;
constexpr size_t W_END = W_XS + (size_t)NSR * 1024 * 4;
constexpr size_t O_Y = 0;
constexpr size_t O_CP = (size_t)MR * 1024;
constexpr size_t O_NP = O_CP + (size_t)8 * 4 * 65536;
constexpr size_t O_MP = O_NP + 8 * 4 * 256;
constexpr size_t O_CVP = O_MP + 32;
constexpr size_t O_CS = O_CVP + 8 * 3 * 2048;
constexpr size_t O_NS = O_CS + (size_t)128 * 4 * 65536;
constexpr size_t O_MS = O_NS + 128 * 4 * 256;
constexpr size_t O_CVS = O_MS + 512;
constexpr size_t O_VS = O_CVS + 128 * 3 * 2048;

struct Params { const float* in[30]; float* out; unsigned char* ws; };

__device__ __forceinline__ float bf2f(u16 b) { return __uint_as_float(((unsigned)b) << 16); }
__device__ __forceinline__ float bflo(unsigned w) { return __uint_as_float(w << 16); }
__device__ __forceinline__ float bfhi(unsigned w) { return __uint_as_float(w & 0xffff0000u); }
__device__ __forceinline__ unsigned pk2(float lo, float hi) { return pg8::cvt_pk_bf16(lo, hi); }
__device__ __forceinline__ float sigm(float x) { return __builtin_amdgcn_rcpf(1.0f + __builtin_amdgcn_exp2f(-1.4426950408889634f * x)); }
__device__ __forceinline__ float gelu_t(float x) { return x * sigm(1.5957691216057308f * (x + 0.044715f * x * x * x)); }
__device__ __forceinline__ size_t zo(size_t row, int col) { return ((size_t)(col >> 8) * MR + row) * 256 + (col & 255); }
__device__ __forceinline__ size_t qo(size_t row, int col) { return ((size_t)(col >> 8) * MR + row) * 256 + (col & 255); }
__device__ __forceinline__ int bidx(int row) { return row < NPR ? (row >> 11) : 8 + ((row - NPR) >> 3); }
__device__ __forceinline__ float wsum(float v) {
#pragma unroll
    for (int o = 32; o > 0; o >>= 1) v += __shfl_xor(v, o);
    return v;
}
__device__ __forceinline__ void unpack8(const u32x4 v, float* f) { f[0] = bflo(v.x); f[1] = bfhi(v.x); f[2] = bflo(v.y); f[3] = bfhi(v.y); f[4] = bflo(v.z); f[5] = bfhi(v.z); f[6] = bflo(v.w); f[7] = bfhi(v.w); }
__device__ __forceinline__ u32x4 pack8(const float* f) { u32x4 r; r.x = pk2(f[0], f[1]); r.y = pk2(f[2], f[3]); r.z = pk2(f[4], f[5]); r.w = pk2(f[6], f[7]); return r; }

__device__ __forceinline__ void lds_barrier() { asm volatile("s_waitcnt lgkmcnt(0)\n\ts_barrier" ::: "memory"); }
__device__ __forceinline__ bf16x8 frag_rm(LAS const u16* base, int stride, int r0, int k0, int lane) {
    return *(LAS const bf16x8*)(base + (r0 + (lane & 15)) * stride + k0 + (lane >> 4) * 8);
}
__device__ __forceinline__ bf16x8 frag_tr(LAS const u16* base, int stride, int n0, int k0, int lane) {
    const int g = lane >> 4, li = lane & 15, q = li >> 2, pp = li & 3;
    LAS const u16* a = base + (k0 + g * 8 + q) * stride + n0 + 4 * pp;
    const s16x4 lo = __builtin_amdgcn_ds_read_tr16_b64_v4i16((LAS s16x4*)a);
    const s16x4 hi = __builtin_amdgcn_ds_read_tr16_b64_v4i16((LAS s16x4*)(a + 4 * stride));
    return (bf16x8){lo[0], lo[1], lo[2], lo[3], hi[0], hi[1], hi[2], hi[3]};
}
#define MMA_T(acc, Bf, Af) acc = __builtin_amdgcn_mfma_f32_16x16x32_bf16(Bf, Af, acc, 0, 0, 0)

struct EpiF32B {
    static constexpr bool PERM = false, AFTER_DRAIN = false;
    float* C; int ldc; const float* bias;
    __device__ __forceinline__ void operator()(const f32x4 (&acc)[2][2][4][2], const pg8::Unit& u, int wr, int wc, int fr, int fq) const {
        const int row0 = u.pm * 256 + wr * 64 + fr, col0 = u.pn * 256 + wc * 32 + 4 * fq;
#pragma unroll
        for (int ai = 0; ai < 2; ++ai)
#pragma unroll
            for (int m = 0; m < 4; ++m) { float* rowp = C + (size_t)(row0 + ai * 128 + m * 16) * ldc + col0;
#pragma unroll
                for (int bj = 0; bj < 2; ++bj)
#pragma unroll
                    for (int n = 0; n < 2; ++n) *(f32x4*)(rowp + bj * 128 + n * 16) = acc[ai][bj][m][n] + *(const f32x4*)(bias + col0 + bj * 128 + n * 16); }
    }
};
struct EpiSwiglu {
    static constexpr bool PERM = true, AFTER_DRAIN = false;
    u16* O;
    __device__ __forceinline__ void operator()(const f32x4 (&acc)[2][2][4][2], const pg8::Unit& u, int wr, int wc, int fr, int fq) const {
        const int row0 = u.pm * 256 + wr * 64 + fr, col0 = u.pn * 128 + wc * 32 + 8 * fq;
#pragma unroll
        for (int ai = 0; ai < 2; ++ai)
#pragma unroll
            for (int m = 0; m < 4; ++m) { u16* rowp = O + (size_t)(row0 + ai * 128 + m * 16) * FF + col0;
                float o[8];
#pragma unroll
                for (int n = 0; n < 2; ++n)
#pragma unroll
                    for (int j = 0; j < 4; ++j) { const float a = acc[ai][0][m][n][j], b = acc[ai][1][m][n][j]; o[n * 4 + j] = a * sigm(a) * b; }
                *(u32x4*)rowp = pack8(o); }
    }
};
struct EpiZ {
    static constexpr bool PERM = true, AFTER_DRAIN = false;
    u16* O; float* vst;
    template <bool GELU> __device__ __forceinline__ void body(const f32x4 (&acc)[2][2][4][2], const pg8::Unit& u, int wr, int wc, int fr, int fq) const {
        const int row0 = u.pm * 256 + wr * 64 + fr, col0 = u.pn * 256 + wc * 32 + 8 * fq;
#pragma unroll
        for (int ai = 0; ai < 2; ++ai)
#pragma unroll
            for (int m = 0; m < 4; ++m) { u16* rowp = O + zo((size_t)(row0 + ai * 128 + m * 16), col0); float s1 = 0.f, s2 = 0.f;
#pragma unroll
                for (int bj = 0; bj < 2; ++bj) { float o[8];
#pragma unroll
                    for (int n = 0; n < 2; ++n)
#pragma unroll
                        for (int j = 0; j < 4; ++j) { const float v = acc[ai][bj][m][n][j]; o[n * 4 + j] = GELU ? gelu_t(v) : v; if (GELU) { s1 += o[n * 4 + j]; s2 += o[n * 4 + j] * o[n * 4 + j]; } }
                    *(u32x4*)(rowp + bj * 128) = pack8(o); }
                if (GELU) { s1 += __shfl_xor(s1, 16); s1 += __shfl_xor(s1, 32); s2 += __shfl_xor(s2, 16); s2 += __shfl_xor(s2, 32);
                    if (fq == 0) { float* q = vst + ((size_t)(row0 + ai * 128 + m * 16) * 16 + (u.pn & 3) * 4 + wc) * 2; q[0] = s1; q[1] = s2; } } }
    }
    __device__ __forceinline__ void operator()(const f32x4 (&acc)[2][2][4][2], const pg8::Unit& u, int wr, int wc, int fr, int fq) const {
        if ((u.pn >> 2) == 1) body<true>(acc, u, wr, wc, fr, fq); else body<false>(acc, u, wr, wc, fr, fq);
    }
};
template <bool XF32> struct EpiResid {
    static constexpr bool PERM = true, AFTER_DRAIN = false;
    const float* __restrict__ XinF; const u16* __restrict__ XinB; u16* __restrict__ Xout; float* __restrict__ XoutT; const float* __restrict__ gate; float coef; int ntf, pk;
    __device__ __forceinline__ void operator()(const f32x4 (&acc)[2][2][4][2], const pg8::Unit& u, int wr, int wc, int fr, int fq) const {
        const int row0 = u.pm * 256 + wr * 64 + fr, col0 = u.pn * 256 + wc * 32 + 8 * fq;
        if (u.nt == ntf) {
#pragma unroll
            for (int ai = 0; ai < 2; ++ai)
#pragma unroll
                for (int m = 0; m < 4; ++m) { const int row = row0 + ai * 128 + m * 16; const float* gp = gate + (size_t)bidx(row) * ADAC + col0;
#pragma unroll
                    for (int bj = 0; bj < 2; ++bj) { const int o = bj * 128; float x[8];
                        if (XF32) { const f32x4 a = *(const f32x4*)(XinF + (size_t)row * 1024 + col0 + o), b = *(const f32x4*)(XinF + (size_t)row * 1024 + col0 + o + 4);
#pragma unroll
                            for (int j = 0; j < 4; ++j) { x[j] = a[j]; x[4 + j] = b[j]; } }
                        else unpack8(*(const u32x4*)(XinB + (size_t)row * 1024 + col0 + o), x);
                        const f32x4 g0 = *(const f32x4*)(gp + o), g1 = *(const f32x4*)(gp + o + 4);
#pragma unroll
                        for (int j = 0; j < 4; ++j) { x[j] += coef * g0[j] * acc[ai][bj][m][0][j]; x[4 + j] += coef * g1[j] * acc[ai][bj][m][1][j]; }
                        *(u32x4*)(Xout + (size_t)row * 1024 + col0 + o) = pack8(x); } }
        } else {
            float* sl = XoutT + (size_t)(u.k0 / pk) * ((size_t)NSR * 1024);
#pragma unroll
            for (int ai = 0; ai < 2; ++ai)
#pragma unroll
                for (int m = 0; m < 4; ++m) { const int row = row0 + ai * 128 + m * 16;
                    const float* gp = gate + (size_t)bidx(row) * ADAC + col0; float* op = sl + (size_t)(row - NPR) * 1024 + col0;
#pragma unroll
                    for (int bj = 0; bj < 2; ++bj) { const int o = bj * 128;
                        *(f32x4*)(op + o) = coef * (*(const f32x4*)(gp + o)) * acc[ai][bj][m][0]; *(f32x4*)(op + o + 4) = coef * (*(const f32x4*)(gp + o + 4)) * acc[ai][bj][m][1]; } }
        }
    }
};
template <class Epi> __device__ __forceinline__ void run_gemm(LAS unsigned char* lds, const u16* A, const u16* Bt, int M, int N, int K, const Epi& E, int ppu = 0, int pnt = 0, int nMt = 0) {
    pg8::Gemm g; g.A = A; g.Bt = Bt; g.M = M; g.N = N; g.K = K;
    pg8::StaticOrder S; S.init(M, N, (int)gridDim.x, (int)blockIdx.x, K / 64, ppu, pnt, nMt);
    pg8::gemm_phase<Epi, pg8::StaticOrder, false>(lds, g, S, E, nullptr);
}

__device__ __forceinline__ void phase_convert(const Params& p, LAS unsigned char* lds, int t_begin, int t_end, int first_wg, int n_wg, bool extras) {
    const int tid = tid_opaque();
    LAS u16* T = (LAS u16*)lds;
    constexpr int NJ = 8;
    const int jn[NJ] = {5632, 1024, 8192, 1024, 5632, 1024, 9216, 2048};
    const int jk[NJ] = {1024, 2816, 1024, 1024, 1024, 2816, 1024, 1024};
    int total = 0;
#pragma unroll
    for (int j = 0; j < NJ; ++j) total += (jn[j] / 256) * (jk[j] / 64);
    (void)total;
    for (int t = t_begin + ((int)blockIdx.x - first_wg); (int)blockIdx.x >= first_wg && (int)blockIdx.x < first_wg + n_wg && t < t_end; t += n_wg) {
        int lt = t, job = 0;
#pragma unroll
        for (int j = 0; j < NJ - 1; ++j) { const int c = (jn[j] / 256) * (jk[j] / 64); if (job == j && lt >= c) { lt -= c; job = j + 1; } }
        const float* src; int ld, K, mode; u16* dst;
        switch (job) {
            case 0: src = p.in[11]; ld = 5632; K = 1024; mode = 1; dst = (u16*)(p.ws + W_WB1); break;
            case 1: src = p.in[12]; ld = 1024; K = 2816; mode = 0; dst = (u16*)(p.ws + W_WB2); break;
            case 2: src = p.in[14]; ld = 8200; K = 1024; mode = 2; dst = (u16*)(p.ws + W_WB3); break;
            case 3: src = p.in[23]; ld = 1024; K = 1024; mode = 0; dst = (u16*)(p.ws + W_WB4); break;
            case 4: src = p.in[25]; ld = 5632; K = 1024; mode = 1; dst = (u16*)(p.ws + W_WB5); break;
            case 5: src = p.in[26]; ld = 1024; K = 2816; mode = 0; dst = (u16*)(p.ws + W_WB6); break;
            case 6: src = p.in[8]; ld = 9216; K = 1024; mode = 0; dst = (u16*)(p.ws + W_WBA); break;
            default: src = p.in[27]; ld = 2048; K = 1024; mode = 0; dst = (u16*)(p.ws + W_WBA) + (size_t)9216 * 1024; break;
        }
        const int nk = K / 64, tn = lt / nk, tk = lt - tn * nk, n0 = tn * 256, k0 = tk * 64;
        const int c4 = (tid & 63) * 4, kr = tid >> 6;
        int sc;
        if (mode == 1) sc = (c4 < 128) ? tn * 128 + c4 : FF + tn * 128 + (c4 - 128);
        else if (mode == 2) sc = (n0 < 6144 ? n0 : n0 + 8) + c4;
        else sc = n0 + c4;
        f32x4 v[8];
#pragma unroll
        for (int i = 0; i < 8; ++i) v[i] = *(const f32x4*)(src + (size_t)(k0 + kr + 8 * i) * ld + sc);
#pragma unroll
        for (int i = 0; i < 8; ++i) { const int k = kr + 8 * i;
            const unsigned a = pk2(v[i][0], v[i][1]), b = pk2(v[i][2], v[i][3]);
            T[(c4 + 0) * 72 + k] = (u16)a; T[(c4 + 1) * 72 + k] = (u16)(a >> 16); T[(c4 + 2) * 72 + k] = (u16)b; T[(c4 + 3) * 72 + k] = (u16)(b >> 16); }
        __syncthreads();
#pragma unroll
        for (int i = 0; i < 4; ++i) { const int q = tid + 512 * i, n = q >> 3, k8 = (q & 7) * 8;
            *(u32x4*)(dst + (size_t)(n0 + n) * K + k0 + k8) = *(LAS const u32x4*)(T + n * 72 + k8); }
        __syncthreads();
    }
    if (!extras) return;
    const int gt = blockIdx.x * 512 + tid, gs = gridDim.x * 512;
    u16* CS = (u16*)(p.ws + W_CS);
    for (int i = gt; i < 256 * 1024; i += gs) { const int r = i >> 10, c = i & 1023; float v = 0.f;
        if (r < 8) v = p.in[2][r * 1024 + c]; else if (r < 136) v = p.in[3][(r - 8) * 1024 + c];
        v = v * sigm(v); CS[i] = (u16)(pk2(v, 0.f) & 0xffffu); }
    float* BIAS = (float*)(p.ws + W_BIAS);
    for (int i = gt; i < ADAC; i += gs) BIAS[i] = i < 9216 ? p.in[9][i] : p.in[28][i - 9216];
    float* WG = (float*)(p.ws + W_WG);
    for (int i = gt; i < 8192; i += gs) { const int j = i >> 10, k = i & 1023; WG[i] = p.in[14][(size_t)k * 8200 + 6144 + j]; }
}

template <int WHICH> __device__ __forceinline__ void phase_prep(const Params& p, LAS unsigned char* lds) {
    const int tid = tid_opaque(), lane = tid & 63, wid = tid >> 6;
    const float* ADA = (const float*)(p.ws + W_ADA);
    float* Y = p.out + O_Y;
    u16* H = (u16*)(p.ws + W_H);
    float* XS = (float*)(p.ws + W_XS);
    const float* gv = WHICH == 0 ? p.in[10] : WHICH == 1 ? p.in[13] : WHICH == 2 ? p.in[24] : p.in[29];
    const int jsh = WHICH == 3 ? 9 : 3 * WHICH, jsc = jsh + 1;
    LAS float* WGL = (LAS float*)lds;
    if (WHICH == 1) { const f32x4* wg = (const f32x4*)(p.ws + W_WG);
#pragma unroll
        for (int i = 0; i < 4; ++i) *(LAS f32x4*)(WGL + (tid + 512 * i) * 4) = wg[tid + 512 * i];
        lds_barrier(); }
    for (int row = blockIdx.x * 8 + wid; row < MR; row += gridDim.x * 8) {
        const float* ab = ADA + (size_t)bidx(row) * ADAC;
        float v[2][8]; float ss = 0.f;
#pragma unroll
        for (int i = 0; i < 2; ++i) { const int c = i * 512 + lane * 8;
            if (WHICH == 0) { const float* xr = (row < NPR ? p.in[0] + (size_t)row * 1024 : p.in[1] + (size_t)(row - NPR) * 1024) + c;
                const f32x4 a = *(const f32x4*)xr, b = *(const f32x4*)(xr + 4);
#pragma unroll
                for (int j = 0; j < 4; ++j) { v[i][j] = a[j]; v[i][4 + j] = b[j]; } }
            else if (row < NPR) { const u16* xb = WHICH == 1 ? (const u16*)p.out : WHICH == 2 ? (const u16*)(p.ws + W_X2) : (const u16*)(p.ws + W_X3);
                unpack8(*(const u32x4*)(xb + (size_t)row * 1024 + c), v[i]); }
            else {
                float* xs = XS + (size_t)(row - NPR) * 1024 + c; f32x4 a = *(const f32x4*)xs, b = *(const f32x4*)(xs + 4);
                const float* sl = (const float*)(p.ws + W_SLAB) + (size_t)(row - NPR) * 1024 + c;
#pragma unroll
                for (int pi = 0; pi < (WHICH == 2 ? 4 : 5); ++pi) { a += *(const f32x4*)(sl + (size_t)pi * NSR * 1024); b += *(const f32x4*)(sl + (size_t)pi * NSR * 1024 + 4); }
                if (WHICH < 3) { *(f32x4*)xs = a; *(f32x4*)(xs + 4) = b; }
#pragma unroll
                for (int j = 0; j < 4; ++j) { v[i][j] = a[j]; v[i][4 + j] = b[j]; } }
#pragma unroll
            for (int j = 0; j < 8; ++j) ss += v[i][j] * v[i][j]; }
        ss = wsum(ss);
        const float rstd = rsqrtf(ss * (1.0f / 1024.0f) + 1e-6f);
        float ga[8];
#pragma unroll
        for (int j = 0; j < 8; ++j) ga[j] = 0.f;
#pragma unroll
        for (int i = 0; i < 2; ++i) { const int c = i * 512 + lane * 8; float h[8];
#pragma unroll
            for (int q = 0; q < 2; ++q) { const f32x4 g4 = *(const f32x4*)(gv + c + 4 * q), s4 = *(const f32x4*)(ab + jsc * 1024 + c + 4 * q), h4 = *(const f32x4*)(ab + jsh * 1024 + c + 4 * q);
#pragma unroll
                for (int j = 0; j < 4; ++j) h[4 * q + j] = v[i][4 * q + j] * rstd * g4[j] * (1.0f + s4[j]) + h4[j]; }
            if (WHICH == 0 && row >= NPR) { float* xs = XS + (size_t)(row - NPR) * 1024 + c;
                *(f32x4*)xs = (f32x4){v[i][0], v[i][1], v[i][2], v[i][3]}; *(f32x4*)(xs + 4) = (f32x4){v[i][4], v[i][5], v[i][6], v[i][7]}; }
            if (WHICH == 3) { float* y = Y + (size_t)row * 1024 + c; *(f32x4*)y = (f32x4){h[0], h[1], h[2], h[3]}; *(f32x4*)(y + 4) = (f32x4){h[4], h[5], h[6], h[7]}; }
            else *(u32x4*)(H + (size_t)row * 1024 + c) = pack8(h);
            if (WHICH == 1) {
#pragma unroll
                for (int j = 0; j < 8; ++j) { const f32x4 w0 = *(LAS const f32x4*)(WGL + j * 1024 + c), w1 = *(LAS const f32x4*)(WGL + j * 1024 + c + 4);
                    ga[j] += h[0] * w0[0] + h[1] * w0[1] + h[2] * w0[2] + h[3] * w0[3] + h[4] * w1[0] + h[5] * w1[1] + h[6] * w1[2] + h[7] * w1[3]; } }
        }
        if (WHICH == 1) {
            float mine = 0.f;
#pragma unroll
            for (int j = 0; j < 8; ++j) { const float s = wsum(ga[j]); if (lane == j) mine = s; }
            if (lane < 8) ((float*)(p.ws + W_GATES))[(size_t)row * 8 + lane] = mine + p.in[15][lane];
        }
    }
}

__device__ __forceinline__ void gmlp_prompt_unit(const Params& p, LAS unsigned char* lds, int b, int c, int g) {
    const int tid = tid_opaque(), lane = tid & 63, wid = tid >> 6;
    LAS float* mu = (LAS float*)lds; LAS float* rs = mu + 128;
    LAS u16* WL = (LAS u16*)(lds + 1024);
    LAS u16* VL = (LAS u16*)(lds + 1024 + 34816);
    u16* Z = (u16*)(p.ws + W_Z);
    const size_t R0 = (size_t)b * 2048 + c * 128;
    if (tid < 128) { const f32x4* q = (const f32x4*)((const float*)(p.ws + W_VST) + (R0 + tid) * 32); float s = 0.f, ss = 0.f;
#pragma unroll
        for (int i = 0; i < 8; ++i) { const f32x4 v = q[i]; s += v[0] + v[2]; ss += v[1] + v[3]; }
        const float m = s * (1.0f / 1024.0f); const float var = fmaxf(ss * (1.0f / 1024.0f) - m * m, 0.f); mu[tid] = m; rs[tid] = rsqrtf(var + 1e-6f); }
    {   const float* w = p.in[20] + (size_t)g * 16384;
#pragma unroll
        for (int i = 0; i < 8; ++i) { const int q = tid + 512 * i, t = q >> 5, s = (q & 31) * 4; const f32x4 v = *(const f32x4*)(w + t * 128 + s);
            u32x2 o; o.x = pk2(s <= t ? v[0] : 0.f, s + 1 <= t ? v[1] : 0.f); o.y = pk2(s + 2 <= t ? v[2] : 0.f, s + 3 <= t ? v[3] : 0.f);
            *(LAS u32x2*)(WL + t * 136 + s) = o; } }
    lds_barrier();
    {   const int cc = (tid & 31) * 8; float lg[8], lb[8];
#pragma unroll
        for (int j = 0; j < 8; ++j) { lg[j] = p.in[18][g * 256 + cc + j]; lb[j] = p.in[19][g * 256 + cc + j]; }
        u32x4 vv[8];
#pragma unroll
        for (int i = 0; i < 8; ++i) { const int r = (tid + 512 * i) >> 5; vv[i] = *(const u32x4*)(Z + zo(R0 + r, 1024 + g * 256 + cc)); }
#pragma unroll
        for (int i = 0; i < 8; ++i) { const int r = (tid + 512 * i) >> 5; const float m = mu[r], rsd = rs[r]; float f[8]; unpack8(vv[i], f);
#pragma unroll
            for (int j = 0; j < 8; ++j) f[j] = (f[j] - m) * rsd * lg[j] + lb[j];
            *(LAS u32x4*)(VL + r * 264 + cc) = pack8(f); } }
    lds_barrier();
    f32x4 acc[8][2];
#pragma unroll
    for (int i = 0; i < 8; ++i) { acc[i][0] = (f32x4){0.f, 0.f, 0.f, 0.f}; acc[i][1] = (f32x4){0.f, 0.f, 0.f, 0.f}; }
#pragma unroll
    for (int kk = 0; kk < 4; ++kk) {
        const bf16x8 B0 = frag_tr(VL, 264, 32 * wid, 32 * kk, lane), B1 = frag_tr(VL, 264, 32 * wid + 16, 32 * kk, lane);
#pragma unroll
        for (int i = 0; i < 8; ++i) if (32 * kk <= 16 * i + 15) { const bf16x8 A = frag_rm(WL, 136, 16 * i, 32 * kk, lane); MMA_T(acc[i][0], B0, A); MMA_T(acc[i][1], B1, A); }
    }
    const int cc = (tid & 31) * 8;
    u32x4 gu[8], ga[8];
#pragma unroll
    for (int i = 0; i < 8; ++i) { const int r = (tid + 512 * i) >> 5; gu[i] = *(const u32x4*)(Z + zo(R0 + r, g * 256 + cc)); ga[i] = *(const u32x4*)(Z + zo(R0 + r, 6 * 1024 + g * 256 + cc)); }
    lds_barrier();
    const float* bs = p.in[21] + g * 128;
#pragma unroll
    for (int i = 0; i < 8; ++i) { const int t = 16 * i + (lane & 15); const float bsv = bs[t];
#pragma unroll
        for (int nn = 0; nn < 2; ++nn) { const int d = 32 * wid + 16 * nn + (lane >> 4) * 4;
            u32x2 o; o.x = pk2(acc[i][nn][0] + bsv, acc[i][nn][1] + bsv); o.y = pk2(acc[i][nn][2] + bsv, acc[i][nn][3] + bsv); *(LAS u32x2*)(VL + t * 264 + d) = o; } }
    lds_barrier();
#pragma unroll
    for (int i = 0; i < 8; ++i) { const int r = (tid + 512 * i) >> 5; float o[8], u8[8], a8[8]; unpack8(*(LAS const u32x4*)(VL + r * 264 + cc), o); unpack8(gu[i], u8); unpack8(ga[i], a8);
#pragma unroll
        for (int j = 0; j < 8; ++j) o[j] = sigm(a8[j]) * gelu_t(u8[j]) * o[j];
        *(u32x4*)(Z + zo(R0 + r, g * 256 + cc)) = pack8(o); }
    lds_barrier();
}

__device__ __forceinline__ void gmlp_sample_unit(const Params& p, LAS unsigned char* lds, int b) {
    const int tid = tid_opaque(), lane = tid & 63, wid = tid >> 6;
    LAS float* VS = (LAS float*)lds;
    u16* Z = (u16*)(p.ws + W_Z);
    const size_t r0 = (size_t)NPR + b * 8;
    {   const int t = wid; const u16* src = Z + zo(r0 + t, 1024 + lane * 16);
        float f[16]; unpack8(*(const u32x4*)src, f); unpack8(*(const u32x4*)(src + 8), f + 8);
        float s = 0.f, ss = 0.f;
#pragma unroll
        for (int j = 0; j < 16; ++j) { s += f[j]; ss += f[j] * f[j]; }
        s = wsum(s); ss = wsum(ss);
        const float m = s * (1.0f / 1024.0f), rsd = rsqrtf(fmaxf(ss * (1.0f / 1024.0f) - m * m, 0.f) + 1e-6f);
        float* vo = p.out + O_VS + ((size_t)b * 8 + t) * 1024 + lane * 16;
#pragma unroll
        for (int j = 0; j < 16; ++j) { const float v = (f[j] - m) * rsd * p.in[18][lane * 16 + j] + p.in[19][lane * 16 + j]; VS[t * 1024 + lane * 16 + j] = v; vo[j] = v; } }
    lds_barrier();
    {   const int c = tid * 2, g = c >> 8; const float* ws = p.in[20] + (size_t)g * 16384; const float* bs = p.in[21] + g * 128;
#pragma unroll
        for (int t = 0; t < 8; ++t) { float a0 = bs[t], a1 = a0;
#pragma unroll
            for (int s = 0; s <= t; ++s) { const float w = ws[t * 128 + s]; a0 += w * VS[s * 1024 + c]; a1 += w * VS[s * 1024 + c + 1]; }
            const size_t row = r0 + t; const unsigned gu = *(const unsigned*)(Z + zo(row, c)), ga = *(const unsigned*)(Z + zo(row, 6 * 1024 + c));
            *(unsigned*)(Z + zo(row, c)) = pk2(sigm(bflo(ga)) * gelu_t(bflo(gu)) * a0, sigm(bfhi(ga)) * gelu_t(bfhi(gu)) * a1); } }
    lds_barrier();
}

__device__ __forceinline__ void conv_unit(const Params& p, size_t rowbase, int nrows, int histmode, const float* hist, float* outconv) {
    const int tid = tid_opaque(), c4 = tid * 4;
    const u16* Z = (const u16*)(p.ws + W_Z);
    u16* dst = c4 < 1024 ? (u16*)(p.ws + W_QB) : (u16*)(p.ws + W_KB); const int dc = c4 & 1023;
    const float osc = c4 < 1024 ? 1.0f : 0.0625f;
    f32x4 w[4];
#pragma unroll
    for (int j = 0; j < 4; ++j) w[j] = *(const f32x4*)(p.in[16] + j * 2048 + c4);
    const f32x4 cb = *(const f32x4*)(p.in[17] + c4);
    f32x4 x[3];
#pragma unroll
    for (int j = 0; j < 3; ++j) {
        if (histmode == 0) x[j] = (f32x4){0.f, 0.f, 0.f, 0.f};
        else if (histmode == 1) { const u32x2 v = *(const u32x2*)(Z + zo(rowbase - 3 + j, 2048 + c4)); x[j] = (f32x4){bflo(v.x), bfhi(v.x), bflo(v.y), bfhi(v.y)}; }
        else x[j] = *(const f32x4*)(hist + j * 2048 + c4);
    }
#pragma unroll 8
    for (int t = 0; t < nrows; ++t) {
        const u32x2 v = *(const u32x2*)(Z + zo(rowbase + t, 2048 + c4));
        const f32x4 xv = (f32x4){bflo(v.x), bfhi(v.x), bflo(v.y), bfhi(v.y)};
        f32x4 y = cb + w[0] * x[0] + w[1] * x[1] + w[2] * x[2] + w[3] * xv;
        u32x2 o; o.x = pk2(y[0] * sigm(y[0]) * osc, y[1] * sigm(y[1]) * osc); o.y = pk2(y[2] * sigm(y[2]) * osc, y[3] * sigm(y[3]) * osc);
        *(u32x2*)(dst + qo(rowbase + t, dc)) = o;
        if (outconv && t >= nrows - 3) *(f32x4*)(outconv + (size_t)(t - (nrows - 3)) * 2048 + c4) = xv;
        x[0] = x[1]; x[1] = x[2]; x[2] = xv;
    }
}

__device__ __forceinline__ void conv_unit64(const Params& p, size_t rowbase, bool zero_hist, float* outconv) {
    const int tid = tid_opaque(), c8 = (tid & 255) * 8, rh = tid >> 8;
    const u16* Z = (const u16*)(p.ws + W_Z); const int zc = 2048 + c8;
    u16* dst = c8 < 1024 ? (u16*)(p.ws + W_QB) : (u16*)(p.ws + W_KB); const int dc = c8 & 1023;
    const float osc = c8 < 1024 ? 1.0f : 0.0625f;
    float w[4][8], cb[8], x[3][8];
#pragma unroll
    for (int j = 0; j < 4; ++j) { const f32x4 a = *(const f32x4*)(p.in[16] + j * 2048 + c8), b = *(const f32x4*)(p.in[16] + j * 2048 + c8 + 4);
#pragma unroll
        for (int e = 0; e < 4; ++e) { w[j][e] = a[e]; w[j][4 + e] = b[e]; } }
    {   const f32x4 a = *(const f32x4*)(p.in[17] + c8), b = *(const f32x4*)(p.in[17] + c8 + 4);
#pragma unroll
        for (int e = 0; e < 4; ++e) { cb[e] = a[e]; cb[4 + e] = b[e]; } }
    const size_t r0 = rowbase + 32 * rh;
    u32x4 cur[8], nxt[8];
#pragma unroll
    for (int i = 0; i < 8; ++i) cur[i] = *(const u32x4*)(Z + zo(r0 + i, zc));
#pragma unroll
    for (int j = 0; j < 3; ++j) {
        if (zero_hist && rh == 0) {
#pragma unroll
            for (int e = 0; e < 8; ++e) x[j][e] = 0.f; }
        else unpack8(*(const u32x4*)(Z + zo(r0 - 3 + j, zc)), x[j]);
    }
#pragma unroll
    for (int blk = 0; blk < 4; ++blk) {
        if (blk < 3) {
#pragma unroll
            for (int i = 0; i < 8; ++i) nxt[i] = *(const u32x4*)(Z + zo(r0 + 8 * (blk + 1) + i, zc)); }
#pragma unroll
        for (int i = 0; i < 8; ++i) { const int t = 8 * blk + i; float xv[8], o[8]; unpack8(cur[i], xv);
#pragma unroll
            for (int e = 0; e < 8; ++e) { const float y = cb[e] + w[0][e] * x[0][e] + w[1][e] * x[1][e] + w[2][e] * x[2][e] + w[3][e] * xv[e]; o[e] = y * sigm(y) * osc; }
            *(u32x4*)(dst + qo(r0 + t, dc)) = pack8(o);
            if (outconv && rh == 1 && t >= 29) { float* oc = outconv + (size_t)(t - 29) * 2048 + c8; *(f32x4*)oc = (f32x4){xv[0], xv[1], xv[2], xv[3]}; *(f32x4*)(oc + 4) = (f32x4){xv[4], xv[5], xv[6], xv[7]}; }
#pragma unroll
            for (int e = 0; e < 8; ++e) { x[0][e] = x[1][e]; x[1][e] = x[2][e]; x[2][e] = xv[e]; } }
        if (blk < 3) {
#pragma unroll
            for (int i = 0; i < 8; ++i) cur[i] = nxt[i]; }
    }
}

__device__ __forceinline__ void phase_mix1(const Params& p, LAS unsigned char* lds) {
    for (int u = blockIdx.x; u < 1024; u += gridDim.x) {
        if (u < 512) gmlp_prompt_unit(p, lds, u >> 6, (u >> 2) & 15, u & 3);
        else if (u < 768) { const int v = u - 512, b = v >> 5, hc = v & 31; conv_unit64(p, (size_t)b * 2048 + hc * 64, hc == 0, hc == 31 ? p.out + O_CVP + (size_t)b * 6144 : nullptr); }
        else if (u < 896) gmlp_sample_unit(p, lds, u - 768);
        else { const int b = u - 896; conv_unit(p, (size_t)NPR + b * 8, 8, 2, p.in[7] + (size_t)b * 6144, p.out + O_CVS + (size_t)b * 6144); }
    }
}

__device__ __forceinline__ float logsig(float f) { return fminf(f, 0.f) - log1pf(__expf(-fabsf(f))); }

__device__ __forceinline__ void scan_prompt_unit(const Params& p, LAS unsigned char* lds, int b, int h, int slab) {
    const int tid = tid_opaque(), lane = tid & 63, wid = tid >> 6, bh = b * 4 + h;
    LAS float* ASl = (LAS float*)lds;
    LAS float* Mc = ASl + 2048;
    LAS float* mi = Mc + 16;
    LAS float* bL = mi + 16;
    LAS float* amx = bL + 16;
    LAS u16* KL = (LAS u16*)(lds + 16384);
    LAS u16* VWL = (LAS u16*)(lds + 16384 + 67584);
    const float* GATES = (const float*)(p.ws + W_GATES);
    const u16* Z = (const u16*)(p.ws + W_Z); const u16* KB = (const u16*)(p.ws + W_KB);
    u16* CT = (u16*)(p.ws + W_CT);
    const size_t Rb = (size_t)b * 2048;
    u32x4 kreg[8], vreg[2];
    const int vr = tid >> 2, vcc = (tid & 3) * 16;
#pragma unroll
    for (int i = 0; i < 8; ++i) { const int q = tid + 512 * i, r = q >> 5, cc = (q & 31) * 8; kreg[i] = *(const u32x4*)(KB + qo(Rb + r, h * 256 + cc)); }
    vreg[0] = *(const u32x4*)(Z + zo(Rb + vr, 4096 + h * 256 + slab * 64 + vcc)); vreg[1] = *(const u32x4*)(Z + zo(Rb + vr, 4096 + h * 256 + slab * 64 + vcc + 8));
    {   const int p0 = tid * 4; float iv[4], bv[4], av[4], cm[4];
        float run = 0.f;
#pragma unroll
        for (int j = 0; j < 4; ++j) { const float* gp = GATES + (Rb + p0 + j) * 8; iv[j] = gp[h]; run += logsig(gp[4 + h]); bv[j] = run; }
        float sc = run;
#pragma unroll
        for (int d = 1; d < 32; d <<= 1) { const float o = __shfl_up(sc, d, 32); if ((lane & 31) >= d) sc += o; }
        const float off = sc - run;
        float rm = -INFINITY;
#pragma unroll
        for (int j = 0; j < 4; ++j) { bv[j] += off; av[j] = iv[j] - bv[j]; rm = fmaxf(rm, av[j]); cm[j] = rm; }
        float sm = rm;
#pragma unroll
        for (int d = 1; d < 32; d <<= 1) { const float o = __shfl_up(sm, d, 32); if ((lane & 31) >= d) sm = fmaxf(sm, o); }
        float em = __shfl_up(sm, 1, 32); if ((lane & 31) == 0) em = -INFINITY;
#pragma unroll
        for (int j = 0; j < 4; ++j) { cm[j] = fmaxf(cm[j], em); ASl[p0 + j] = av[j]; }
        if (slab == 0) {
            *(f32x4*)((float*)(p.ws + W_BS) + (size_t)bh * 2048 + p0) = (f32x4){bv[0], bv[1], bv[2], bv[3]};
            *(f32x4*)((float*)(p.ws + W_AS) + (size_t)bh * 2048 + p0) = (f32x4){av[0], av[1], av[2], av[3]};
            *(f32x4*)((float*)(p.ws + W_CM) + (size_t)bh * 2048 + p0) = (f32x4){cm[0], cm[1], cm[2], cm[3]}; }
        if ((lane & 31) == 31) { bL[p0 >> 7] = bv[3]; amx[p0 >> 7] = cm[3]; } }
    lds_barrier();
    if (tid == 0) { float m = 0.f;
        for (int c = 0; c < 16; ++c) { mi[c] = m; const float M = fmaxf(m, amx[c]); Mc[c] = M; if (slab == 0) ((float*)(p.ws + W_MINIT))[bh * 16 + c] = m; m = bL[c] + M; }
        if (slab == 0) p.out[O_MP + bh] = m; }
    lds_barrier();
    f32x4 acc[5][2];
#pragma unroll
    for (int i = 0; i < 5; ++i) { acc[i][0] = (f32x4){0.f, 0.f, 0.f, 0.f}; acc[i][1] = (f32x4){0.f, 0.f, 0.f, 0.f}; }
    for (int c = 0; c < 16; ++c) {
        const float M = Mc[c], ap = __expf(mi[c] - M);
        const float w = __expf(ASl[c * 128 + vr] - M);
#pragma unroll
        for (int i = 0; i < 8; ++i) { const int q = tid + 512 * i, r = q >> 5, cc = (q & 31) * 8; *(LAS u32x4*)(KL + r * 264 + cc) = kreg[i]; }
        {   float f[8];
#pragma unroll
            for (int q = 0; q < 2; ++q) { unpack8(vreg[q], f);
#pragma unroll
                for (int j = 0; j < 8; ++j) f[j] *= w;
                *(LAS u32x4*)(VWL + vr * 88 + vcc + 8 * q) = pack8(f); }
            if ((tid & 3) == 0) { u32x4 e; e.x = pk2(w, 0.f); e.y = 0u; e.z = 0u; e.w = 0u; *(LAS u32x4*)(VWL + vr * 88 + 64) = e; e.x = 0u; *(LAS u32x4*)(VWL + vr * 88 + 72) = e; } }
        lds_barrier();
        if (c < 15) { const size_t R1 = Rb + (c + 1) * 128;
#pragma unroll
            for (int i = 0; i < 8; ++i) { const int q = tid + 512 * i, r = q >> 5, cc = (q & 31) * 8; kreg[i] = *(const u32x4*)(KB + qo(R1 + r, h * 256 + cc)); }
            vreg[0] = *(const u32x4*)(Z + zo(R1 + vr, 4096 + h * 256 + slab * 64 + vcc)); vreg[1] = *(const u32x4*)(Z + zo(R1 + vr, 4096 + h * 256 + slab * 64 + vcc + 8)); }
#pragma unroll
        for (int i = 0; i < 5; ++i) { acc[i][0] *= ap; acc[i][1] *= ap; }
#pragma unroll
        for (int kk = 0; kk < 4; ++kk) {
            const bf16x8 B0 = frag_tr(KL, 264, 32 * wid, 32 * kk, lane), B1 = frag_tr(KL, 264, 32 * wid + 16, 32 * kk, lane);
#pragma unroll
            for (int et = 0; et < 4; ++et) { const bf16x8 A = frag_tr(VWL, 88, 16 * et, 32 * kk, lane); MMA_T(acc[et][0], B0, A); MMA_T(acc[et][1], B1, A); }
            if (slab == 0) { const bf16x8 A4 = frag_tr(VWL, 88, 64, 32 * kk, lane); MMA_T(acc[4][0], B0, A4); MMA_T(acc[4][1], B1, A4); }
        }
        if (c < 15) {
#pragma unroll
            for (int et = 0; et < 4; ++et)
#pragma unroll
                for (int dt = 0; dt < 2; ++dt) { const int e = slab * 64 + 16 * et + (lane & 15), d = 32 * wid + 16 * dt + (lane >> 4) * 4;
                    u32x2 o; o.x = pk2(acc[et][dt][0], acc[et][dt][1]); o.y = pk2(acc[et][dt][2], acc[et][dt][3]);
                    *(u32x2*)(CT + (((size_t)bh * 16 + c + 1) * 256 + e) * 256 + d) = o; }
            if (slab == 0 && (lane & 15) == 0) {
#pragma unroll
                for (int dt = 0; dt < 2; ++dt) { const int d = 32 * wid + 16 * dt + (lane >> 4) * 4; *(f32x4*)((float*)(p.ws + W_NINIT) + ((size_t)bh * 16 + c + 1) * 256 + d) = acc[4][dt]; } } }
        lds_barrier();
    }
#pragma unroll
    for (int et = 0; et < 4; ++et)
#pragma unroll
        for (int dt = 0; dt < 2; ++dt) { const int e = slab * 64 + 16 * et + (lane & 15), d = 32 * wid + 16 * dt + (lane >> 4) * 4;
#pragma unroll
            for (int j = 0; j < 4; ++j) p.out[O_CP + ((size_t)bh * 256 + d + j) * 256 + e] = acc[et][dt][j]; }
    if (slab == 0 && (lane & 15) == 0) {
#pragma unroll
        for (int dt = 0; dt < 2; ++dt) { const int d = 32 * wid + 16 * dt + (lane >> 4) * 4; *(f32x4*)(p.out + O_NP + (size_t)bh * 256 + d) = acc[4][dt]; } }
    lds_barrier();
}

__device__ __forceinline__ void sample_unit(const Params& p, LAS unsigned char* lds, int b, int h) {
    const int tid = tid_opaque(), lane = tid & 63, wid = tid >> 6, bh = b * 4 + h;
    LAS float* QF = (LAS float*)lds;
    LAS float* KF = QF + 2048;
    LAS float* KWF = KF + 2048;
    LAS float* VF = KWF + 2048;
    LAS float* NUM = VF + 2048;
    LAS float* SC = NUM + 16384;
    LAS float* QN = SC + 64;
    LAS float* sa = QN + 8;
    LAS float* sM = sa + 8;
    LAS float* swi = sM + 8;
    LAS float* semt = swi + 8;
    LAS float* sw7 = semt + 8;
    LAS float* sden = sw7 + 8;
    LAS float* smisc = sden + 8;
    const float* GATES = (const float*)(p.ws + W_GATES);
    const u16* Z = (const u16*)(p.ws + W_Z); const u16* QB = (const u16*)(p.ws + W_QB); const u16* KB = (const u16*)(p.ws + W_KB);
    const size_t r0 = (size_t)NPR + b * 8;
    const float m0 = p.in[6][bh];
    const int e4 = lane * 4, dg = wid * 32;
    const float* C0 = p.in[4] + (size_t)bh * 65536 + e4; float* Co = p.out + O_CS + (size_t)bh * 65536 + e4;
    f32x4 cpre[4];
#pragma unroll
    for (int u = 0; u < 4; ++u) cpre[u] = __builtin_nontemporal_load((const f32x4*)(C0 + (size_t)(dg + u) * 256));
    if (tid == 0) { float bc = 0.f, cm = -INFINITY; float a[8];
        for (int t = 0; t < 8; ++t) { const float* gp = GATES + (r0 + t) * 8; bc += logsig(gp[4 + h]); a[t] = gp[h] - bc; cm = fmaxf(cm, a[t]); const float M = fmaxf(m0, cm);
            sa[t] = a[t]; sM[t] = M; swi[t] = __expf(m0 - M); semt[t] = __expf(-(bc + M)); if (t == 7) { smisc[0] = __expf(m0 - M); smisc[1] = bc + M; } }
        const float M7 = sM[7];
        for (int s = 0; s < 8; ++s) sw7[s] = __expf(a[s] - M7); }
    {   const int t = tid >> 6, d4 = (tid & 63) * 4;
        const u32x2 q = *(const u32x2*)(QB + qo(r0 + t, h * 256 + d4)), k = *(const u32x2*)(KB + qo(r0 + t, h * 256 + d4)), v = *(const u32x2*)(Z + zo(r0 + t, 4096 + h * 256 + d4));
        QF[(d4 + 0) * 8 + t] = bflo(q.x); QF[(d4 + 1) * 8 + t] = bfhi(q.x); QF[(d4 + 2) * 8 + t] = bflo(q.y); QF[(d4 + 3) * 8 + t] = bfhi(q.y);
        KF[(d4 + 0) * 8 + t] = bflo(k.x); KF[(d4 + 1) * 8 + t] = bfhi(k.x); KF[(d4 + 2) * 8 + t] = bflo(k.y); KF[(d4 + 3) * 8 + t] = bfhi(k.y);
        *(LAS f32x4*)(VF + t * 256 + d4) = (f32x4){bflo(v.x), bfhi(v.x), bflo(v.y), bfhi(v.y)}; }
    lds_barrier();
    {   const int pair = tid >> 3, t = pair >> 3, s = pair & 7, sub = tid & 7; float dot = 0.f, qn = 0.f;
        const float* n0 = p.in[5] + (size_t)bh * 256;
#pragma unroll 8
        for (int i = 0; i < 32; ++i) { const int d = sub * 32 + i; const float q = QF[d * 8 + t]; dot += q * KF[d * 8 + s]; qn += q * n0[d]; }
        dot += __shfl_xor(dot, 1); dot += __shfl_xor(dot, 2); dot += __shfl_xor(dot, 4);
        qn += __shfl_xor(qn, 1); qn += __shfl_xor(qn, 2); qn += __shfl_xor(qn, 4);
        if (sub == 0) { SC[t * 8 + s] = s <= t ? dot * __expf(fminf(sa[s] - sM[t], 0.f)) : 0.f; if (s == 0) QN[t] = qn; }
        const int d = tid >> 1, s4 = (tid & 1) * 4;
#pragma unroll
        for (int j = 0; j < 4; ++j) KWF[d * 8 + s4 + j] = KF[d * 8 + s4 + j] * sw7[s4 + j]; }
    lds_barrier();
    if (tid < 8) { float dn = swi[tid] * QN[tid];
        for (int s = 0; s < 8; ++s) dn += SC[tid * 8 + s];
        sden[tid] = dn; }
    const float ap = smisc[0];
    {   f32x4 vv[8], num[8];
#pragma unroll
        for (int s = 0; s < 8; ++s) { vv[s] = *(LAS const f32x4*)(VF + s * 256 + e4); num[s] = (f32x4){0.f, 0.f, 0.f, 0.f}; }
#pragma unroll 1
        for (int i = 0; i < 32; i += 4) {
            f32x4 cnx[4];
            if (i + 4 < 32) {
#pragma unroll
                for (int u = 0; u < 4; ++u) cnx[u] = __builtin_nontemporal_load((const f32x4*)(C0 + (size_t)(dg + i + 4 + u) * 256)); }
#pragma unroll
            for (int u = 0; u < 4; ++u) { const int d = dg + i + u; const f32x4 c0 = cpre[u];
                const f32x4 q0 = *(LAS const f32x4*)(QF + d * 8), q1 = *(LAS const f32x4*)(QF + d * 8 + 4), k0 = *(LAS const f32x4*)(KWF + d * 8), k1 = *(LAS const f32x4*)(KWF + d * 8 + 4);
                f32x4 cn = ap * c0;
#pragma unroll
                for (int j = 0; j < 4; ++j) { num[j] += q0[j] * c0; num[4 + j] += q1[j] * c0; cn += k0[j] * vv[j] + k1[j] * vv[4 + j]; }
                __builtin_nontemporal_store(cn, (f32x4*)(Co + (size_t)d * 256)); }
            if (i + 4 < 32) {
#pragma unroll
                for (int u = 0; u < 4; ++u) cpre[u] = cnx[u]; }
        }
#pragma unroll
        for (int t = 0; t < 8; ++t) *(LAS f32x4*)(NUM + (wid * 8 + t) * 256 + e4) = num[t];
        if (tid < 256) { const int d = tid; float s = ap * p.in[5][(size_t)bh * 256 + d];
#pragma unroll
            for (int j = 0; j < 8; ++j) s += KWF[d * 8 + j];
            p.out[O_NS + (size_t)bh * 256 + d] = s; }
        if (tid == 0) p.out[O_MS + bh] = smisc[1]; }
    lds_barrier();
    {   const int t = wid; const float wi = swi[t], dn = fmaxf(fabsf(sden[t]), semt[t]);
        f32x4 n = (f32x4){0.f, 0.f, 0.f, 0.f};
#pragma unroll
        for (int g = 0; g < 8; ++g) n += *(LAS const f32x4*)(NUM + (g * 8 + t) * 256 + e4);
        n *= wi;
#pragma unroll
        for (int s = 0; s < 8; ++s) n += SC[t * 8 + s] * (*(LAS const f32x4*)(VF + s * 256 + e4));
        float hv[4]; float s1 = 0.f, s2 = 0.f;
#pragma unroll
        for (int j = 0; j < 4; ++j) { hv[j] = n[j] / dn; s1 += hv[j]; s2 += hv[j] * hv[j]; }
        s1 = wsum(s1); s2 = wsum(s2);
        const float mean = s1 * (1.0f / 256.0f), rstd = rsqrtf(fmaxf(s2 * (1.0f / 256.0f) - mean * mean, 0.f) + 1e-6f);
        const size_t row = r0 + t; const int col = h * 256 + e4;
        const u32x2 ma = *(const u32x2*)(Z + zo(row, col)), so = *(const u32x2*)(Z + zo(row, 5 * 1024 + col)), gb = *(const u32x2*)(Z + zo(row, 7 * 1024 + col));
        const f32x4 ng = *(const f32x4*)(p.in[22] + col);
        const float o0 = bflo(ma.x) + sigm(bflo(gb.x)) * sigm(bflo(so.x)) * (hv[0] - mean) * rstd * ng[0], o1 = bfhi(ma.x) + sigm(bfhi(gb.x)) * sigm(bfhi(so.x)) * (hv[1] - mean) * rstd * ng[1];
        const float o2 = bflo(ma.y) + sigm(bflo(gb.y)) * sigm(bflo(so.y)) * (hv[2] - mean) * rstd * ng[2], o3 = bfhi(ma.y) + sigm(bfhi(gb.y)) * sigm(bfhi(so.y)) * (hv[3] - mean) * rstd * ng[3];
        u32x2 o; o.x = pk2(o0, o1); o.y = pk2(o2, o3); *(u32x2*)((u16*)(p.ws + W_H) + row * 1024 + col) = o; }
    lds_barrier();
}

__device__ __forceinline__ void phase_mix2(const Params& p, LAS unsigned char* lds) {
    const int nscan = (int)gridDim.x / 2;
    if ((int)blockIdx.x < nscan) {
#pragma unroll 1
        for (int u = blockIdx.x; u < 128; u += nscan) { const int x = u & 7, j = u >> 3, bh = x * 4 + (j >> 2);
            scan_prompt_unit(p, lds, bh >> 2, bh & 3, j & 3); }
    }
    unsigned* ctr = (unsigned*)(p.ws + W_BAR) + 3584;
    LAS unsigned* slot = (LAS unsigned*)(lds + LDS_BYTES) + 2;
#pragma unroll 1
    for (;;) {
        if (tid_opaque() == 0) *slot = __hip_atomic_fetch_add(ctr, 1u, __ATOMIC_RELAXED, __HIP_MEMORY_SCOPE_AGENT);
        lds_barrier();
        const unsigned v = *slot;
        lds_barrier();
        if (v >= 512u) break;
        sample_unit(p, lds, (int)(v >> 2), (int)(v & 3));
    }
}

__device__ __forceinline__ void out_prompt_unit(const Params& p, LAS unsigned char* lds, int b, int h, int c) {
    const int tid = tid_opaque(), lane = tid & 63, wid = __builtin_amdgcn_readfirstlane(tid >> 6), bh = b * 4 + h;
    LAS u16* QL = (LAS u16*)lds;
    LAS u16* KVL = (LAS u16*)(lds + 67584);
    LAS float* al = (LAS float*)(lds + 135168);
    LAS float* Ml = al + 128;
    LAS float* wil = Ml + 128;
    LAS float* emtl = wil + 128;
    LAS float* RS = emtl + 128;
    LAS float* DEN = RS + 1024;
    LAS float* QN = DEN + 128;
    LAS float* nin = QN + 128;
    LAS float* LNS = nin + 256;
    const u16* Z = (const u16*)(p.ws + W_Z); const u16* QB = (const u16*)(p.ws + W_QB); const u16* KB = (const u16*)(p.ws + W_KB);
    const u16* CT = (const u16*)(p.ws + W_CT);
    const size_t R0 = (size_t)b * 2048 + c * 128;
    const int sr = tid >> 5, scc = (tid & 31) * 8;
    u32x4 vreg[8];
#pragma unroll
    for (int i = 0; i < 8; ++i) { const int r = sr + 16 * i;
        *(LAS u32x4*)(QL + r * 264 + scc) = *(const u32x4*)(QB + qo(R0 + r, h * 256 + scc));
        *(LAS u32x4*)(KVL + r * 264 + scc) = *(const u32x4*)(KB + qo(R0 + r, h * 256 + scc)); }
#pragma unroll
    for (int i = 0; i < 8; ++i) vreg[i] = *(const u32x4*)(Z + zo(R0 + sr + 16 * i, 4096 + h * 256 + scc));
    if (tid < 128) { const size_t gi = (size_t)bh * 2048 + c * 128 + tid; const float a = ((const float*)(p.ws + W_AS))[gi], cm = ((const float*)(p.ws + W_CM))[gi], bt = ((const float*)(p.ws + W_BS))[gi];
        const float mi = ((const float*)(p.ws + W_MINIT))[bh * 16 + c]; const float M = fmaxf(mi, cm);
        al[tid] = a; Ml[tid] = M; wil[tid] = __expf(mi - M); emtl[tid] = __expf(-(bt + M)); }
    if (tid < 256) nin[tid] = c > 0 ? ((const float*)(p.ws + W_NINIT))[((size_t)bh * 16 + c) * 256 + tid] : 0.f;
    RS[wid * 128 + lane] = 0.f; RS[wid * 128 + 64 + lane] = 0.f;
    lds_barrier();
    u32x2 preg[5];
#pragma unroll
    for (int it = 0; it < 5; ++it) {
        const int idx = wid + 8 * it;
        preg[it] = (u32x2){0u, 0u};
        if (idx < 36) {
            int tt = 0; while (idx >= (tt + 1) * (tt + 2) / 2) ++tt;
            const int st = idx - tt * (tt + 1) / 2;
            f32x4 sacc = (f32x4){0.f, 0.f, 0.f, 0.f};
#pragma unroll
            for (int kk = 0; kk < 8; ++kk) { const bf16x8 B = frag_rm(KVL, 264, 16 * st, 32 * kk, lane), A = frag_rm(QL, 264, 16 * tt, 32 * kk, lane); MMA_T(sacc, B, A); }
            const int t = 16 * tt + (lane & 15), s0 = 16 * st + (lane >> 4) * 4; const float M = Ml[t]; float pv[4]; float ps = 0.f;
#pragma unroll
            for (int j = 0; j < 4; ++j) { const int s = s0 + j; pv[j] = s <= t ? sacc[j] * __expf(fminf(al[s] - M, 0.f)) : 0.f; ps += pv[j]; }
            ps += __shfl_xor(ps, 16); ps += __shfl_xor(ps, 32);
            if (lane < 16) RS[wid * 128 + t] += ps;
            preg[it].x = pk2(pv[0], pv[1]); preg[it].y = pk2(pv[2], pv[3]);
        }
    }
    {   const int t = tid >> 2, sub = tid & 3; float qn = 0.f;
#pragma unroll 8
        for (int i = 0; i < 64; ++i) { const int d = sub * 64 + i; qn += bf2f(QL[t * 264 + d]) * nin[d]; }
        qn += __shfl_xor(qn, 1); qn += __shfl_xor(qn, 2);
        if (sub == 0) QN[t] = qn; }
    f32x4 acc[8][2];
#pragma unroll
    for (int i = 0; i < 8; ++i) { acc[i][0] = (f32x4){0.f, 0.f, 0.f, 0.f}; acc[i][1] = (f32x4){0.f, 0.f, 0.f, 0.f}; }
    if (c > 0) {
        const u16* cb = CT + (((size_t)bh * 16 + c) * 256 + 32 * wid + (lane & 15)) * 256 + (lane >> 4) * 8;
#pragma unroll
        for (int kk = 0; kk < 8; ++kk) { const bf16x8 B0 = *(const bf16x8*)(cb + 32 * kk), B1 = *(const bf16x8*)(cb + 16 * 256 + 32 * kk);
#pragma unroll
            for (int tt = 0; tt < 8; ++tt) { const bf16x8 A = frag_rm(QL, 264, 16 * tt, 32 * kk, lane); MMA_T(acc[tt][0], B0, A); MMA_T(acc[tt][1], B1, A); } }
#pragma unroll
        for (int tt = 0; tt < 8; ++tt) { const float w = wil[16 * tt + (lane & 15)]; acc[tt][0] *= w; acc[tt][1] *= w; }
    }
    lds_barrier();
    LAS u16* PL = QL;
#pragma unroll
    for (int it = 0; it < 5; ++it) {
        const int idx = wid + 8 * it;
        if (idx < 36) {
            int tt = 0; while (idx >= (tt + 1) * (tt + 2) / 2) ++tt;
            const int st = idx - tt * (tt + 1) / 2;
            const int t = 16 * tt + (lane & 15), s0 = 16 * st + (lane >> 4) * 4;
            *(LAS u32x2*)(PL + t * 136 + s0) = preg[it];
            if (st == tt && (tt & 1) == 0) *(LAS u32x2*)(PL + t * 136 + s0 + 16) = (u32x2){0u, 0u};
        }
    }
#pragma unroll
    for (int i = 0; i < 8; ++i) *(LAS u32x4*)(KVL + (sr + 16 * i) * 264 + scc) = vreg[i];
    if (tid < 128) { float dn = wil[tid] * QN[tid];
#pragma unroll
        for (int w = 0; w < 8; ++w) dn += RS[w * 128 + tid];
        DEN[tid] = dn; }
    lds_barrier();
#pragma unroll
    for (int kk = 0; kk < 4; ++kk) { const bf16x8 B0 = frag_tr(KVL, 264, 32 * wid, 32 * kk, lane), B1 = frag_tr(KVL, 264, 32 * wid + 16, 32 * kk, lane);
#pragma unroll
        for (int tt = 2 * kk; tt < 8; ++tt) { const bf16x8 A = frag_rm(PL, 136, 16 * tt, 32 * kk, lane); MMA_T(acc[tt][0], B0, A); MMA_T(acc[tt][1], B1, A); } }
#pragma unroll
    for (int tt = 0; tt < 8; ++tt) { const int tl = 16 * tt + (lane & 15); const float inv = 1.0f / fmaxf(fabsf(DEN[tl]), emtl[tl]); float s1 = 0.f, s2 = 0.f;
#pragma unroll
        for (int et = 0; et < 2; ++et) { acc[tt][et] *= inv;
#pragma unroll
            for (int j = 0; j < 4; ++j) { s1 += acc[tt][et][j]; s2 += acc[tt][et][j] * acc[tt][et][j]; } }
        s1 += __shfl_xor(s1, 16); s1 += __shfl_xor(s1, 32); s2 += __shfl_xor(s2, 16); s2 += __shfl_xor(s2, 32);
        if (lane < 16) { LNS[(wid * 128 + tl) * 2] = s1; LNS[(wid * 128 + tl) * 2 + 1] = s2; } }
    lds_barrier();
#pragma unroll
    for (int tt = 0; tt < 8; ++tt) { const int tl = 16 * tt + (lane & 15); float s1 = 0.f, s2 = 0.f;
#pragma unroll
        for (int w = 0; w < 8; ++w) { s1 += LNS[(w * 128 + tl) * 2]; s2 += LNS[(w * 128 + tl) * 2 + 1]; }
        const float mean = s1 * (1.0f / 256.0f), rstd = rsqrtf(fmaxf(s2 * (1.0f / 256.0f) - mean * mean, 0.f) + 1e-6f);
#pragma unroll
        for (int et = 0; et < 2; ++et) { const int e = 32 * wid + 16 * et + (lane >> 4) * 4;
            u32x2 o; o.x = pk2((acc[tt][et][0] - mean) * rstd, (acc[tt][et][1] - mean) * rstd); o.y = pk2((acc[tt][et][2] - mean) * rstd, (acc[tt][et][3] - mean) * rstd);
            *(LAS u32x2*)(KVL + tl * 264 + e) = o; } }
    lds_barrier();
    {   u16* H = (u16*)(p.ws + W_H); float ng[8];
#pragma unroll
        for (int j = 0; j < 8; ++j) ng[j] = p.in[22][h * 256 + scc + j];
        u32x4 ma[8], so[8], gb[8];
#pragma unroll
        for (int i = 0; i < 8; ++i) { const size_t zr = R0 + sr + 16 * i; ma[i] = *(const u32x4*)(Z + zo(zr, h * 256 + scc)); so[i] = *(const u32x4*)(Z + zo(zr, 5 * 1024 + h * 256 + scc)); gb[i] = *(const u32x4*)(Z + zo(zr, 7 * 1024 + h * 256 + scc)); }
#pragma unroll
        for (int i = 0; i < 8; ++i) { const int r = sr + 16 * i; float hn[8], m8[8], s8[8], g8[8]; unpack8(*(LAS const u32x4*)(KVL + r * 264 + scc), hn); unpack8(ma[i], m8); unpack8(so[i], s8); unpack8(gb[i], g8);
#pragma unroll
            for (int j = 0; j < 8; ++j) hn[j] = m8[j] + sigm(g8[j]) * sigm(s8[j]) * hn[j] * ng[j];
            *(u32x4*)(H + (R0 + r) * 1024 + h * 256 + scc) = pack8(hn); } }
    lds_barrier();
}

__device__ __forceinline__ void phase_mix3(const Params& p, LAS unsigned char* lds) {
#pragma unroll 1
    for (int u = blockIdx.x; u < 512; u += gridDim.x) { const int c = u & 15, bh = u >> 4; out_prompt_unit(p, lds, bh >> 2, bh & 3, c); }
}

#define XB_TMO      128
#define XB_XCNT(j)  (256  + 64 * (j))
#define XB_XSUB(j)  (1280 + 64 * (j))
#define XB_XGEN(j)  (2304 + 64 * (j))
#define XB_TOP      3328
#define XB_TOPGEN   3392
#define XCD_BAR_WORDS 3456
#define XB_SPIN_CAP (1u << 18)
__device__ __forceinline__ unsigned xb_ld(unsigned* p)              { return __hip_atomic_load(p, __ATOMIC_RELAXED, __HIP_MEMORY_SCOPE_AGENT); }
__device__ __forceinline__ unsigned xb_add(unsigned* p, unsigned v) { return __hip_atomic_fetch_add(p, v, __ATOMIC_RELAXED, __HIP_MEMORY_SCOPE_AGENT); }
__device__ __forceinline__ unsigned xb_xcc_id() { return (unsigned)__builtin_amdgcn_s_getreg((3 << 11) | 20) & 0xFu; }
#define XB_SPIN(cond, bar) do { unsigned _sp = 0; while (cond) { __builtin_amdgcn_s_sleep(1); \
    if ((++_sp & 255u) == 0u) { if (xb_ld(&(bar)[XB_TMO])) break; if (_sp > XB_SPIN_CAP) { atomicAdd(&(bar)[XB_TMO], 1u); break; } } } } while (0)
struct XcdBarrier { unsigned* bar; unsigned x; volatile LAS unsigned* st; };
__device__ __forceinline__ XcdBarrier xcd_barrier_post(unsigned* bar, volatile LAS unsigned* st) {
    XcdBarrier b; b.bar = bar; b.x = xb_xcc_id(); b.st = st;
    if (threadIdx.x == 0) (void)xb_add(&bar[XB_XCNT(b.x)], 1u);
    return b;
}
__device__ __forceinline__ void xcd_barrier_complete(unsigned* bar, unsigned x, unsigned& nloc, unsigned& nx) {
    const unsigned G = gridDim.x * gridDim.y * gridDim.z;
    unsigned sum, cnt, mine, sp = 0u;
    for (;;) {
        sum = 0u; cnt = 0u; mine = 0u;
#pragma unroll
        for (unsigned j = 0; j < 16; ++j) { const unsigned c = xb_ld(&bar[XB_XCNT(j)]); sum += c; cnt += (c > 0u) ? 1u : 0u; mine = (j == x) ? c : mine; }
        if (sum == G) break;
        __builtin_amdgcn_s_sleep(1);
        if ((++sp & 255u) == 0u) { if (xb_ld(&bar[XB_TMO])) break; if (sp > XB_SPIN_CAP) { atomicAdd(&bar[XB_TMO], 1u); break; } }
    }
    nloc = mine > 0u ? mine : 1u; nx = cnt > 0u ? cnt : 1u;
}
__device__ __forceinline__ void xcd_barrier(const XcdBarrier& b) {
    asm volatile("s_waitcnt vmcnt(0)" ::: "memory");
    __syncthreads();
    if (threadIdx.x == 0) {
        unsigned* bar = b.bar;
        __builtin_amdgcn_s_waitcnt(0);
        unsigned nloc = b.st[0], nx = b.st[1];
        if (nloc == 0u) { xcd_barrier_complete(bar, b.x, nloc, nx); b.st[0] = nloc; b.st[1] = nx; }
        const unsigned old = xb_add(&bar[XB_XSUB(b.x)], 1u);
        const unsigned gen = old / nloc;
        if (old + 1u == (gen + 1u) * nloc) {
            __builtin_amdgcn_fence(__ATOMIC_RELEASE, "agent");
            asm volatile("s_waitcnt vmcnt(0)" ::: "memory");
            const unsigned og = xb_add(&bar[XB_TOP], 1u);
            const unsigned tg = og / nx;
            if (og + 1u == (tg + 1u) * nx) xb_add(&bar[XB_TOPGEN], 1u);
            else XB_SPIN(xb_ld(&bar[XB_TOPGEN]) == tg, bar);
            __builtin_amdgcn_fence(__ATOMIC_ACQUIRE, "agent");
            xb_add(&bar[XB_XGEN(b.x)], 1u);
            asm volatile("s_waitcnt vmcnt(0)" ::: "memory");
        } else {
            XB_SPIN(xb_ld(&bar[XB_XGEN(b.x)]) == gen, bar);
            __builtin_amdgcn_fence(__ATOMIC_ACQUIRE, "agent");
            asm volatile("s_waitcnt vmcnt(0)" ::: "memory");
        }
    }
    __syncthreads();
}

constexpr int NPHASE = 14;
__device__ __forceinline__ void run_phase(int ph, const Params& p, LAS unsigned char* lds) {
    unsigned char* ws = p.ws; const float* ADA = (const float*)(ws + W_ADA); float* X = p.out + O_Y;
    u16* H = (u16*)(ws + W_H); u16* ACT = (u16*)(ws + W_ACT);
    switch (ph) {
        case 0: phase_convert(p, lds, 1632, 2336, 0, (int)gridDim.x, true); break;
        case 1: { EpiF32B E; E.C = (float*)(ws + W_ADA); E.ldc = ADAC; E.bias = (const float*)(ws + W_BIAS); run_gemm(lds, (const u16*)(ws + W_CS), (const u16*)(ws + W_WBA), 256, ADAC, 1024, E);
                  const int nb = (int)gridDim.x - 44;
                  phase_convert(p, lds, 0, 7 * nb, 44, nb, false); phase_convert(p, lds, 7 * nb, 1632, 0, 44, false); } break;
        case 2: phase_prep<0>(p, lds); break;
        case 3: { EpiSwiglu E; E.O = ACT; run_gemm(lds, H, (const u16*)(ws + W_WB1), MR, 5632, 1024, E); } break;
        case 4: { EpiResid<true> E; E.XinF = p.in[0]; E.XinB = nullptr; E.Xout = (u16*)p.out; E.XoutT = (float*)(ws + W_SLAB); E.gate = ADA + 2 * 1024; E.coef = 0.5f; E.ntf = FF / 64; E.pk = 8 * 64; run_gemm(lds, ACT, (const u16*)(ws + W_WB2), MR, 1024, FF, E, 5, 8, 4); } break;
        case 5: phase_prep<1>(p, lds); break;
        case 6: { EpiZ E; E.O = (u16*)(ws + W_Z); E.vst = (float*)(ws + W_VST); run_gemm(lds, H, (const u16*)(ws + W_WB3), MR, ZC, 1024, E); } break;
        case 7: phase_mix1(p, lds); break;
        case 8: phase_mix2(p, lds); break;
        case 9: phase_mix3(p, lds); break;
        case 10: { EpiResid<false> E; E.XinF = nullptr; E.XinB = (const u16*)p.out; E.Xout = (u16*)(ws + W_X2); E.XoutT = (float*)(ws + W_SLAB); E.gate = ADA + 5 * 1024; E.coef = 1.0f; E.ntf = 16; E.pk = 4 * 64; run_gemm(lds, H, (const u16*)(ws + W_WB4), MR, 1024, 1024, E, 4, 4, 4); } break;
        case 11: phase_prep<2>(p, lds); break;
        case 12: { EpiSwiglu E; E.O = ACT; run_gemm(lds, H, (const u16*)(ws + W_WB5), MR, 5632, 1024, E); } break;
        case 13: { EpiResid<false> E; E.XinF = nullptr; E.XinB = (const u16*)(ws + W_X2); E.Xout = (u16*)(ws + W_X3); E.XoutT = (float*)(ws + W_SLAB); E.gate = ADA + 8 * 1024; E.coef = 0.5f; E.ntf = FF / 64; E.pk = 8 * 64; run_gemm(lds, ACT, (const u16*)(ws + W_WB6), MR, 1024, FF, E, 5, 8, 4); } break;
        default: phase_prep<3>(p, lds); break;
    }
}

#if FUSED
__global__ void __launch_bounds__(512, 2) mega_kernel(Params p) {
    extern __shared__ __attribute__((aligned(16))) unsigned char shm[];
    cg::grid_group grid = cg::this_grid();
    LAS unsigned char* lds = (LAS unsigned char*)shm;
    volatile LAS unsigned* st = (volatile LAS unsigned*)(lds + LDS_BYTES);
    if (threadIdx.x == 0) { st[0] = 0u; st[1] = 0u; st[2] = 0u; st[3] = 0u; }
    __syncthreads();
    const XcdBarrier xb = xcd_barrier_post((unsigned*)(p.ws + W_BAR), st);
    run_phase(0, p, lds); grid.sync();
    run_phase(1, p, lds); xcd_barrier(xb); run_phase(2, p, lds); xcd_barrier(xb); run_phase(3, p, lds); xcd_barrier(xb);
    run_phase(4, p, lds); xcd_barrier(xb); run_phase(5, p, lds); xcd_barrier(xb); run_phase(6, p, lds); xcd_barrier(xb); run_phase(7, p, lds); xcd_barrier(xb);
    run_phase(8, p, lds); xcd_barrier(xb); run_phase(9, p, lds); xcd_barrier(xb); run_phase(10, p, lds); xcd_barrier(xb); run_phase(11, p, lds); xcd_barrier(xb);
    run_phase(12, p, lds); xcd_barrier(xb); run_phase(13, p, lds); xcd_barrier(xb); run_phase(14, p, lds);
}
#else
template <int PH> __global__ void __launch_bounds__(512, 2) phase_kernel(Params p) {
    extern __shared__ __attribute__((aligned(16))) unsigned char shm[];
    run_phase(PH, p, (LAS unsigned char*)shm);
}
template <int PH> static void launch_phase(const Params& p, int grid, hipStream_t stream) {
    static bool attr = false;
    if (!attr) { hipFuncSetAttribute((const void*)phase_kernel<PH>, hipFuncAttributeMaxDynamicSharedMemorySize, LDS_BYTES); attr = true; }
    hipLaunchKernelGGL(phase_kernel<PH>, dim3(grid), dim3(512), LDS_BYTES, stream, p);
}
#endif

extern "C" void kernel_launch(void* const* d_in, const int* in_sizes, int n_in, void* d_out, int out_size, void* d_ws, size_t ws_size, hipStream_t stream) {
    static int grid = 0;
    if (grid == 0) {
        if (n_in != 30 || ws_size < W_END) { fprintf(stderr, "kernel_launch: need 30 inputs and %zu workspace bytes; got %d, %zu\n", (size_t)W_END, n_in, ws_size); grid = -1; return; }
        int dev = 0, cus = 0;
        hipGetDevice(&dev); hipDeviceGetAttribute(&cus, hipDeviceAttributeMultiprocessorCount, dev);
#if FUSED
        int per_cu = 0;
        hipFuncSetAttribute((const void*)mega_kernel, hipFuncAttributeMaxDynamicSharedMemorySize, LDS_BYTES + 16);
        hipOccupancyMaxActiveBlocksPerMultiprocessor(&per_cu, (const void*)mega_kernel, 512, LDS_BYTES + 16);
        if (per_cu < 1) { fprintf(stderr, "kernel_launch: occupancy query says %d blocks per CU\n", per_cu); grid = -1; return; }
        grid = cus;
#else
        grid = cus;
#endif
    }
    if (grid < 0) return;
    Params p{};
    for (int i = 0; i < 30; ++i) p.in[i] = (const float*)d_in[i];
    p.out = (float*)d_out; p.ws = (unsigned char*)d_ws;
#if FUSED
    hipMemsetAsync((unsigned char*)d_ws + W_BAR, 0, 16384, stream);
    void* args[] = {&p};
    hipError_t e = hipLaunchCooperativeKernel((const void*)mega_kernel, dim3(grid), dim3(512), args, LDS_BYTES + 16, stream);
    if (e != hipSuccess) fprintf(stderr, "cooperative launch failed: %s (grid %d)\n", hipGetErrorString(e), grid);
#else
    launch_phase<0>(p, grid, stream); launch_phase<1>(p, grid, stream); launch_phase<2>(p, grid, stream); launch_phase<3>(p, grid, stream); launch_phase<4>(p, grid, stream);
    launch_phase<5>(p, grid, stream); launch_phase<6>(p, grid, stream); launch_phase<7>(p, grid, stream); launch_phase<8>(p, grid, stream); launch_phase<9>(p, grid, stream);
    launch_phase<10>(p, grid, stream); launch_phase<11>(p, grid, stream); launch_phase<12>(p, grid, stream); launch_phase<13>(p, grid, stream); launch_phase<14>(p, grid, stream);
#endif
}
```

```cpp
#include <hip/hip_runtime.h>
#include <hip/hip_cooperative_groups.h>
#include <cstdio>
namespace cg = cooperative_groups;
#ifndef FUSED
#define FUSED 1
#endif
__device__ __forceinline__ int tid_opaque() { int t = (int)threadIdx.x; asm volatile("" : "+v"(t)); return t; }
namespace pg8 {
#define PG8_LAS __attribute__((address_space(3)))
typedef unsigned short bf16_t;
typedef short bf16x8 __attribute__((ext_vector_type(8)));
typedef float f32x4 __attribute__((ext_vector_type(4)));
typedef unsigned u32x4 __attribute__((ext_vector_type(4)));
constexpr int BM = 256, BK = 64, HALF = 128, HTB = HALF * BK * 2  , STAGE_BYTES = 8 * HTB, NXCD = 8, WGM = 8;

__host__ __device__ __forceinline__ int lds_byte(int r, int c) { const int st = (r >> 4) * 2 + (c >> 5), rr = r & 15, cc = c & 31, ob = rr * 64 + cc * 2; return st * 1024 + (ob ^ (((ob >> 9) & 1) << 5)); }
__host__ __device__ __forceinline__ void stage_rc(int b, int& R, int& C) { const int st = b / 1024, sb = b % 1024, swz = sb ^ (((sb >> 9) & 1) << 5); R = (st >> 1) * 16 + swz / 64; C = (st & 1) * 32 + (swz % 64) / 2; }
__host__ __device__ __forceinline__ int perm32(int rho) { const int n = rho >> 4, i = rho & 15; return 8 * (i >> 2) + 4 * n + (i & 3); }

struct Unit { int pm, pn, k0, nt; };
struct Gemm { const bf16_t* A; const bf16_t* Bt; int M, N, K; };

struct StaticOrder {
    int nM, nN, nwg, G, c, ntf, ppu, pnt, nMt;
    __host__ __device__ void init(int M, int N, int G_, int c_, int ntf_ = 0, int ppu_ = 0, int pnt_ = 0, int nMt_ = 0) { nM = M / BM - (ppu_ > 0 ? nMt_ : 0); nN = N / BM; nwg = nM * nN; G = G_; c = c_; ntf = ntf_; ppu = ppu_; pnt = pnt_; nMt = nMt_; }
    __host__ __device__ void map(int wgid, Unit& u) const {
        { const int q = nwg / NXCD, r = nwg % NXCD, xcd = wgid % NXCD, off = wgid / NXCD; wgid = (xcd < r ? xcd * (q + 1) : r * (q + 1) + (xcd - r) * q) + off; }
        const int nig = WGM * nN, gid = wgid / nig, fm = gid * WGM, gsz = (nM - fm) < WGM ? (nM - fm) : WGM;
        u.pm = fm + ((wgid % nig) % gsz); u.pn = (wgid % nig) / gsz;
    }
    __host__ __device__ bool next(int i, Unit& u) const {
        const long L = (long)i * G + c;
        if (L < nwg) { map((int)L, u); u.k0 = 0; u.nt = ntf; return true; }
        if (ppu == 0) return false;
        const int full = ((nwg + G - 1) / G) * G; if (L < full) return false;
        const int q = (int)(L - full); if (q >= nMt * nN * ppu) return false;
        const int pi = q % ppu, j = q / ppu; u.pm = nM + j % nMt; u.pn = j / nMt; u.k0 = pi * pnt * BK; u.nt = (pi == ppu - 1) ? ntf - pnt * (ppu - 1) : pnt; return true;
    }
    __device__ __forceinline__ void a_ready(const Unit&) const {}
    __device__ __forceinline__ void done(const Unit&) const {}
};
typedef __bf16 bf16x2_t __attribute__((ext_vector_type(2)));
typedef float f32x2_t __attribute__((ext_vector_type(2)));
__device__ __forceinline__ unsigned cvt_pk_bf16(float lo, float hi) { return __builtin_bit_cast(unsigned, __builtin_convertvector((f32x2_t){lo, hi}, bf16x2_t)); }
template <class Epi, class Sched, bool STAMP = false>
__device__ __forceinline__ void gemm_phase(PG8_LAS unsigned char* lds, const Gemm g, const Sched& S, const Epi& E, unsigned long long* stamps) {
    const int tid = tid_opaque(), wid = __builtin_amdgcn_readfirstlane(tid >> 6), lane = tid & 63, wr = wid >> 2, wc = wid & 3, fr = lane & 15, fq = lane >> 4;
    const int K = g.K;
    int ts_lo = 0, ts_hi = 0, nts = 0; const unsigned long long rt_entry = STAMP ? (unsigned long long)wall_clock64() : 0ull;
#define PG8_STAMP() do { if (STAMP && wid == 0 && nts < 64) { const unsigned long long _c = (unsigned long long)clock64(); \
        ts_lo = (lane == nts) ? (int)(unsigned)_c : ts_lo; ts_hi = (lane == nts) ? (int)(unsigned)(_c >> 32) : ts_hi; ++nts; } } while (0)
    PG8_STAMP();
    unsigned voffA[2], voffB[2];
#pragma unroll
    for (int i = 0; i < 2; ++i) { int R, C; stage_rc(tid * 16 + i * 8192, R, C); const int Rb = Epi::PERM ? ((R & ~31) + perm32(R & 31)) : R;
        voffA[i] = (unsigned)(R * K + C) * 2u; voffB[i] = (unsigned)(Rb * K + C) * 2u; }
    const size_t kstep = (size_t)(BK * 2);
    const size_t hstep = (size_t)HALF * K * 2;
    const size_t tstep = 2 * hstep;
    const unsigned ldsw = (unsigned)wid * 1024u;
    const int aoff = lds_byte(wr * 64 + fr, fq * 8), boff = lds_byte(wc * 32 + fr, fq * 8);
#define PG8_SA(b, h) (((b) * 2 + (h)) * HTB)
#define PG8_SB(b, h) ((4 + (b) * 2 + (h)) * HTB)
#define PG8_STAGE(bufoff, gbase, voff) do { _Pragma("unroll") for (int _i = 0; _i < 2; ++_i) \
        __builtin_amdgcn_global_load_lds((const unsigned*)((const char*)(gbase) + (voff)[_i]), (PG8_LAS unsigned*)(lds + (bufoff) + ldsw + _i * 8192), 16, 0, 0); } while (0)
#define PG8_LDA(dst, b, h) do { _Pragma("unroll") for (int m = 0; m < 4; ++m) _Pragma("unroll") for (int k = 0; k < 2; ++k) dst[m][k] = *(const PG8_LAS bf16x8*)(lds + PG8_SA(b, h) + aoff + m * 2048 + k * 1024); } while (0)
#define PG8_LDB(dst, b, h) do { _Pragma("unroll") for (int n = 0; n < 2; ++n) _Pragma("unroll") for (int k = 0; k < 2; ++k) dst[n][k] = *(const PG8_LAS bf16x8*)(lds + PG8_SB(b, h) + boff + n * 2048 + k * 1024); } while (0)
#define PG8_MMA(ai, bj, At, Bt) do { __builtin_amdgcn_s_setprio(1); _Pragma("unroll") for (int m = 0; m < 4; ++m) _Pragma("unroll") for (int n = 0; n < 2; ++n) _Pragma("unroll") for (int k = 0; k < 2; ++k) \
        acc[ai][bj][m][n] = __builtin_amdgcn_mfma_f32_16x16x32_bf16(Bt[n][k], At[m][k], acc[ai][bj][m][n], 0, 0, 0); __builtin_amdgcn_s_setprio(0); } while (0)
#define PG8_WAIT_V(n) asm volatile("s_waitcnt vmcnt(" #n ")" ::: "memory")
#define PG8_WAIT_L(n) asm volatile("s_waitcnt lgkmcnt(" #n ")" ::: "memory")
#define PG8_BAR __builtin_amdgcn_s_barrier()
#define PG8_SCHED __builtin_amdgcn_sched_barrier(0)
    Unit cur, nxt; int ui = 0;
    if (!S.next(0, cur)) return;
    f32x4 acc[2][2][4][2];
#pragma unroll
    for (int a = 0; a < 2; ++a)
#pragma unroll
        for (int b = 0; b < 2; ++b)
#pragma unroll
            for (int m = 0; m < 4; ++m)
#pragma unroll
                for (int n = 0; n < 2; ++n) acc[a][b][m][n] = (f32x4){0.f, 0.f, 0.f, 0.f};
    bf16x8 At[4][2], B0[2][2], B1[2][2];
    const char* cA = (const char*)g.A + (size_t)cur.pm * tstep + (size_t)cur.k0 * 2; const char* cB = (const char*)g.Bt + (size_t)cur.pn * tstep + (size_t)cur.k0 * 2;
    S.a_ready(cur);
    PG8_STAGE(PG8_SB(0, 0), cB, voffB); PG8_STAGE(PG8_SA(0, 0), cA, voffA); PG8_STAGE(PG8_SB(0, 1), cB + hstep, voffB); PG8_STAGE(PG8_SA(0, 1), cA + hstep, voffA);
    if (wr == 1) PG8_BAR;
    PG8_WAIT_V(4); PG8_BAR;
    PG8_STAGE(PG8_SB(1, 0), cB + kstep, voffB); PG8_STAGE(PG8_SA(1, 0), cA + kstep, voffA); PG8_STAGE(PG8_SB(1, 1), cB + hstep + kstep, voffB);
    PG8_WAIT_V(6); PG8_BAR;
    PG8_STAMP();
    for (;;) {
        const bool has_next = S.next(ui + 1, nxt);
        const char* nA = has_next ? (const char*)g.A + (size_t)nxt.pm * tstep + (size_t)nxt.k0 * 2 : cA; const char* nB = has_next ? (const char*)g.Bt + (size_t)nxt.pn * tstep + (size_t)nxt.k0 * 2 : cB;
        const int nt = cur.nt;
        for (int t = 0; t < nt; t += 2) {
            const bool last = (t == nt - 2);
            const char* a1 = cA + (size_t)(t + 1) * kstep;
            const char* a2 = last ? nA : cA + (size_t)(t + 2) * kstep; const char* b2 = last ? nB : cB + (size_t)(t + 2) * kstep;
            const char* a3 = a2 + kstep; const char* b3 = b2 + kstep;
            if (last && has_next) S.a_ready(nxt);
            PG8_LDB(B0, 0, 0); PG8_SCHED; PG8_LDA(At, 0, 0); PG8_STAGE(PG8_SA(1, 1), a1 + hstep, voffA);
            PG8_WAIT_L(8); PG8_BAR; PG8_WAIT_L(0); PG8_MMA(0, 0, At, B0); PG8_BAR; PG8_SCHED;
            PG8_LDB(B1, 0, 1); PG8_STAGE(PG8_SB(0, 0), b2, voffB);
            PG8_BAR; PG8_WAIT_L(0); PG8_MMA(0, 1, At, B1); PG8_BAR;
            PG8_LDA(At, 0, 1); PG8_STAGE(PG8_SA(0, 0), a2, voffA);
            PG8_BAR; PG8_WAIT_L(0); PG8_MMA(1, 0, At, B0); PG8_BAR; PG8_SCHED;
            PG8_STAGE(PG8_SB(0, 1), b2 + hstep, voffB);
            PG8_WAIT_V(6); PG8_BAR; PG8_MMA(1, 1, At, B1); PG8_BAR;
            PG8_LDB(B0, 1, 0); PG8_SCHED; PG8_LDA(At, 1, 0); PG8_STAGE(PG8_SA(0, 1), a2 + hstep, voffA);
            PG8_WAIT_L(8); PG8_BAR; PG8_WAIT_L(0); PG8_MMA(0, 0, At, B0); PG8_BAR; PG8_SCHED;
            PG8_LDB(B1, 1, 1); PG8_STAGE(PG8_SB(1, 0), b3, voffB);
            PG8_BAR; PG8_WAIT_L(0); PG8_MMA(0, 1, At, B1); PG8_BAR;
            PG8_LDA(At, 1, 1); PG8_STAGE(PG8_SA(1, 0), a3, voffA);
            PG8_BAR; PG8_WAIT_L(0); PG8_MMA(1, 0, At, B0); PG8_BAR; PG8_SCHED;
            PG8_STAGE(PG8_SB(1, 1), b3 + hstep, voffB);
            PG8_WAIT_V(6); PG8_BAR; PG8_MMA(1, 1, At, B1); PG8_BAR;
        }
        PG8_STAMP();
        if constexpr (!Epi::AFTER_DRAIN) { E(acc, cur, wr, wc, fr, fq); S.done(cur); }
        PG8_STAMP();
        if (!has_next) break;
#pragma unroll
        for (int a = 0; a < 2; ++a)
#pragma unroll
            for (int b = 0; b < 2; ++b)
#pragma unroll
                for (int m = 0; m < 4; ++m)
#pragma unroll
                    for (int n = 0; n < 2; ++n) acc[a][b][m][n] = (f32x4){0.f, 0.f, 0.f, 0.f};
        cur = nxt; cA = nA; cB = nB; ++ui;
    }
    PG8_WAIT_V(0);
    if (wr == 0) PG8_BAR;
    PG8_BAR;
    if constexpr (Epi::AFTER_DRAIN) { E.fused(acc, cur, wr, wc, fr, fq, lds, wid, lane); S.done(cur); }
    PG8_STAMP();
    if (STAMP && wid == 0) { stamps[lane] = lane < nts ? (((unsigned long long)(unsigned)ts_hi << 32) | (unsigned)ts_lo) : 0ull;
        if (lane == 62) stamps[62] = rt_entry; if (lane == 63) stamps[63] = (unsigned long long)wall_clock64(); }
#undef PG8_STAMP
#undef PG8_SA
#undef PG8_SB
#undef PG8_STAGE
#undef PG8_LDA
#undef PG8_LDB
#undef PG8_MMA
#undef PG8_WAIT_V
#undef PG8_WAIT_L
#undef PG8_BAR
#undef PG8_SCHED
}
}

#define LAS __attribute__((address_space(3)))
typedef unsigned short u16;
typedef short bf16x8 __attribute__((ext_vector_type(8)));
typedef short s16x4 __attribute__((ext_vector_type(4)));
typedef float f32x4 __attribute__((ext_vector_type(4)));
typedef unsigned u32x4 __attribute__((ext_vector_type(4)));
typedef unsigned u32x2 __attribute__((ext_vector_type(2)));

constexpr int DM = 1024, NPR = 16384, NSR = 1024, MR = NPR + NSR, FF = 2816, ZC = 8192, ADAC = 11264;
constexpr int LDS_BYTES = 151552;
constexpr size_t W_WB1 = 0;
constexpr size_t W_WB2 = W_WB1 + (size_t)5632 * 1024 * 2;
constexpr size_t W_WB3 = W_WB2 + (size_t)1024 * 2816 * 2;
constexpr size_t W_WB4 = W_WB3 + (size_t)8192 * 1024 * 2;
constexpr size_t W_WB5 = W_WB4 + (size_t)1024 * 1024 * 2;
constexpr size_t W_WB6 = W_WB5 + (size_t)5632 * 1024 * 2;
constexpr size_t W_CS = W_WB6 + (size_t)1024 * 2816 * 2;
constexpr size_t W_BIAS = W_CS + (size_t)256 * 1024 * 2;
constexpr size_t W_WG = W_BIAS + (size_t)ADAC * 4;
constexpr size_t W_ADA = W_WG + (size_t)8 * 1024 * 4;
constexpr size_t W_H = W_ADA + (size_t)256 * ADAC * 4;
constexpr size_t W_GATES = W_H + (size_t)MR * 1024 * 2;
constexpr size_t W_BS = W_GATES + (size_t)MR * 8 * 4;
constexpr size_t W_AS = W_BS + (size_t)32 * 2048 * 4;
constexpr size_t W_CM = W_AS + (size_t)32 * 2048 * 4;
constexpr size_t W_MINIT = W_CM + (size_t)32 * 2048 * 4;
constexpr size_t W_NINIT = W_MINIT + 4096;
constexpr size_t W_Z = W_NINIT + (size_t)32 * 16 * 256 * 4;
constexpr size_t W_ACT = W_Z;
constexpr size_t W_SLAB = W_Z + (size_t)200 * 1024 * 1024;
constexpr size_t W_X3 = W_Z + (size_t)164 * 1024 * 1024;
constexpr size_t W_X2 = W_Z + (size_t)128 * 1024 * 1024;
constexpr size_t W_QB = W_Z + (size_t)MR * ZC * 2;
constexpr size_t W_KB = W_QB + (size_t)MR * 1024 * 2;
constexpr size_t W_CT = W_KB + (size_t)MR * 1024 * 2;
constexpr size_t W_WBA = W_CT;
constexpr size_t W_BAR = W_CT + (size_t)32 * 16 * 65536 * 2;
constexpr size_t W_VST = W_BAR + 16384;
constexpr size_t W_XS = W_VST + (size_t)MR * 32 * 4;
constexpr size_t W_END = W_XS + (size_t)NSR * 1024 * 4;
constexpr size_t O_Y = 0;
constexpr size_t O_CP = (size_t)MR * 1024;
constexpr size_t O_NP = O_CP + (size_t)8 * 4 * 65536;
constexpr size_t O_MP = O_NP + 8 * 4 * 256;
constexpr size_t O_CVP = O_MP + 32;
constexpr size_t O_CS = O_CVP + 8 * 3 * 2048;
constexpr size_t O_NS = O_CS + (size_t)128 * 4 * 65536;
constexpr size_t O_MS = O_NS + 128 * 4 * 256;
constexpr size_t O_CVS = O_MS + 512;
constexpr size_t O_VS = O_CVS + 128 * 3 * 2048;

struct Params { const float* in[30]; float* out; unsigned char* ws; };

__device__ __forceinline__ float bf2f(u16 b) { return __uint_as_float(((unsigned)b) << 16); }
__device__ __forceinline__ float bflo(unsigned w) { return __uint_as_float(w << 16); }
__device__ __forceinline__ float bfhi(unsigned w) { return __uint_as_float(w & 0xffff0000u); }
__device__ __forceinline__ unsigned pk2(float lo, float hi) { return pg8::cvt_pk_bf16(lo, hi); }
__device__ __forceinline__ float sigm(float x) { return __builtin_amdgcn_rcpf(1.0f + __builtin_amdgcn_exp2f(-1.4426950408889634f * x)); }
__device__ __forceinline__ float gelu_t(float x) { return x * sigm(1.5957691216057308f * (x + 0.044715f * x * x * x)); }
__device__ __forceinline__ size_t zo(size_t row, int col) { return ((size_t)(col >> 8) * MR + row) * 256 + (col & 255); }
__device__ __forceinline__ size_t qo(size_t row, int col) { return ((size_t)(col >> 8) * MR + row) * 256 + (col & 255); }
__device__ __forceinline__ int bidx(int row) { return row < NPR ? (row >> 11) : 8 + ((row - NPR) >> 3); }
__device__ __forceinline__ float wsum(float v) {
#pragma unroll
    for (int o = 32; o > 0; o >>= 1) v += __shfl_xor(v, o);
    return v;
}
__device__ __forceinline__ void unpack8(const u32x4 v, float* f) { f[0] = bflo(v.x); f[1] = bfhi(v.x); f[2] = bflo(v.y); f[3] = bfhi(v.y); f[4] = bflo(v.z); f[5] = bfhi(v.z); f[6] = bflo(v.w); f[7] = bfhi(v.w); }
__device__ __forceinline__ u32x4 pack8(const float* f) { u32x4 r; r.x = pk2(f[0], f[1]); r.y = pk2(f[2], f[3]); r.z = pk2(f[4], f[5]); r.w = pk2(f[6], f[7]); return r; }

__device__ __forceinline__ void lds_barrier() { asm volatile("s_waitcnt lgkmcnt(0)\n\ts_barrier" ::: "memory"); }
__device__ __forceinline__ bf16x8 frag_rm(LAS const u16* base, int stride, int r0, int k0, int lane) {
    return *(LAS const bf16x8*)(base + (r0 + (lane & 15)) * stride + k0 + (lane >> 4) * 8);
}
__device__ __forceinline__ bf16x8 frag_tr(LAS const u16* base, int stride, int n0, int k0, int lane) {
    const int g = lane >> 4, li = lane & 15, q = li >> 2, pp = li & 3;
    LAS const u16* a = base + (k0 + g * 8 + q) * stride + n0 + 4 * pp;
    const s16x4 lo = __builtin_amdgcn_ds_read_tr16_b64_v4i16((LAS s16x4*)a);
    const s16x4 hi = __builtin_amdgcn_ds_read_tr16_b64_v4i16((LAS s16x4*)(a + 4 * stride));
    return (bf16x8){lo[0], lo[1], lo[2], lo[3], hi[0], hi[1], hi[2], hi[3]};
}
#define MMA_T(acc, Bf, Af) acc = __builtin_amdgcn_mfma_f32_16x16x32_bf16(Bf, Af, acc, 0, 0, 0)

struct EpiF32B {
    static constexpr bool PERM = false, AFTER_DRAIN = false;
    float* C; int ldc; const float* bias;
    __device__ __forceinline__ void operator()(const f32x4 (&acc)[2][2][4][2], const pg8::Unit& u, int wr, int wc, int fr, int fq) const {
        const int row0 = u.pm * 256 + wr * 64 + fr, col0 = u.pn * 256 + wc * 32 + 4 * fq;
#pragma unroll
        for (int ai = 0; ai < 2; ++ai)
#pragma unroll
            for (int m = 0; m < 4; ++m) { float* rowp = C + (size_t)(row0 + ai * 128 + m * 16) * ldc + col0;
#pragma unroll
                for (int bj = 0; bj < 2; ++bj)
#pragma unroll
                    for (int n = 0; n < 2; ++n) *(f32x4*)(rowp + bj * 128 + n * 16) = acc[ai][bj][m][n] + *(const f32x4*)(bias + col0 + bj * 128 + n * 16); }
    }
};
struct EpiSwiglu {
    static constexpr bool PERM = true, AFTER_DRAIN = false;
    u16* O;
    __device__ __forceinline__ void operator()(const f32x4 (&acc)[2][2][4][2], const pg8::Unit& u, int wr, int wc, int fr, int fq) const {
        const int row0 = u.pm * 256 + wr * 64 + fr, col0 = u.pn * 128 + wc * 32 + 8 * fq;
#pragma unroll
        for (int ai = 0; ai < 2; ++ai)
#pragma unroll
            for (int m = 0; m < 4; ++m) { u16* rowp = O + (size_t)(row0 + ai * 128 + m * 16) * FF + col0;
                float o[8];
#pragma unroll
                for (int n = 0; n < 2; ++n)
#pragma unroll
                    for (int j = 0; j < 4; ++j) { const float a = acc[ai][0][m][n][j], b = acc[ai][1][m][n][j]; o[n * 4 + j] = a * sigm(a) * b; }
                *(u32x4*)rowp = pack8(o); }
    }
};
struct EpiZ {
    static constexpr bool PERM = true, AFTER_DRAIN = false;
    u16* O; float* vst;
    template <bool GELU> __device__ __forceinline__ void body(const f32x4 (&acc)[2][2][4][2], const pg8::Unit& u, int wr, int wc, int fr, int fq) const {
        const int row0 = u.pm * 256 + wr * 64 + fr, col0 = u.pn * 256 + wc * 32 + 8 * fq;
#pragma unroll
        for (int ai = 0; ai < 2; ++ai)
#pragma unroll
            for (int m = 0; m < 4; ++m) { u16* rowp = O + zo((size_t)(row0 + ai * 128 + m * 16), col0); float s1 = 0.f, s2 = 0.f;
#pragma unroll
                for (int bj = 0; bj < 2; ++bj) { float o[8];
#pragma unroll
                    for (int n = 0; n < 2; ++n)
#pragma unroll
                        for (int j = 0; j < 4; ++j) { const float v = acc[ai][bj][m][n][j]; o[n * 4 + j] = GELU ? gelu_t(v) : v; if (GELU) { s1 += o[n * 4 + j]; s2 += o[n * 4 + j] * o[n * 4 + j]; } }
                    *(u32x4*)(rowp + bj * 128) = pack8(o); }
                if (GELU) { s1 += __shfl_xor(s1, 16); s1 += __shfl_xor(s1, 32); s2 += __shfl_xor(s2, 16); s2 += __shfl_xor(s2, 32);
                    if (fq == 0) { float* q = vst + ((size_t)(row0 + ai * 128 + m * 16) * 16 + (u.pn & 3) * 4 + wc) * 2; q[0] = s1; q[1] = s2; } } }
    }
    __device__ __forceinline__ void operator()(const f32x4 (&acc)[2][2][4][2], const pg8::Unit& u, int wr, int wc, int fr, int fq) const {
        if ((u.pn >> 2) == 1) body<true>(acc, u, wr, wc, fr, fq); else body<false>(acc, u, wr, wc, fr, fq);
    }
};
template <bool XF32> struct EpiResid {
    static constexpr bool PERM = true, AFTER_DRAIN = false;
    const float* __restrict__ XinF; const u16* __restrict__ XinB; u16* __restrict__ Xout; float* __restrict__ XoutT; const float* __restrict__ gate; float coef; int ntf, pk;
    __device__ __forceinline__ void operator()(const f32x4 (&acc)[2][2][4][2], const pg8::Unit& u, int wr, int wc, int fr, int fq) const {
        const int row0 = u.pm * 256 + wr * 64 + fr, col0 = u.pn * 256 + wc * 32 + 8 * fq;
        if (u.nt == ntf) {
#pragma unroll
            for (int ai = 0; ai < 2; ++ai)
#pragma unroll
                for (int m = 0; m < 4; ++m) { const int row = row0 + ai * 128 + m * 16; const float* gp = gate + (size_t)bidx(row) * ADAC + col0;
#pragma unroll
                    for (int bj = 0; bj < 2; ++bj) { const int o = bj * 128; float x[8];
                        if (XF32) { const f32x4 a = *(const f32x4*)(XinF + (size_t)row * 1024 + col0 + o), b = *(const f32x4*)(XinF + (size_t)row * 1024 + col0 + o + 4);
#pragma unroll
                            for (int j = 0; j < 4; ++j) { x[j] = a[j]; x[4 + j] = b[j]; } }
                        else unpack8(*(const u32x4*)(XinB + (size_t)row * 1024 + col0 + o), x);
                        const f32x4 g0 = *(const f32x4*)(gp + o), g1 = *(const f32x4*)(gp + o + 4);
#pragma unroll
                        for (int j = 0; j < 4; ++j) { x[j] += coef * g0[j] * acc[ai][bj][m][0][j]; x[4 + j] += coef * g1[j] * acc[ai][bj][m][1][j]; }
                        *(u32x4*)(Xout + (size_t)row * 1024 + col0 + o) = pack8(x); } }
        } else {
            float* sl = XoutT + (size_t)(u.k0 / pk) * ((size_t)NSR * 1024);
#pragma unroll
            for (int ai = 0; ai < 2; ++ai)
#pragma unroll
                for (int m = 0; m < 4; ++m) { const int row = row0 + ai * 128 + m * 16;
                    const float* gp = gate + (size_t)bidx(row) * ADAC + col0; float* op = sl + (size_t)(row - NPR) * 1024 + col0;
#pragma unroll
                    for (int bj = 0; bj < 2; ++bj) { const int o = bj * 128;
                        *(f32x4*)(op + o) = coef * (*(const f32x4*)(gp + o)) * acc[ai][bj][m][0]; *(f32x4*)(op + o + 4) = coef * (*(const f32x4*)(gp + o + 4)) * acc[ai][bj][m][1]; } }
        }
    }
};
template <class Epi> __device__ __forceinline__ void run_gemm(LAS unsigned char* lds, const u16* A, const u16* Bt, int M, int N, int K, const Epi& E, int ppu = 0, int pnt = 0, int nMt = 0) {
    pg8::Gemm g; g.A = A; g.Bt = Bt; g.M = M; g.N = N; g.K = K;
    pg8::StaticOrder S; S.init(M, N, (int)gridDim.x, (int)blockIdx.x, K / 64, ppu, pnt, nMt);
    pg8::gemm_phase<Epi, pg8::StaticOrder, false>(lds, g, S, E, nullptr);
}

__device__ __forceinline__ void phase_convert(const Params& p, LAS unsigned char* lds, int t_begin, int t_end, int first_wg, int n_wg, bool extras) {
    const int tid = tid_opaque();
    LAS u16* T = (LAS u16*)lds;
    constexpr int NJ = 8;
    const int jn[NJ] = {5632, 1024, 8192, 1024, 5632, 1024, 9216, 2048};
    const int jk[NJ] = {1024, 2816, 1024, 1024, 1024, 2816, 1024, 1024};
    int total = 0;
#pragma unroll
    for (int j = 0; j < NJ; ++j) total += (jn[j] / 256) * (jk[j] / 64);
    (void)total;
    for (int t = t_begin + ((int)blockIdx.x - first_wg); (int)blockIdx.x >= first_wg && (int)blockIdx.x < first_wg + n_wg && t < t_end; t += n_wg) {
        int lt = t, job = 0;
#pragma unroll
        for (int j = 0; j < NJ - 1; ++j) { const int c = (jn[j] / 256) * (jk[j] / 64); if (job == j && lt >= c) { lt -= c; job = j + 1; } }
        const float* src; int ld, K, mode; u16* dst;
        switch (job) {
            case 0: src = p.in[11]; ld = 5632; K = 1024; mode = 1; dst = (u16*)(p.ws + W_WB1); break;
            case 1: src = p.in[12]; ld = 1024; K = 2816; mode = 0; dst = (u16*)(p.ws + W_WB2); break;
            case 2: src = p.in[14]; ld = 8200; K = 1024; mode = 2; dst = (u16*)(p.ws + W_WB3); break;
            case 3: src = p.in[23]; ld = 1024; K = 1024; mode = 0; dst = (u16*)(p.ws + W_WB4); break;
            case 4: src = p.in[25]; ld = 5632; K = 1024; mode = 1; dst = (u16*)(p.ws + W_WB5); break;
            case 5: src = p.in[26]; ld = 1024; K = 2816; mode = 0; dst = (u16*)(p.ws + W_WB6); break;
            case 6: src = p.in[8]; ld = 9216; K = 1024; mode = 0; dst = (u16*)(p.ws + W_WBA); break;
            default: src = p.in[27]; ld = 2048; K = 1024; mode = 0; dst = (u16*)(p.ws + W_WBA) + (size_t)9216 * 1024; break;
        }
        const int nk = K / 64, tn = lt / nk, tk = lt - tn * nk, n0 = tn * 256, k0 = tk * 64;
        const int c4 = (tid & 63) * 4, kr = tid >> 6;
        int sc;
        if (mode == 1) sc = (c4 < 128) ? tn * 128 + c4 : FF + tn * 128 + (c4 - 128);
        else if (mode == 2) sc = (n0 < 6144 ? n0 : n0 + 8) + c4;
        else sc = n0 + c4;
        f32x4 v[8];
#pragma unroll
        for (int i = 0; i < 8; ++i) v[i] = *(const f32x4*)(src + (size_t)(k0 + kr + 8 * i) * ld + sc);
#pragma unroll
        for (int i = 0; i < 8; ++i) { const int k = kr + 8 * i;
            const unsigned a = pk2(v[i][0], v[i][1]), b = pk2(v[i][2], v[i][3]);
            T[(c4 + 0) * 72 + k] = (u16)a; T[(c4 + 1) * 72 + k] = (u16)(a >> 16); T[(c4 + 2) * 72 + k] = (u16)b; T[(c4 + 3) * 72 + k] = (u16)(b >> 16); }
        __syncthreads();
#pragma unroll
        for (int i = 0; i < 4; ++i) { const int q = tid + 512 * i, n = q >> 3, k8 = (q & 7) * 8;
            *(u32x4*)(dst + (size_t)(n0 + n) * K + k0 + k8) = *(LAS const u32x4*)(T + n * 72 + k8); }
        __syncthreads();
    }
    if (!extras) return;
    const int gt = blockIdx.x * 512 + tid, gs = gridDim.x * 512;
    u16* CS = (u16*)(p.ws + W_CS);
    for (int i = gt; i < 256 * 1024; i += gs) { const int r = i >> 10, c = i & 1023; float v = 0.f;
        if (r < 8) v = p.in[2][r * 1024 + c]; else if (r < 136) v = p.in[3][(r - 8) * 1024 + c];
        v = v * sigm(v); CS[i] = (u16)(pk2(v, 0.f) & 0xffffu); }
    float* BIAS = (float*)(p.ws + W_BIAS);
    for (int i = gt; i < ADAC; i += gs) BIAS[i] = i < 9216 ? p.in[9][i] : p.in[28][i - 9216];
    float* WG = (float*)(p.ws + W_WG);
    for (int i = gt; i < 8192; i += gs) { const int j = i >> 10, k = i & 1023; WG[i] = p.in[14][(size_t)k * 8200 + 6144 + j]; }
}

template <int WHICH> __device__ __forceinline__ void phase_prep(const Params& p, LAS unsigned char* lds) {
    const int tid = tid_opaque(), lane = tid & 63, wid = tid >> 6;
    const float* ADA = (const float*)(p.ws + W_ADA);
    float* Y = p.out + O_Y;
    u16* H = (u16*)(p.ws + W_H);
    float* XS = (float*)(p.ws + W_XS);
    const float* gv = WHICH == 0 ? p.in[10] : WHICH == 1 ? p.in[13] : WHICH == 2 ? p.in[24] : p.in[29];
    const int jsh = WHICH == 3 ? 9 : 3 * WHICH, jsc = jsh + 1;
    LAS float* WGL = (LAS float*)lds;
    if (WHICH == 1) { const f32x4* wg = (const f32x4*)(p.ws + W_WG);
#pragma unroll
        for (int i = 0; i < 4; ++i) *(LAS f32x4*)(WGL + (tid + 512 * i) * 4) = wg[tid + 512 * i];
        lds_barrier(); }
    for (int row = blockIdx.x * 8 + wid; row < MR; row += gridDim.x * 8) {
        const float* ab = ADA + (size_t)bidx(row) * ADAC;
        float v[2][8]; float ss = 0.f;
#pragma unroll
        for (int i = 0; i < 2; ++i) { const int c = i * 512 + lane * 8;
            if (WHICH == 0) { const float* xr = (row < NPR ? p.in[0] + (size_t)row * 1024 : p.in[1] + (size_t)(row - NPR) * 1024) + c;
                const f32x4 a = *(const f32x4*)xr, b = *(const f32x4*)(xr + 4);
#pragma unroll
                for (int j = 0; j < 4; ++j) { v[i][j] = a[j]; v[i][4 + j] = b[j]; } }
            else if (row < NPR) { const u16* xb = WHICH == 1 ? (const u16*)p.out : WHICH == 2 ? (const u16*)(p.ws + W_X2) : (const u16*)(p.ws + W_X3);
                unpack8(*(const u32x4*)(xb + (size_t)row * 1024 + c), v[i]); }
            else {
                float* xs = XS + (size_t)(row - NPR) * 1024 + c; f32x4 a = *(const f32x4*)xs, b = *(const f32x4*)(xs + 4);
                const float* sl = (const float*)(p.ws + W_SLAB) + (size_t)(row - NPR) * 1024 + c;
#pragma unroll
                for (int pi = 0; pi < (WHICH == 2 ? 4 : 5); ++pi) { a += *(const f32x4*)(sl + (size_t)pi * NSR * 1024); b += *(const f32x4*)(sl + (size_t)pi * NSR * 1024 + 4); }
                if (WHICH < 3) { *(f32x4*)xs = a; *(f32x4*)(xs + 4) = b; }
#pragma unroll
                for (int j = 0; j < 4; ++j) { v[i][j] = a[j]; v[i][4 + j] = b[j]; } }
#pragma unroll
            for (int j = 0; j < 8; ++j) ss += v[i][j] * v[i][j]; }
        ss = wsum(ss);
        const float rstd = rsqrtf(ss * (1.0f / 1024.0f) + 1e-6f);
        float ga[8];
#pragma unroll
        for (int j = 0; j < 8; ++j) ga[j] = 0.f;
#pragma unroll
        for (int i = 0; i < 2; ++i) { const int c = i * 512 + lane * 8; float h[8];
#pragma unroll
            for (int q = 0; q < 2; ++q) { const f32x4 g4 = *(const f32x4*)(gv + c + 4 * q), s4 = *(const f32x4*)(ab + jsc * 1024 + c + 4 * q), h4 = *(const f32x4*)(ab + jsh * 1024 + c + 4 * q);
#pragma unroll
                for (int j = 0; j < 4; ++j) h[4 * q + j] = v[i][4 * q + j] * rstd * g4[j] * (1.0f + s4[j]) + h4[j]; }
            if (WHICH == 0 && row >= NPR) { float* xs = XS + (size_t)(row - NPR) * 1024 + c;
                *(f32x4*)xs = (f32x4){v[i][0], v[i][1], v[i][2], v[i][3]}; *(f32x4*)(xs + 4) = (f32x4){v[i][4], v[i][5], v[i][6], v[i][7]}; }
            if (WHICH == 3) { float* y = Y + (size_t)row * 1024 + c; *(f32x4*)y = (f32x4){h[0], h[1], h[2], h[3]}; *(f32x4*)(y + 4) = (f32x4){h[4], h[5], h[6], h[7]}; }
            else *(u32x4*)(H + (size_t)row * 1024 + c) = pack8(h);
            if (WHICH == 1) {
#pragma unroll
                for (int j = 0; j < 8; ++j) { const f32x4 w0 = *(LAS const f32x4*)(WGL + j * 1024 + c), w1 = *(LAS const f32x4*)(WGL + j * 1024 + c + 4);
                    ga[j] += h[0] * w0[0] + h[1] * w0[1] + h[2] * w0[2] + h[3] * w0[3] + h[4] * w1[0] + h[5] * w1[1] + h[6] * w1[2] + h[7] * w1[3]; } }
        }
        if (WHICH == 1) {
            float mine = 0.f;
#pragma unroll
            for (int j = 0; j < 8; ++j) { const float s = wsum(ga[j]); if (lane == j) mine = s; }
            if (lane < 8) ((float*)(p.ws + W_GATES))[(size_t)row * 8 + lane] = mine + p.in[15][lane];
        }
    }
}

__device__ __forceinline__ void gmlp_prompt_unit(const Params& p, LAS unsigned char* lds, int b, int c, int g) {
    const int tid = tid_opaque(), lane = tid & 63, wid = tid >> 6;
    LAS float* mu = (LAS float*)lds; LAS float* rs = mu + 128;
    LAS u16* WL = (LAS u16*)(lds + 1024);
    LAS u16* VL = (LAS u16*)(lds + 1024 + 34816);
    u16* Z = (u16*)(p.ws + W_Z);
    const size_t R0 = (size_t)b * 2048 + c * 128;
    if (tid < 128) { const f32x4* q = (const f32x4*)((const float*)(p.ws + W_VST) + (R0 + tid) * 32); float s = 0.f, ss = 0.f;
#pragma unroll
        for (int i = 0; i < 8; ++i) { const f32x4 v = q[i]; s += v[0] + v[2]; ss += v[1] + v[3]; }
        const float m = s * (1.0f / 1024.0f); const float var = fmaxf(ss * (1.0f / 1024.0f) - m * m, 0.f); mu[tid] = m; rs[tid] = rsqrtf(var + 1e-6f); }
    {   const float* w = p.in[20] + (size_t)g * 16384;
#pragma unroll
        for (int i = 0; i < 8; ++i) { const int q = tid + 512 * i, t = q >> 5, s = (q & 31) * 4; const f32x4 v = *(const f32x4*)(w + t * 128 + s);
            u32x2 o; o.x = pk2(s <= t ? v[0] : 0.f, s + 1 <= t ? v[1] : 0.f); o.y = pk2(s + 2 <= t ? v[2] : 0.f, s + 3 <= t ? v[3] : 0.f);
            *(LAS u32x2*)(WL + t * 136 + s) = o; } }
    lds_barrier();
    {   const int cc = (tid & 31) * 8; float lg[8], lb[8];
#pragma unroll
        for (int j = 0; j < 8; ++j) { lg[j] = p.in[18][g * 256 + cc + j]; lb[j] = p.in[19][g * 256 + cc + j]; }
        u32x4 vv[8];
#pragma unroll
        for (int i = 0; i < 8; ++i) { const int r = (tid + 512 * i) >> 5; vv[i] = *(const u32x4*)(Z + zo(R0 + r, 1024 + g * 256 + cc)); }
#pragma unroll
        for (int i = 0; i < 8; ++i) { const int r = (tid + 512 * i) >> 5; const float m = mu[r], rsd = rs[r]; float f[8]; unpack8(vv[i], f);
#pragma unroll
            for (int j = 0; j < 8; ++j) f[j] = (f[j] - m) * rsd * lg[j] + lb[j];
            *(LAS u32x4*)(VL + r * 264 + cc) = pack8(f); } }
    lds_barrier();
    f32x4 acc[8][2];
#pragma unroll
    for (int i = 0; i < 8; ++i) { acc[i][0] = (f32x4){0.f, 0.f, 0.f, 0.f}; acc[i][1] = (f32x4){0.f, 0.f, 0.f, 0.f}; }
#pragma unroll
    for (int kk = 0; kk < 4; ++kk) {
        const bf16x8 B0 = frag_tr(VL, 264, 32 * wid, 32 * kk, lane), B1 = frag_tr(VL, 264, 32 * wid + 16, 32 * kk, lane);
#pragma unroll
        for (int i = 0; i < 8; ++i) if (32 * kk <= 16 * i + 15) { const bf16x8 A = frag_rm(WL, 136, 16 * i, 32 * kk, lane); MMA_T(acc[i][0], B0, A); MMA_T(acc[i][1], B1, A); }
    }
    const int cc = (tid & 31) * 8;
    u32x4 gu[8], ga[8];
#pragma unroll
    for (int i = 0; i < 8; ++i) { const int r = (tid + 512 * i) >> 5; gu[i] = *(const u32x4*)(Z + zo(R0 + r, g * 256 + cc)); ga[i] = *(const u32x4*)(Z + zo(R0 + r, 6 * 1024 + g * 256 + cc)); }
    lds_barrier();
    const float* bs = p.in[21] + g * 128;
#pragma unroll
    for (int i = 0; i < 8; ++i) { const int t = 16 * i + (lane & 15); const float bsv = bs[t];
#pragma unroll
        for (int nn = 0; nn < 2; ++nn) { const int d = 32 * wid + 16 * nn + (lane >> 4) * 4;
            u32x2 o; o.x = pk2(acc[i][nn][0] + bsv, acc[i][nn][1] + bsv); o.y = pk2(acc[i][nn][2] + bsv, acc[i][nn][3] + bsv); *(LAS u32x2*)(VL + t * 264 + d) = o; } }
    lds_barrier();
#pragma unroll
    for (int i = 0; i < 8; ++i) { const int r = (tid + 512 * i) >> 5; float o[8], u8[8], a8[8]; unpack8(*(LAS const u32x4*)(VL + r * 264 + cc), o); unpack8(gu[i], u8); unpack8(ga[i], a8);
#pragma unroll
        for (int j = 0; j < 8; ++j) o[j] = sigm(a8[j]) * gelu_t(u8[j]) * o[j];
        *(u32x4*)(Z + zo(R0 + r, g * 256 + cc)) = pack8(o); }
    lds_barrier();
}

__device__ __forceinline__ void gmlp_sample_unit(const Params& p, LAS unsigned char* lds, int b) {
    const int tid = tid_opaque(), lane = tid & 63, wid = tid >> 6;
    LAS float* VS = (LAS float*)lds;
    u16* Z = (u16*)(p.ws + W_Z);
    const size_t r0 = (size_t)NPR + b * 8;
    {   const int t = wid; const u16* src = Z + zo(r0 + t, 1024 + lane * 16);
        float f[16]; unpack8(*(const u32x4*)src, f); unpack8(*(const u32x4*)(src + 8), f + 8);
        float s = 0.f, ss = 0.f;
#pragma unroll
        for (int j = 0; j < 16; ++j) { s += f[j]; ss += f[j] * f[j]; }
        s = wsum(s); ss = wsum(ss);
        const float m = s * (1.0f / 1024.0f), rsd = rsqrtf(fmaxf(ss * (1.0f / 1024.0f) - m * m, 0.f) + 1e-6f);
        float* vo = p.out + O_VS + ((size_t)b * 8 + t) * 1024 + lane * 16;
#pragma unroll
        for (int j = 0; j < 16; ++j) { const float v = (f[j] - m) * rsd * p.in[18][lane * 16 + j] + p.in[19][lane * 16 + j]; VS[t * 1024 + lane * 16 + j] = v; vo[j] = v; } }
    lds_barrier();
    {   const int c = tid * 2, g = c >> 8; const float* ws = p.in[20] + (size_t)g * 16384; const float* bs = p.in[21] + g * 128;
#pragma unroll
        for (int t = 0; t < 8; ++t) { float a0 = bs[t], a1 = a0;
#pragma unroll
            for (int s = 0; s <= t; ++s) { const float w = ws[t * 128 + s]; a0 += w * VS[s * 1024 + c]; a1 += w * VS[s * 1024 + c + 1]; }
            const size_t row = r0 + t; const unsigned gu = *(const unsigned*)(Z + zo(row, c)), ga = *(const unsigned*)(Z + zo(row, 6 * 1024 + c));
            *(unsigned*)(Z + zo(row, c)) = pk2(sigm(bflo(ga)) * gelu_t(bflo(gu)) * a0, sigm(bfhi(ga)) * gelu_t(bfhi(gu)) * a1); } }
    lds_barrier();
}

__device__ __forceinline__ void conv_unit(const Params& p, size_t rowbase, int nrows, int histmode, const float* hist, float* outconv) {
    const int tid = tid_opaque(), c4 = tid * 4;
    const u16* Z = (const u16*)(p.ws + W_Z);
    u16* dst = c4 < 1024 ? (u16*)(p.ws + W_QB) : (u16*)(p.ws + W_KB); const int dc = c4 & 1023;
    const float osc = c4 < 1024 ? 1.0f : 0.0625f;
    f32x4 w[4];
#pragma unroll
    for (int j = 0; j < 4; ++j) w[j] = *(const f32x4*)(p.in[16] + j * 2048 + c4);
    const f32x4 cb = *(const f32x4*)(p.in[17] + c4);
    f32x4 x[3];
#pragma unroll
    for (int j = 0; j < 3; ++j) {
        if (histmode == 0) x[j] = (f32x4){0.f, 0.f, 0.f, 0.f};
        else if (histmode == 1) { const u32x2 v = *(const u32x2*)(Z + zo(rowbase - 3 + j, 2048 + c4)); x[j] = (f32x4){bflo(v.x), bfhi(v.x), bflo(v.y), bfhi(v.y)}; }
        else x[j] = *(const f32x4*)(hist + j * 2048 + c4);
    }
#pragma unroll 8
    for (int t = 0; t < nrows; ++t) {
        const u32x2 v = *(const u32x2*)(Z + zo(rowbase + t, 2048 + c4));
        const f32x4 xv = (f32x4){bflo(v.x), bfhi(v.x), bflo(v.y), bfhi(v.y)};
        f32x4 y = cb + w[0] * x[0] + w[1] * x[1] + w[2] * x[2] + w[3] * xv;
        u32x2 o; o.x = pk2(y[0] * sigm(y[0]) * osc, y[1] * sigm(y[1]) * osc); o.y = pk2(y[2] * sigm(y[2]) * osc, y[3] * sigm(y[3]) * osc);
        *(u32x2*)(dst + qo(rowbase + t, dc)) = o;
        if (outconv && t >= nrows - 3) *(f32x4*)(outconv + (size_t)(t - (nrows - 3)) * 2048 + c4) = xv;
        x[0] = x[1]; x[1] = x[2]; x[2] = xv;
    }
}

__device__ __forceinline__ void conv_unit64(const Params& p, size_t rowbase, bool zero_hist, float* outconv) {
    const int tid = tid_opaque(), c8 = (tid & 255) * 8, rh = tid >> 8;
    const u16* Z = (const u16*)(p.ws + W_Z); const int zc = 2048 + c8;
    u16* dst = c8 < 1024 ? (u16*)(p.ws + W_QB) : (u16*)(p.ws + W_KB); const int dc = c8 & 1023;
    const float osc = c8 < 1024 ? 1.0f : 0.0625f;
    float w[4][8], cb[8], x[3][8];
#pragma unroll
    for (int j = 0; j < 4; ++j) { const f32x4 a = *(const f32x4*)(p.in[16] + j * 2048 + c8), b = *(const f32x4*)(p.in[16] + j * 2048 + c8 + 4);
#pragma unroll
        for (int e = 0; e < 4; ++e) { w[j][e] = a[e]; w[j][4 + e] = b[e]; } }
    {   const f32x4 a = *(const f32x4*)(p.in[17] + c8), b = *(const f32x4*)(p.in[17] + c8 + 4);
#pragma unroll
        for (int e = 0; e < 4; ++e) { cb[e] = a[e]; cb[4 + e] = b[e]; } }
    const size_t r0 = rowbase + 32 * rh;
    u32x4 cur[8], nxt[8];
#pragma unroll
    for (int i = 0; i < 8; ++i) cur[i] = *(const u32x4*)(Z + zo(r0 + i, zc));
#pragma unroll
    for (int j = 0; j < 3; ++j) {
        if (zero_hist && rh == 0) {
#pragma unroll
            for (int e = 0; e < 8; ++e) x[j][e] = 0.f; }
        else unpack8(*(const u32x4*)(Z + zo(r0 - 3 + j, zc)), x[j]);
    }
#pragma unroll
    for (int blk = 0; blk < 4; ++blk) {
        if (blk < 3) {
#pragma unroll
            for (int i = 0; i < 8; ++i) nxt[i] = *(const u32x4*)(Z + zo(r0 + 8 * (blk + 1) + i, zc)); }
#pragma unroll
        for (int i = 0; i < 8; ++i) { const int t = 8 * blk + i; float xv[8], o[8]; unpack8(cur[i], xv);
#pragma unroll
            for (int e = 0; e < 8; ++e) { const float y = cb[e] + w[0][e] * x[0][e] + w[1][e] * x[1][e] + w[2][e] * x[2][e] + w[3][e] * xv[e]; o[e] = y * sigm(y) * osc; }
            *(u32x4*)(dst + qo(r0 + t, dc)) = pack8(o);
            if (outconv && rh == 1 && t >= 29) { float* oc = outconv + (size_t)(t - 29) * 2048 + c8; *(f32x4*)oc = (f32x4){xv[0], xv[1], xv[2], xv[3]}; *(f32x4*)(oc + 4) = (f32x4){xv[4], xv[5], xv[6], xv[7]}; }
#pragma unroll
            for (int e = 0; e < 8; ++e) { x[0][e] = x[1][e]; x[1][e] = x[2][e]; x[2][e] = xv[e]; } }
        if (blk < 3) {
#pragma unroll
            for (int i = 0; i < 8; ++i) cur[i] = nxt[i]; }
    }
}

__device__ __forceinline__ void phase_mix1(const Params& p, LAS unsigned char* lds) {
    for (int u = blockIdx.x; u < 1024; u += gridDim.x) {
        if (u < 512) gmlp_prompt_unit(p, lds, u >> 6, (u >> 2) & 15, u & 3);
        else if (u < 768) { const int v = u - 512, b = v >> 5, hc = v & 31; conv_unit64(p, (size_t)b * 2048 + hc * 64, hc == 0, hc == 31 ? p.out + O_CVP + (size_t)b * 6144 : nullptr); }
        else if (u < 896) gmlp_sample_unit(p, lds, u - 768);
        else { const int b = u - 896; conv_unit(p, (size_t)NPR + b * 8, 8, 2, p.in[7] + (size_t)b * 6144, p.out + O_CVS + (size_t)b * 6144); }
    }
}

__device__ __forceinline__ float logsig(float f) { return fminf(f, 0.f) - log1pf(__expf(-fabsf(f))); }

__device__ __forceinline__ void scan_prompt_unit(const Params& p, LAS unsigned char* lds, int b, int h, int slab) {
    const int tid = tid_opaque(), lane = tid & 63, wid = tid >> 6, bh = b * 4 + h;
    LAS float* ASl = (LAS float*)lds;
    LAS float* Mc = ASl + 2048;
    LAS float* mi = Mc + 16;
    LAS float* bL = mi + 16;
    LAS float* amx = bL + 16;
    LAS u16* KL = (LAS u16*)(lds + 16384);
    LAS u16* VWL = (LAS u16*)(lds + 16384 + 67584);
    const float* GATES = (const float*)(p.ws + W_GATES);
    const u16* Z = (const u16*)(p.ws + W_Z); const u16* KB = (const u16*)(p.ws + W_KB);
    u16* CT = (u16*)(p.ws + W_CT);
    const size_t Rb = (size_t)b * 2048;
    u32x4 kreg[8], vreg[2];
    const int vr = tid >> 2, vcc = (tid & 3) * 16;
#pragma unroll
    for (int i = 0; i < 8; ++i) { const int q = tid + 512 * i, r = q >> 5, cc = (q & 31) * 8; kreg[i] = *(const u32x4*)(KB + qo(Rb + r, h * 256 + cc)); }
    vreg[0] = *(const u32x4*)(Z + zo(Rb + vr, 4096 + h * 256 + slab * 64 + vcc)); vreg[1] = *(const u32x4*)(Z + zo(Rb + vr, 4096 + h * 256 + slab * 64 + vcc + 8));
    {   const int p0 = tid * 4; float iv[4], bv[4], av[4], cm[4];
        float run = 0.f;
#pragma unroll
        for (int j = 0; j < 4; ++j) { const float* gp = GATES + (Rb + p0 + j) * 8; iv[j] = gp[h]; run += logsig(gp[4 + h]); bv[j] = run; }
        float sc = run;
#pragma unroll
        for (int d = 1; d < 32; d <<= 1) { const float o = __shfl_up(sc, d, 32); if ((lane & 31) >= d) sc += o; }
        const float off = sc - run;
        float rm = -INFINITY;
#pragma unroll
        for (int j = 0; j < 4; ++j) { bv[j] += off; av[j] = iv[j] - bv[j]; rm = fmaxf(rm, av[j]); cm[j] = rm; }
        float sm = rm;
#pragma unroll
        for (int d = 1; d < 32; d <<= 1) { const float o = __shfl_up(sm, d, 32); if ((lane & 31) >= d) sm = fmaxf(sm, o); }
        float em = __shfl_up(sm, 1, 32); if ((lane & 31) == 0) em = -INFINITY;
#pragma unroll
        for (int j = 0; j < 4; ++j) { cm[j] = fmaxf(cm[j], em); ASl[p0 + j] = av[j]; }
        if (slab == 0) {
            *(f32x4*)((float*)(p.ws + W_BS) + (size_t)bh * 2048 + p0) = (f32x4){bv[0], bv[1], bv[2], bv[3]};
            *(f32x4*)((float*)(p.ws + W_AS) + (size_t)bh * 2048 + p0) = (f32x4){av[0], av[1], av[2], av[3]};
            *(f32x4*)((float*)(p.ws + W_CM) + (size_t)bh * 2048 + p0) = (f32x4){cm[0], cm[1], cm[2], cm[3]}; }
        if ((lane & 31) == 31) { bL[p0 >> 7] = bv[3]; amx[p0 >> 7] = cm[3]; } }
    lds_barrier();
    if (tid == 0) { float m = 0.f;
        for (int c = 0; c < 16; ++c) { mi[c] = m; const float M = fmaxf(m, amx[c]); Mc[c] = M; if (slab == 0) ((float*)(p.ws + W_MINIT))[bh * 16 + c] = m; m = bL[c] + M; }
        if (slab == 0) p.out[O_MP + bh] = m; }
    lds_barrier();
    f32x4 acc[5][2];
#pragma unroll
    for (int i = 0; i < 5; ++i) { acc[i][0] = (f32x4){0.f, 0.f, 0.f, 0.f}; acc[i][1] = (f32x4){0.f, 0.f, 0.f, 0.f}; }
    for (int c = 0; c < 16; ++c) {
        const float M = Mc[c], ap = __expf(mi[c] - M);
        const float w = __expf(ASl[c * 128 + vr] - M);
#pragma unroll
        for (int i = 0; i < 8; ++i) { const int q = tid + 512 * i, r = q >> 5, cc = (q & 31) * 8; *(LAS u32x4*)(KL + r * 264 + cc) = kreg[i]; }
        {   float f[8];
#pragma unroll
            for (int q = 0; q < 2; ++q) { unpack8(vreg[q], f);
#pragma unroll
                for (int j = 0; j < 8; ++j) f[j] *= w;
                *(LAS u32x4*)(VWL + vr * 88 + vcc + 8 * q) = pack8(f); }
            if ((tid & 3) == 0) { u32x4 e; e.x = pk2(w, 0.f); e.y = 0u; e.z = 0u; e.w = 0u; *(LAS u32x4*)(VWL + vr * 88 + 64) = e; e.x = 0u; *(LAS u32x4*)(VWL + vr * 88 + 72) = e; } }
        lds_barrier();
        if (c < 15) { const size_t R1 = Rb + (c + 1) * 128;
#pragma unroll
            for (int i = 0; i < 8; ++i) { const int q = tid + 512 * i, r = q >> 5, cc = (q & 31) * 8; kreg[i] = *(const u32x4*)(KB + qo(R1 + r, h * 256 + cc)); }
            vreg[0] = *(const u32x4*)(Z + zo(R1 + vr, 4096 + h * 256 + slab * 64 + vcc)); vreg[1] = *(const u32x4*)(Z + zo(R1 + vr, 4096 + h * 256 + slab * 64 + vcc + 8)); }
#pragma unroll
        for (int i = 0; i < 5; ++i) { acc[i][0] *= ap; acc[i][1] *= ap; }
#pragma unroll
        for (int kk = 0; kk < 4; ++kk) {
            const bf16x8 B0 = frag_tr(KL, 264, 32 * wid, 32 * kk, lane), B1 = frag_tr(KL, 264, 32 * wid + 16, 32 * kk, lane);
#pragma unroll
            for (int et = 0; et < 4; ++et) { const bf16x8 A = frag_tr(VWL, 88, 16 * et, 32 * kk, lane); MMA_T(acc[et][0], B0, A); MMA_T(acc[et][1], B1, A); }
            if (slab == 0) { const bf16x8 A4 = frag_tr(VWL, 88, 64, 32 * kk, lane); MMA_T(acc[4][0], B0, A4); MMA_T(acc[4][1], B1, A4); }
        }
        if (c < 15) {
#pragma unroll
            for (int et = 0; et < 4; ++et)
#pragma unroll
                for (int dt = 0; dt < 2; ++dt) { const int e = slab * 64 + 16 * et + (lane & 15), d = 32 * wid + 16 * dt + (lane >> 4) * 4;
                    u32x2 o; o.x = pk2(acc[et][dt][0], acc[et][dt][1]); o.y = pk2(acc[et][dt][2], acc[et][dt][3]);
                    *(u32x2*)(CT + (((size_t)bh * 16 + c + 1) * 256 + e) * 256 + d) = o; }
            if (slab == 0 && (lane & 15) == 0) {
#pragma unroll
                for (int dt = 0; dt < 2; ++dt) { const int d = 32 * wid + 16 * dt + (lane >> 4) * 4; *(f32x4*)((float*)(p.ws + W_NINIT) + ((size_t)bh * 16 + c + 1) * 256 + d) = acc[4][dt]; } } }
        lds_barrier();
    }
#pragma unroll
    for (int et = 0; et < 4; ++et)
#pragma unroll
        for (int dt = 0; dt < 2; ++dt) { const int e = slab * 64 + 16 * et + (lane & 15), d = 32 * wid + 16 * dt + (lane >> 4) * 4;
#pragma unroll
            for (int j = 0; j < 4; ++j) p.out[O_CP + ((size_t)bh * 256 + d + j) * 256 + e] = acc[et][dt][j]; }
    if (slab == 0 && (lane & 15) == 0) {
#pragma unroll
        for (int dt = 0; dt < 2; ++dt) { const int d = 32 * wid + 16 * dt + (lane >> 4) * 4; *(f32x4*)(p.out + O_NP + (size_t)bh * 256 + d) = acc[4][dt]; } }
    lds_barrier();
}

__device__ __forceinline__ void sample_unit(const Params& p, LAS unsigned char* lds, int b, int h) {
    const int tid = tid_opaque(), lane = tid & 63, wid = tid >> 6, bh = b * 4 + h;
    LAS float* QF = (LAS float*)lds;
    LAS float* KF = QF + 2048;
    LAS float* KWF = KF + 2048;
    LAS float* VF = KWF + 2048;
    LAS float* NUM = VF + 2048;
    LAS float* SC = NUM + 16384;
    LAS float* QN = SC + 64;
    LAS float* sa = QN + 8;
    LAS float* sM = sa + 8;
    LAS float* swi = sM + 8;
    LAS float* semt = swi + 8;
    LAS float* sw7 = semt + 8;
    LAS float* sden = sw7 + 8;
    LAS float* smisc = sden + 8;
    const float* GATES = (const float*)(p.ws + W_GATES);
    const u16* Z = (const u16*)(p.ws + W_Z); const u16* QB = (const u16*)(p.ws + W_QB); const u16* KB = (const u16*)(p.ws + W_KB);
    const size_t r0 = (size_t)NPR + b * 8;
    const float m0 = p.in[6][bh];
    const int e4 = lane * 4, dg = wid * 32;
    const float* C0 = p.in[4] + (size_t)bh * 65536 + e4; float* Co = p.out + O_CS + (size_t)bh * 65536 + e4;
    f32x4 cpre[4];
#pragma unroll
    for (int u = 0; u < 4; ++u) cpre[u] = __builtin_nontemporal_load((const f32x4*)(C0 + (size_t)(dg + u) * 256));
    if (tid == 0) { float bc = 0.f, cm = -INFINITY; float a[8];
        for (int t = 0; t < 8; ++t) { const float* gp = GATES + (r0 + t) * 8; bc += logsig(gp[4 + h]); a[t] = gp[h] - bc; cm = fmaxf(cm, a[t]); const float M = fmaxf(m0, cm);
            sa[t] = a[t]; sM[t] = M; swi[t] = __expf(m0 - M); semt[t] = __expf(-(bc + M)); if (t == 7) { smisc[0] = __expf(m0 - M); smisc[1] = bc + M; } }
        const float M7 = sM[7];
        for (int s = 0; s < 8; ++s) sw7[s] = __expf(a[s] - M7); }
    {   const int t = tid >> 6, d4 = (tid & 63) * 4;
        const u32x2 q = *(const u32x2*)(QB + qo(r0 + t, h * 256 + d4)), k = *(const u32x2*)(KB + qo(r0 + t, h * 256 + d4)), v = *(const u32x2*)(Z + zo(r0 + t, 4096 + h * 256 + d4));
        QF[(d4 + 0) * 8 + t] = bflo(q.x); QF[(d4 + 1) * 8 + t] = bfhi(q.x); QF[(d4 + 2) * 8 + t] = bflo(q.y); QF[(d4 + 3) * 8 + t] = bfhi(q.y);
        KF[(d4 + 0) * 8 + t] = bflo(k.x); KF[(d4 + 1) * 8 + t] = bfhi(k.x); KF[(d4 + 2) * 8 + t] = bflo(k.y); KF[(d4 + 3) * 8 + t] = bfhi(k.y);
        *(LAS f32x4*)(VF + t * 256 + d4) = (f32x4){bflo(v.x), bfhi(v.x), bflo(v.y), bfhi(v.y)}; }
    lds_barrier();
    {   const int pair = tid >> 3, t = pair >> 3, s = pair & 7, sub = tid & 7; float dot = 0.f, qn = 0.f;
        const float* n0 = p.in[5] + (size_t)bh * 256;
#pragma unroll 8
        for (int i = 0; i < 32; ++i) { const int d = sub * 32 + i; const float q = QF[d * 8 + t]; dot += q * KF[d * 8 + s]; qn += q * n0[d]; }
        dot += __shfl_xor(dot, 1); dot += __shfl_xor(dot, 2); dot += __shfl_xor(dot, 4);
        qn += __shfl_xor(qn, 1); qn += __shfl_xor(qn, 2); qn += __shfl_xor(qn, 4);
        if (sub == 0) { SC[t * 8 + s] = s <= t ? dot * __expf(fminf(sa[s] - sM[t], 0.f)) : 0.f; if (s == 0) QN[t] = qn; }
        const int d = tid >> 1, s4 = (tid & 1) * 4;
#pragma unroll
        for (int j = 0; j < 4; ++j) KWF[d * 8 + s4 + j] = KF[d * 8 + s4 + j] * sw7[s4 + j]; }
    lds_barrier();
    if (tid < 8) { float dn = swi[tid] * QN[tid];
        for (int s = 0; s < 8; ++s) dn += SC[tid * 8 + s];
        sden[tid] = dn; }
    const float ap = smisc[0];
    {   f32x4 vv[8], num[8];
#pragma unroll
        for (int s = 0; s < 8; ++s) { vv[s] = *(LAS const f32x4*)(VF + s * 256 + e4); num[s] = (f32x4){0.f, 0.f, 0.f, 0.f}; }
#pragma unroll 1
        for (int i = 0; i < 32; i += 4) {
            f32x4 cnx[4];
            if (i + 4 < 32) {
#pragma unroll
                for (int u = 0; u < 4; ++u) cnx[u] = __builtin_nontemporal_load((const f32x4*)(C0 + (size_t)(dg + i + 4 + u) * 256)); }
#pragma unroll
            for (int u = 0; u < 4; ++u) { const int d = dg + i + u; const f32x4 c0 = cpre[u];
                const f32x4 q0 = *(LAS const f32x4*)(QF + d * 8), q1 = *(LAS const f32x4*)(QF + d * 8 + 4), k0 = *(LAS const f32x4*)(KWF + d * 8), k1 = *(LAS const f32x4*)(KWF + d * 8 + 4);
                f32x4 cn = ap * c0;
#pragma unroll
                for (int j = 0; j < 4; ++j) { num[j] += q0[j] * c0; num[4 + j] += q1[j] * c0; cn += k0[j] * vv[j] + k1[j] * vv[4 + j]; }
                __builtin_nontemporal_store(cn, (f32x4*)(Co + (size_t)d * 256)); }
            if (i + 4 < 32) {
#pragma unroll
                for (int u = 0; u < 4; ++u) cpre[u] = cnx[u]; }
        }
#pragma unroll
        for (int t = 0; t < 8; ++t) *(LAS f32x4*)(NUM + (wid * 8 + t) * 256 + e4) = num[t];
        if (tid < 256) { const int d = tid; float s = ap * p.in[5][(size_t)bh * 256 + d];
#pragma unroll
            for (int j = 0; j < 8; ++j) s += KWF[d * 8 + j];
            p.out[O_NS + (size_t)bh * 256 + d] = s; }
        if (tid == 0) p.out[O_MS + bh] = smisc[1]; }
    lds_barrier();
    {   const int t = wid; const float wi = swi[t], dn = fmaxf(fabsf(sden[t]), semt[t]);
        f32x4 n = (f32x4){0.f, 0.f, 0.f, 0.f};
#pragma unroll
        for (int g = 0; g < 8; ++g) n += *(LAS const f32x4*)(NUM + (g * 8 + t) * 256 + e4);
        n *= wi;
#pragma unroll
        for (int s = 0; s < 8; ++s) n += SC[t * 8 + s] * (*(LAS const f32x4*)(VF + s * 256 + e4));
        float hv[4]; float s1 = 0.f, s2 = 0.f;
#pragma unroll
        for (int j = 0; j < 4; ++j) { hv[j] = n[j] / dn; s1 += hv[j]; s2 += hv[j] * hv[j]; }
        s1 = wsum(s1); s2 = wsum(s2);
        const float mean = s1 * (1.0f / 256.0f), rstd = rsqrtf(fmaxf(s2 * (1.0f / 256.0f) - mean * mean, 0.f) + 1e-6f);
        const size_t row = r0 + t; const int col = h * 256 + e4;
        const u32x2 ma = *(const u32x2*)(Z + zo(row, col)), so = *(const u32x2*)(Z + zo(row, 5 * 1024 + col)), gb = *(const u32x2*)(Z + zo(row, 7 * 1024 + col));
        const f32x4 ng = *(const f32x4*)(p.in[22] + col);
        const float o0 = bflo(ma.x) + sigm(bflo(gb.x)) * sigm(bflo(so.x)) * (hv[0] - mean) * rstd * ng[0], o1 = bfhi(ma.x) + sigm(bfhi(gb.x)) * sigm(bfhi(so.x)) * (hv[1] - mean) * rstd * ng[1];
        const float o2 = bflo(ma.y) + sigm(bflo(gb.y)) * sigm(bflo(so.y)) * (hv[2] - mean) * rstd * ng[2], o3 = bfhi(ma.y) + sigm(bfhi(gb.y)) * sigm(bfhi(so.y)) * (hv[3] - mean) * rstd * ng[3];
        u32x2 o; o.x = pk2(o0, o1); o.y = pk2(o2, o3); *(u32x2*)((u16*)(p.ws + W_H) + row * 1024 + col) = o; }
    lds_barrier();
}

__device__ __forceinline__ void phase_mix2(const Params& p, LAS unsigned char* lds) {
    const int nscan = (int)gridDim.x / 2;
    if ((int)blockIdx.x < nscan) {
#pragma unroll 1
        for (int u = blockIdx.x; u < 128; u += nscan) { const int x = u & 7, j = u >> 3, bh = x * 4 + (j >> 2);
            scan_prompt_unit(p, lds, bh >> 2, bh & 3, j & 3); }
    }
    unsigned* ctr = (unsigned*)(p.ws + W_BAR) + 3584;
    LAS unsigned* slot = (LAS unsigned*)(lds + LDS_BYTES) + 2;
#pragma unroll 1
    for (;;) {
        if (tid_opaque() == 0) *slot = __hip_atomic_fetch_add(ctr, 1u, __ATOMIC_RELAXED, __HIP_MEMORY_SCOPE_AGENT);
        lds_barrier();
        const unsigned v = *slot;
        lds_barrier();
        if (v >= 512u) break;
        sample_unit(p, lds, (int)(v >> 2), (int)(v & 3));
    }
}

__device__ __forceinline__ void out_prompt_unit(const Params& p, LAS unsigned char* lds, int b, int h, int c) {
    const int tid = tid_opaque(), lane = tid & 63, wid = __builtin_amdgcn_readfirstlane(tid >> 6), bh = b * 4 + h;
    LAS u16* QL = (LAS u16*)lds;
    LAS u16* KVL = (LAS u16*)(lds + 67584);
    LAS float* al = (LAS float*)(lds + 135168);
    LAS float* Ml = al + 128;
    LAS float* wil = Ml + 128;
    LAS float* emtl = wil + 128;
    LAS float* RS = emtl + 128;
    LAS float* DEN = RS + 1024;
    LAS float* QN = DEN + 128;
    LAS float* nin = QN + 128;
    LAS float* LNS = nin + 256;
    const u16* Z = (const u16*)(p.ws + W_Z); const u16* QB = (const u16*)(p.ws + W_QB); const u16* KB = (const u16*)(p.ws + W_KB);
    const u16* CT = (const u16*)(p.ws + W_CT);
    const size_t R0 = (size_t)b * 2048 + c * 128;
    const int sr = tid >> 5, scc = (tid & 31) * 8;
    u32x4 vreg[8];
#pragma unroll
    for (int i = 0; i < 8; ++i) { const int r = sr + 16 * i;
        *(LAS u32x4*)(QL + r * 264 + scc) = *(const u32x4*)(QB + qo(R0 + r, h * 256 + scc));
        *(LAS u32x4*)(KVL + r * 264 + scc) = *(const u32x4*)(KB + qo(R0 + r, h * 256 + scc)); }
#pragma unroll
    for (int i = 0; i < 8; ++i) vreg[i] = *(const u32x4*)(Z + zo(R0 + sr + 16 * i, 4096 + h * 256 + scc));
    if (tid < 128) { const size_t gi = (size_t)bh * 2048 + c * 128 + tid; const float a = ((const float*)(p.ws + W_AS))[gi], cm = ((const float*)(p.ws + W_CM))[gi], bt = ((const float*)(p.ws + W_BS))[gi];
        const float mi = ((const float*)(p.ws + W_MINIT))[bh * 16 + c]; const float M = fmaxf(mi, cm);
        al[tid] = a; Ml[tid] = M; wil[tid] = __expf(mi - M); emtl[tid] = __expf(-(bt + M)); }
    if (tid < 256) nin[tid] = c > 0 ? ((const float*)(p.ws + W_NINIT))[((size_t)bh * 16 + c) * 256 + tid] : 0.f;
    RS[wid * 128 + lane] = 0.f; RS[wid * 128 + 64 + lane] = 0.f;
    lds_barrier();
    u32x2 preg[5];
#pragma unroll
    for (int it = 0; it < 5; ++it) {
        const int idx = wid + 8 * it;
        preg[it] = (u32x2){0u, 0u};
        if (idx < 36) {
            int tt = 0; while (idx >= (tt + 1) * (tt + 2) / 2) ++tt;
            const int st = idx - tt * (tt + 1) / 2;
            f32x4 sacc = (f32x4){0.f, 0.f, 0.f, 0.f};
#pragma unroll
            for (int kk = 0; kk < 8; ++kk) { const bf16x8 B = frag_rm(KVL, 264, 16 * st, 32 * kk, lane), A = frag_rm(QL, 264, 16 * tt, 32 * kk, lane); MMA_T(sacc, B, A); }
            const int t = 16 * tt + (lane & 15), s0 = 16 * st + (lane >> 4) * 4; const float M = Ml[t]; float pv[4]; float ps = 0.f;
#pragma unroll
            for (int j = 0; j < 4; ++j) { const int s = s0 + j; pv[j] = s <= t ? sacc[j] * __expf(fminf(al[s] - M, 0.f)) : 0.f; ps += pv[j]; }
            ps += __shfl_xor(ps, 16); ps += __shfl_xor(ps, 32);
            if (lane < 16) RS[wid * 128 + t] += ps;
            preg[it].x = pk2(pv[0], pv[1]); preg[it].y = pk2(pv[2], pv[3]);
        }
    }
    {   const int t = tid >> 2, sub = tid & 3; float qn = 0.f;
#pragma unroll 8
        for (int i = 0; i < 64; ++i) { const int d = sub * 64 + i; qn += bf2f(QL[t * 264 + d]) * nin[d]; }
        qn += __shfl_xor(qn, 1); qn += __shfl_xor(qn, 2);
        if (sub == 0) QN[t] = qn; }
    f32x4 acc[8][2];
#pragma unroll
    for (int i = 0; i < 8; ++i) { acc[i][0] = (f32x4){0.f, 0.f, 0.f, 0.f}; acc[i][1] = (f32x4){0.f, 0.f, 0.f, 0.f}; }
    if (c > 0) {
        const u16* cb = CT + (((size_t)bh * 16 + c) * 256 + 32 * wid + (lane & 15)) * 256 + (lane >> 4) * 8;
#pragma unroll
        for (int kk = 0; kk < 8; ++kk) { const bf16x8 B0 = *(const bf16x8*)(cb + 32 * kk), B1 = *(const bf16x8*)(cb + 16 * 256 + 32 * kk);
#pragma unroll
            for (int tt = 0; tt < 8; ++tt) { const bf16x8 A = frag_rm(QL, 264, 16 * tt, 32 * kk, lane); MMA_T(acc[tt][0], B0, A); MMA_T(acc[tt][1], B1, A); } }
#pragma unroll
        for (int tt = 0; tt < 8; ++tt) { const float w = wil[16 * tt + (lane & 15)]; acc[tt][0] *= w; acc[tt][1] *= w; }
    }
    lds_barrier();
    LAS u16* PL = QL;
#pragma unroll
    for (int it = 0; it < 5; ++it) {
        const int idx = wid + 8 * it;
        if (idx < 36) {
            int tt = 0; while (idx >= (tt + 1) * (tt + 2) / 2) ++tt;
            const int st = idx - tt * (tt + 1) / 2;
            const int t = 16 * tt + (lane & 15), s0 = 16 * st + (lane >> 4) * 4;
            *(LAS u32x2*)(PL + t * 136 + s0) = preg[it];
            if (st == tt && (tt & 1) == 0) *(LAS u32x2*)(PL + t * 136 + s0 + 16) = (u32x2){0u, 0u};
        }
    }
#pragma unroll
    for (int i = 0; i < 8; ++i) *(LAS u32x4*)(KVL + (sr + 16 * i) * 264 + scc) = vreg[i];
    if (tid < 128) { float dn = wil[tid] * QN[tid];
#pragma unroll
        for (int w = 0; w < 8; ++w) dn += RS[w * 128 + tid];
        DEN[tid] = dn; }
    lds_barrier();
#pragma unroll
    for (int kk = 0; kk < 4; ++kk) { const bf16x8 B0 = frag_tr(KVL, 264, 32 * wid, 32 * kk, lane), B1 = frag_tr(KVL, 264, 32 * wid + 16, 32 * kk, lane);
#pragma unroll
        for (int tt = 2 * kk; tt < 8; ++tt) { const bf16x8 A = frag_rm(PL, 136, 16 * tt, 32 * kk, lane); MMA_T(acc[tt][0], B0, A); MMA_T(acc[tt][1], B1, A); } }
#pragma unroll
    for (int tt = 0; tt < 8; ++tt) { const int tl = 16 * tt + (lane & 15); const float inv = 1.0f / fmaxf(fabsf(DEN[tl]), emtl[tl]); float s1 = 0.f, s2 = 0.f;
#pragma unroll
        for (int et = 0; et < 2; ++et) { acc[tt][et] *= inv;
#pragma unroll
            for (int j = 0; j < 4; ++j) { s1 += acc[tt][et][j]; s2 += acc[tt][et][j] * acc[tt][et][j]; } }
        s1 += __shfl_xor(s1, 16); s1 += __shfl_xor(s1, 32); s2 += __shfl_xor(s2, 16); s2 += __shfl_xor(s2, 32);
        if (lane < 16) { LNS[(wid * 128 + tl) * 2] = s1; LNS[(wid * 128 + tl) * 2 + 1] = s2; } }
    lds_barrier();
#pragma unroll
    for (int tt = 0; tt < 8; ++tt) { const int tl = 16 * tt + (lane & 15); float s1 = 0.f, s2 = 0.f;
#pragma unroll
        for (int w = 0; w < 8; ++w) { s1 += LNS[(w * 128 + tl) * 2]; s2 += LNS[(w * 128 + tl) * 2 + 1]; }
        const float mean = s1 * (1.0f / 256.0f), rstd = rsqrtf(fmaxf(s2 * (1.0f / 256.0f) - mean * mean, 0.f) + 1e-6f);
#pragma unroll
        for (int et = 0; et < 2; ++et) { const int e = 32 * wid + 16 * et + (lane >> 4) * 4;
            u32x2 o; o.x = pk2((acc[tt][et][0] - mean) * rstd, (acc[tt][et][1] - mean) * rstd); o.y = pk2((acc[tt][et][2] - mean) * rstd, (acc[tt][et][3] - mean) * rstd);
            *(LAS u32x2*)(KVL + tl * 264 + e) = o; } }
    lds_barrier();
    {   u16* H = (u16*)(p.ws + W_H); float ng[8];
#pragma unroll
        for (int j = 0; j < 8; ++j) ng[j] = p.in[22][h * 256 + scc + j];
        u32x4 ma[8], so[8], gb[8];
#pragma unroll
        for (int i = 0; i < 8; ++i) { const size_t zr = R0 + sr + 16 * i; ma[i] = *(const u32x4*)(Z + zo(zr, h * 256 + scc)); so[i] = *(const u32x4*)(Z + zo(zr, 5 * 1024 + h * 256 + scc)); gb[i] = *(const u32x4*)(Z + zo(zr, 7 * 1024 + h * 256 + scc)); }
#pragma unroll
        for (int i = 0; i < 8; ++i) { const int r = sr + 16 * i; float hn[8], m8[8], s8[8], g8[8]; unpack8(*(LAS const u32x4*)(KVL + r * 264 + scc), hn); unpack8(ma[i], m8); unpack8(so[i], s8); unpack8(gb[i], g8);
#pragma unroll
            for (int j = 0; j < 8; ++j) hn[j] = m8[j] + sigm(g8[j]) * sigm(s8[j]) * hn[j] * ng[j];
            *(u32x4*)(H + (R0 + r) * 1024 + h * 256 + scc) = pack8(hn); } }
    lds_barrier();
}

__device__ __forceinline__ void phase_mix3(const Params& p, LAS unsigned char* lds) {
#pragma unroll 1
    for (int u = blockIdx.x; u < 512; u += gridDim.x) { const int c = u & 15, bh = u >> 4; out_prompt_unit(p, lds, bh >> 2, bh & 3, c); }
}

#define XB_TMO      128
#define XB_XCNT(j)  (256  + 64 * (j))
#define XB_XSUB(j)  (1280 + 64 * (j))
#define XB_XGEN(j)  (2304 + 64 * (j))
#define XB_TOP      3328
#define XB_TOPGEN   3392
#define XCD_BAR_WORDS 3456
#define XB_SPIN_CAP (1u << 18)
__device__ __forceinline__ unsigned xb_ld(unsigned* p)              { return __hip_atomic_load(p, __ATOMIC_RELAXED, __HIP_MEMORY_SCOPE_AGENT); }
__device__ __forceinline__ unsigned xb_add(unsigned* p, unsigned v) { return __hip_atomic_fetch_add(p, v, __ATOMIC_RELAXED, __HIP_MEMORY_SCOPE_AGENT); }
__device__ __forceinline__ unsigned xb_xcc_id() { return (unsigned)__builtin_amdgcn_s_getreg((3 << 11) | 20) & 0xFu; }
#define XB_SPIN(cond, bar) do { unsigned _sp = 0; while (cond) { __builtin_amdgcn_s_sleep(6);     \
    if ((++_sp & 255u) == 0u) { if (xb_ld(&(bar)[XB_TMO])) break; if (_sp > XB_SPIN_CAP) { atomicAdd(&(bar)[XB_TMO], 1u); break; } } } } while (0)
struct XcdBarrier { unsigned* bar; unsigned x; volatile LAS unsigned* st; };
__device__ __forceinline__ XcdBarrier xcd_barrier_post(unsigned* bar, volatile LAS unsigned* st) {
    XcdBarrier b; b.bar = bar; b.x = xb_xcc_id(); b.st = st;
    if (threadIdx.x == 0) (void)xb_add(&bar[XB_XCNT(b.x)], 1u);
    return b;
}
__device__ __forceinline__ void xcd_barrier_complete(unsigned* bar, unsigned x, unsigned& nloc, unsigned& nx) {
    const unsigned G = gridDim.x * gridDim.y * gridDim.z;
    unsigned sum, cnt, mine, sp = 0u;
    for (;;) {
        sum = 0u; cnt = 0u; mine = 0u;
#pragma unroll
        for (unsigned j = 0; j < 16; ++j) { const unsigned c = xb_ld(&bar[XB_XCNT(j)]); sum += c; cnt += (c > 0u) ? 1u : 0u; mine = (j == x) ? c : mine; }
        if (sum == G) break;
        __builtin_amdgcn_s_sleep(1);
        if ((++sp & 255u) == 0u) { if (xb_ld(&bar[XB_TMO])) break; if (sp > XB_SPIN_CAP) { atomicAdd(&bar[XB_TMO], 1u); break; } }
    }
    nloc = mine > 0u ? mine : 1u; nx = cnt > 0u ? cnt : 1u;
}
__device__ __forceinline__ void xcd_barrier(const XcdBarrier& b) {
    asm volatile("s_waitcnt vmcnt(0)" ::: "memory");
    __syncthreads();
    if (threadIdx.x == 0) {
        unsigned* bar = b.bar;
        __builtin_amdgcn_s_waitcnt(0);
        unsigned nloc = b.st[0], nx = b.st[1];
        if (nloc == 0u) { xcd_barrier_complete(bar, b.x, nloc, nx); b.st[0] = nloc; b.st[1] = nx; }
        const unsigned old = xb_add(&bar[XB_XSUB(b.x)], 1u);
        const unsigned gen = old / nloc;
        if (old + 1u == (gen + 1u) * nloc) {
            __builtin_amdgcn_fence(__ATOMIC_RELEASE, "agent");
            asm volatile("s_waitcnt vmcnt(0)" ::: "memory");
            const unsigned og = xb_add(&bar[XB_TOP], 1u);
            const unsigned tg = og / nx;
            if (og + 1u == (tg + 1u) * nx) xb_add(&bar[XB_TOPGEN], 1u);
            else XB_SPIN(xb_ld(&bar[XB_TOPGEN]) == tg, bar);
            __builtin_amdgcn_fence(__ATOMIC_ACQUIRE, "agent");
            xb_add(&bar[XB_XGEN(b.x)], 1u);
            asm volatile("s_waitcnt vmcnt(0)" ::: "memory");
        } else {
            XB_SPIN(xb_ld(&bar[XB_XGEN(b.x)]) == gen, bar);
            __builtin_amdgcn_fence(__ATOMIC_ACQUIRE, "agent");
            asm volatile("s_waitcnt vmcnt(0)" ::: "memory");
        }
    }
    __syncthreads();
}

constexpr int NPHASE = 14;
__device__ __forceinline__ void run_phase(int ph, const Params& p, LAS unsigned char* lds) {
    unsigned char* ws = p.ws; const float* ADA = (const float*)(ws + W_ADA); float* X = p.out + O_Y;
    u16* H = (u16*)(ws + W_H); u16* ACT = (u16*)(ws + W_ACT);
    switch (ph) {
        case 0: phase_convert(p, lds, 1632, 2336, 0, (int)gridDim.x, true); break;
        case 1: { EpiF32B E; E.C = (float*)(ws + W_ADA); E.ldc = ADAC; E.bias = (const float*)(ws + W_BIAS); run_gemm(lds, (const u16*)(ws + W_CS), (const u16*)(ws + W_WBA), 256, ADAC, 1024, E);
                  const int nb = (int)gridDim.x - 44;
                  phase_convert(p, lds, 0, 7 * nb, 44, nb, false); phase_convert(p, lds, 7 * nb, 1632, 0, 44, false); } break;
        case 2: phase_prep<0>(p, lds); break;
        case 3: { EpiSwiglu E; E.O = ACT; run_gemm(lds, H, (const u16*)(ws + W_WB1), MR, 5632, 1024, E); } break;
        case 4: { EpiResid<true> E; E.XinF = p.in[0]; E.XinB = nullptr; E.Xout = (u16*)p.out; E.XoutT = (float*)(ws + W_SLAB); E.gate = ADA + 2 * 1024; E.coef = 0.5f; E.ntf = FF / 64; E.pk = 8 * 64; run_gemm(lds, ACT, (const u16*)(ws + W_WB2), MR, 1024, FF, E, 5, 8, 4); } break;
        case 5: phase_prep<1>(p, lds); break;
        case 6: { EpiZ E; E.O = (u16*)(ws + W_Z); E.vst = (float*)(ws + W_VST); run_gemm(lds, H, (const u16*)(ws + W_WB3), MR, ZC, 1024, E); } break;
        case 7: phase_mix1(p, lds); break;
        case 8: phase_mix2(p, lds); break;
        case 9: phase_mix3(p, lds); break;
        case 10: { EpiResid<false> E; E.XinF = nullptr; E.XinB = (const u16*)p.out; E.Xout = (u16*)(ws + W_X2); E.XoutT = (float*)(ws + W_SLAB); E.gate = ADA + 5 * 1024; E.coef = 1.0f; E.ntf = 16; E.pk = 4 * 64; run_gemm(lds, H, (const u16*)(ws + W_WB4), MR, 1024, 1024, E, 4, 4, 4); } break;
        case 11: phase_prep<2>(p, lds); break;
        case 12: { EpiSwiglu E; E.O = ACT; run_gemm(lds, H, (const u16*)(ws + W_WB5), MR, 5632, 1024, E); } break;
        case 13: { EpiResid<false> E; E.XinF = nullptr; E.XinB = (const u16*)(ws + W_X2); E.Xout = (u16*)(ws + W_X3); E.XoutT = (float*)(ws + W_SLAB); E.gate = ADA + 8 * 1024; E.coef = 0.5f; E.ntf = FF / 64; E.pk = 8 * 64; run_gemm(lds, ACT, (const u16*)(ws + W_WB6), MR, 1024, FF, E, 5, 8, 4); } break;
        default: phase_prep<3>(p, lds); break;
    }
}

#if FUSED
__global__ void __launch_bounds__(512, 2) mega_kernel(Params p) {
    extern __shared__ __attribute__((aligned(16))) unsigned char shm[];
    cg::grid_group grid = cg::this_grid();
    LAS unsigned char* lds = (LAS unsigned char*)shm;
    volatile LAS unsigned* st = (volatile LAS unsigned*)(lds + LDS_BYTES);
    if (threadIdx.x == 0) { st[0] = 0u; st[1] = 0u; st[2] = 0u; st[3] = 0u; }
    __syncthreads();
    const XcdBarrier xb = xcd_barrier_post((unsigned*)(p.ws + W_BAR), st);
    run_phase(0, p, lds); grid.sync();
    run_phase(1, p, lds); xcd_barrier(xb); run_phase(2, p, lds); xcd_barrier(xb); run_phase(3, p, lds); xcd_barrier(xb);
    run_phase(4, p, lds); xcd_barrier(xb); run_phase(5, p, lds); xcd_barrier(xb); run_phase(6, p, lds); xcd_barrier(xb); run_phase(7, p, lds); xcd_barrier(xb);
    run_phase(8, p, lds); xcd_barrier(xb); run_phase(9, p, lds); xcd_barrier(xb); run_phase(10, p, lds); xcd_barrier(xb); run_phase(11, p, lds); xcd_barrier(xb);
    run_phase(12, p, lds); xcd_barrier(xb); run_phase(13, p, lds); xcd_barrier(xb); run_phase(14, p, lds);
}
#else
template <int PH> __global__ void __launch_bounds__(512, 2) phase_kernel(Params p) {
    extern __shared__ __attribute__((aligned(16))) unsigned char shm[];
    run_phase(PH, p, (LAS unsigned char*)shm);
}
template <int PH> static void launch_phase(const Params& p, int grid, hipStream_t stream) {
    static bool attr = false;
    if (!attr) { hipFuncSetAttribute((const void*)phase_kernel<PH>, hipFuncAttributeMaxDynamicSharedMemorySize, LDS_BYTES); attr = true; }
    hipLaunchKernelGGL(phase_kernel<PH>, dim3(grid), dim3(512), LDS_BYTES, stream, p);
}
#endif

extern "C" void kernel_launch(void* const* d_in, const int* in_sizes, int n_in, void* d_out, int out_size, void* d_ws, size_t ws_size, hipStream_t stream) {
    static int grid = 0;
    if (grid == 0) {
        if (n_in != 30 || ws_size < W_END) { fprintf(stderr, "kernel_launch: need 30 inputs and %zu workspace bytes; got %d, %zu\n", (size_t)W_END, n_in, ws_size); grid = -1; return; }
        int dev = 0, cus = 0;
        hipGetDevice(&dev); hipDeviceGetAttribute(&cus, hipDeviceAttributeMultiprocessorCount, dev);
#if FUSED
        int per_cu = 0;
        hipFuncSetAttribute((const void*)mega_kernel, hipFuncAttributeMaxDynamicSharedMemorySize, LDS_BYTES + 16);
        hipOccupancyMaxActiveBlocksPerMultiprocessor(&per_cu, (const void*)mega_kernel, 512, LDS_BYTES + 16);
        if (per_cu < 1) { fprintf(stderr, "kernel_launch: occupancy query says %d blocks per CU\n", per_cu); grid = -1; return; }
        grid = cus;
#else
        grid = cus;
#endif
    }
    if (grid < 0) return;
    Params p{};
    for (int i = 0; i < 30; ++i) p.in[i] = (const float*)d_in[i];
    p.out = (float*)d_out; p.ws = (unsigned char*)d_ws;
#if FUSED
    hipMemsetAsync((unsigned char*)d_ws + W_BAR, 0, 16384, stream);
    void* args[] = {&p};
    hipError_t e = hipLaunchCooperativeKernel((const void*)mega_kernel, dim3(grid), dim3(512), args, LDS_BYTES + 16, stream);
    if (e != hipSuccess) fprintf(stderr, "cooperative launch failed: %s (grid %d)\n", hipGetErrorString(e), grid);
#else
    launch_phase<0>(p, grid, stream); launch_phase<1>(p, grid, stream); launch_phase<2>(p, grid, stream); launch_phase<3>(p, grid, stream); launch_phase<4>(p, grid, stream);
    launch_phase<5>(p, grid, stream); launch_phase<6>(p, grid, stream); launch_phase<7>(p, grid, stream); launch_phase<8>(p, grid, stream); launch_phase<9>(p, grid, stream);
    launch_phase<10>(p, grid, stream); launch_phase<11>(p, grid, stream); launch_phase<12>(p, grid, stream); launch_phase<13>(p, grid, stream); launch_phase<14>(p, grid, stream);
#endif
}
```

```cpp
#include <hip/hip_runtime.h>
#include <hip/hip_cooperative_groups.h>
#include <cstdio>
namespace cg = cooperative_groups;
#ifndef FUSED
#define FUSED 1
#endif
__device__ __forceinline__ int tid_opaque() { int t = (int)threadIdx.x; asm volatile("" : "+v"(t)); return t; }
namespace pg8 {
#define PG8_LAS __attribute__((address_space(3)))
typedef unsigned short bf16_t;
typedef short bf16x8 __attribute__((ext_vector_type(8)));
typedef float f32x4 __attribute__((ext_vector_type(4)));
typedef unsigned u32x4 __attribute__((ext_vector_type(4)));
constexpr int BM = 256, BK = 64, HALF = 128, HTB = HALF * BK * 2  , STAGE_BYTES = 8 * HTB, NXCD = 8, WGM = 8;

__host__ __device__ __forceinline__ int lds_byte(int r, int c) { const int st = (r >> 4) * 2 + (c >> 5), rr = r & 15, cc = c & 31, ob = rr * 64 + cc * 2; return st * 1024 + (ob ^ (((ob >> 9) & 1) << 5)); }
__host__ __device__ __forceinline__ void stage_rc(int b, int& R, int& C) { const int st = b / 1024, sb = b % 1024, swz = sb ^ (((sb >> 9) & 1) << 5); R = (st >> 1) * 16 + swz / 64; C = (st & 1) * 32 + (swz % 64) / 2; }
__host__ __device__ __forceinline__ int perm32(int rho) { const int n = rho >> 4, i = rho & 15; return 8 * (i >> 2) + 4 * n + (i & 3); }

struct Unit { int pm, pn, k0, nt; };
struct Gemm { const bf16_t* A; const bf16_t* Bt; int M, N, K; };

struct StaticOrder {
    int nM, nN, nwg, G, c, ntf, ppu, pnt, nMt;
    __host__ __device__ void init(int M, int N, int G_, int c_, int ntf_ = 0, int ppu_ = 0, int pnt_ = 0, int nMt_ = 0) { nM = M / BM - (ppu_ > 0 ? nMt_ : 0); nN = N / BM; nwg = nM * nN; G = G_; c = c_; ntf = ntf_; ppu = ppu_; pnt = pnt_; nMt = nMt_; }
    __host__ __device__ void map(int wgid, Unit& u) const {
        { const int q = nwg / NXCD, r = nwg % NXCD, xcd = wgid % NXCD, off = wgid / NXCD; wgid = (xcd < r ? xcd * (q + 1) : r * (q + 1) + (xcd - r) * q) + off; }
        const int nig = WGM * nN, gid = wgid / nig, fm = gid * WGM, gsz = (nM - fm) < WGM ? (nM - fm) : WGM;
        u.pm = fm + ((wgid % nig) % gsz); u.pn = (wgid % nig) / gsz;
    }
    __host__ __device__ bool next(int i, Unit& u) const {
        const long L = (long)i * G + c;
        if (L < nwg) { map((int)L, u); u.k0 = 0; u.nt = ntf; return true; }
        if (ppu == 0) return false;
        const int full = ((nwg + G - 1) / G) * G; if (L < full) return false;
        const int q = (int)(L - full); if (q >= nMt * nN * ppu) return false;
        const int pi = q % ppu, j = q / ppu; u.pm = nM + j % nMt; u.pn = j / nMt; u.k0 = pi * pnt * BK; u.nt = (pi == ppu - 1) ? ntf - pnt * (ppu - 1) : pnt; return true;
    }
    __device__ __forceinline__ void a_ready(const Unit&) const {}
    __device__ __forceinline__ void done(const Unit&) const {}
};
typedef __bf16 bf16x2_t __attribute__((ext_vector_type(2)));
typedef float f32x2_t __attribute__((ext_vector_type(2)));
__device__ __forceinline__ unsigned cvt_pk_bf16(float lo, float hi) { return __builtin_bit_cast(unsigned, __builtin_convertvector((f32x2_t){lo, hi}, bf16x2_t)); }
template <class Epi, class Sched, bool STAMP = false>
__device__ __forceinline__ void gemm_phase(PG8_LAS unsigned char* lds, const Gemm g, const Sched& S, const Epi& E, unsigned long long* stamps) {
    const int tid = tid_opaque(), wid = __builtin_amdgcn_readfirstlane(tid >> 6), lane = tid & 63, wr = wid >> 2, wc = wid & 3, fr = lane & 15, fq = lane >> 4;
    const int K = g.K;
    int ts_lo = 0, ts_hi = 0, nts = 0; const unsigned long long rt_entry = STAMP ? (unsigned long long)wall_clock64() : 0ull;
#define PG8_STAMP() do { if (STAMP && wid == 0 && nts < 64) { const unsigned long long _c = (unsigned long long)clock64(); \
        ts_lo = (lane == nts) ? (int)(unsigned)_c : ts_lo; ts_hi = (lane == nts) ? (int)(unsigned)(_c >> 32) : ts_hi; ++nts; } } while (0)
    PG8_STAMP();
    unsigned voffA[2], voffB[2];
#pragma unroll
    for (int i = 0; i < 2; ++i) { int R, C; stage_rc(tid * 16 + i * 8192, R, C); const int Rb = Epi::PERM ? ((R & ~31) + perm32(R & 31)) : R;
        voffA[i] = (unsigned)(R * K + C) * 2u; voffB[i] = (unsigned)(Rb * K + C) * 2u; }
    const size_t kstep = (size_t)(BK * 2);
    const size_t hstep = (size_t)HALF * K * 2;
    const size_t tstep = 2 * hstep;
    const unsigned ldsw = (unsigned)wid * 1024u;
    const int aoff = lds_byte(wr * 64 + fr, fq * 8), boff = lds_byte(wc * 32 + fr, fq * 8);
#define PG8_SA(b, h) (((b) * 2 + (h)) * HTB)
#define PG8_SB(b, h) ((4 + (b) * 2 + (h)) * HTB)
#define PG8_STAGE(bufoff, gbase, voff) do { _Pragma("unroll") for (int _i = 0; _i < 2; ++_i) \
        __builtin_amdgcn_global_load_lds((const unsigned*)((const char*)(gbase) + (voff)[_i]), (PG8_LAS unsigned*)(lds + (bufoff) + ldsw + _i * 8192), 16, 0, 0); } while (0)
#define PG8_LDA(dst, b, h) do { _Pragma("unroll") for (int m = 0; m < 4; ++m) _Pragma("unroll") for (int k = 0; k < 2; ++k) dst[m][k] = *(const PG8_LAS bf16x8*)(lds + PG8_SA(b, h) + aoff + m * 2048 + k * 1024); } while (0)
#define PG8_LDB(dst, b, h) do { _Pragma("unroll") for (int n = 0; n < 2; ++n) _Pragma("unroll") for (int k = 0; k < 2; ++k) dst[n][k] = *(const PG8_LAS bf16x8*)(lds + PG8_SB(b, h) + boff + n * 2048 + k * 1024); } while (0)
#define PG8_MMA(ai, bj, At, Bt) do { __builtin_amdgcn_s_setprio(1); _Pragma("unroll") for (int m = 0; m < 4; ++m) _Pragma("unroll") for (int n = 0; n < 2; ++n) _Pragma("unroll") for (int k = 0; k < 2; ++k) \
        acc[ai][bj][m][n] = __builtin_amdgcn_mfma_f32_16x16x32_bf16(Bt[n][k], At[m][k], acc[ai][bj][m][n], 0, 0, 0); __builtin_amdgcn_s_setprio(0); } while (0)
#define PG8_WAIT_V(n) asm volatile("s_waitcnt vmcnt(" #n ")" ::: "memory")
#define PG8_WAIT_L(n) asm volatile("s_waitcnt lgkmcnt(" #n ")" ::: "memory")
#define PG8_BAR __builtin_amdgcn_s_barrier()
#define PG8_SCHED __builtin_amdgcn_sched_barrier(0)
    Unit cur, nxt; int ui = 0;
    if (!S.next(0, cur)) return;
    f32x4 acc[2][2][4][2];
#pragma unroll
    for (int a = 0; a < 2; ++a)
#pragma unroll
        for (int b = 0; b < 2; ++b)
#pragma unroll
            for (int m = 0; m < 4; ++m)
#pragma unroll
                for (int n = 0; n < 2; ++n) acc[a][b][m][n] = (f32x4){0.f, 0.f, 0.f, 0.f};
    bf16x8 At[4][2], B0[2][2], B1[2][2];
    const char* cA = (const char*)g.A + (size_t)cur.pm * tstep + (size_t)cur.k0 * 2; const char* cB = (const char*)g.Bt + (size_t)cur.pn * tstep + (size_t)cur.k0 * 2;
    S.a_ready(cur);
    PG8_STAGE(PG8_SB(0, 0), cB, voffB); PG8_STAGE(PG8_SA(0, 0), cA, voffA); PG8_STAGE(PG8_SB(0, 1), cB + hstep, voffB); PG8_STAGE(PG8_SA(0, 1), cA + hstep, voffA);
    if (wr == 1) PG8_BAR;
    PG8_WAIT_V(4); PG8_BAR;
    PG8_STAGE(PG8_SB(1, 0), cB + kstep, voffB); PG8_STAGE(PG8_SA(1, 0), cA + kstep, voffA); PG8_STAGE(PG8_SB(1, 1), cB + hstep + kstep, voffB);
    PG8_WAIT_V(6); PG8_BAR;
    PG8_STAMP();
    for (;;) {
        const bool has_next = S.next(ui + 1, nxt);
        const char* nA = has_next ? (const char*)g.A + (size_t)nxt.pm * tstep + (size_t)nxt.k0 * 2 : cA; const char* nB = has_next ? (const char*)g.Bt + (size_t)nxt.pn * tstep + (size_t)nxt.k0 * 2 : cB;
        const int nt = cur.nt;
        for (int t = 0; t < nt; t += 2) {
            const bool last = (t == nt - 2);
            const char* a1 = cA + (size_t)(t + 1) * kstep;
            const char* a2 = last ? nA : cA + (size_t)(t + 2) * kstep; const char* b2 = last ? nB : cB + (size_t)(t + 2) * kstep;
            const char* a3 = a2 + kstep; const char* b3 = b2 + kstep;
            if (last && has_next) S.a_ready(nxt);
            PG8_LDB(B0, 0, 0); PG8_SCHED; PG8_LDA(At, 0, 0); PG8_STAGE(PG8_SA(1, 1), a1 + hstep, voffA);
            PG8_WAIT_L(8); PG8_BAR; PG8_WAIT_L(0); PG8_MMA(0, 0, At, B0); PG8_BAR; PG8_SCHED;
            PG8_LDB(B1, 0, 1); PG8_STAGE(PG8_SB(0, 0), b2, voffB);
            PG8_BAR; PG8_WAIT_L(0); PG8_MMA(0, 1, At, B1); PG8_BAR;
            PG8_LDA(At, 0, 1); PG8_STAGE(PG8_SA(0, 0), a2, voffA);
            PG8_BAR; PG8_WAIT_L(0); PG8_MMA(1, 0, At, B0); PG8_BAR; PG8_SCHED;
            PG8_STAGE(PG8_SB(0, 1), b2 + hstep, voffB);
            PG8_WAIT_V(6); PG8_BAR; PG8_MMA(1, 1, At, B1); PG8_BAR;
            PG8_LDB(B0, 1, 0); PG8_SCHED; PG8_LDA(At, 1, 0); PG8_STAGE(PG8_SA(0, 1), a2 + hstep, voffA);
            PG8_WAIT_L(8); PG8_BAR; PG8_WAIT_L(0); PG8_MMA(0, 0, At, B0); PG8_BAR; PG8_SCHED;
            PG8_LDB(B1, 1, 1); PG8_STAGE(PG8_SB(1, 0), b3, voffB);
            PG8_BAR; PG8_WAIT_L(0); PG8_MMA(0, 1, At, B1); PG8_BAR;
            PG8_LDA(At, 1, 1); PG8_STAGE(PG8_SA(1, 0), a3, voffA);
            PG8_BAR; PG8_WAIT_L(0); PG8_MMA(1, 0, At, B0); PG8_BAR; PG8_SCHED;
            PG8_STAGE(PG8_SB(1, 1), b3 + hstep, voffB);
            PG8_WAIT_V(6); PG8_BAR; PG8_MMA(1, 1, At, B1); PG8_BAR;
        }
        PG8_STAMP();
        if constexpr (!Epi::AFTER_DRAIN) { E(acc, cur, wr, wc, fr, fq); S.done(cur); }
        PG8_STAMP();
        if (!has_next) break;
#pragma unroll
        for (int a = 0; a < 2; ++a)
#pragma unroll
            for (int b = 0; b < 2; ++b)
#pragma unroll
                for (int m = 0; m < 4; ++m)
#pragma unroll
                    for (int n = 0; n < 2; ++n) acc[a][b][m][n] = (f32x4){0.f, 0.f, 0.f, 0.f};
        cur = nxt; cA = nA; cB = nB; ++ui;
    }
    PG8_WAIT_V(0);
    if (wr == 0) PG8_BAR;
    PG8_BAR;
    if constexpr (Epi::AFTER_DRAIN) { E.fused(acc, cur, wr, wc, fr, fq, lds, wid, lane); S.done(cur); }
    PG8_STAMP();
    if (STAMP && wid == 0) { stamps[lane] = lane < nts ? (((unsigned long long)(unsigned)ts_hi << 32) | (unsigned)ts_lo) : 0ull;
        if (lane == 62) stamps[62] = rt_entry; if (lane == 63) stamps[63] = (unsigned long long)wall_clock64(); }
#undef PG8_STAMP
#undef PG8_SA
#undef PG8_SB
#undef PG8_STAGE
#undef PG8_LDA
#undef PG8_LDB
#undef PG8_MMA
#undef PG8_WAIT_V
#undef PG8_WAIT_L
#undef PG8_BAR
#undef PG8_SCHED
}
}

#define LAS __attribute__((address_space(3)))
typedef unsigned short u16;
typedef short bf16x8 __attribute__((ext_vector_type(8)));
typedef short s16x4 __attribute__((ext_vector_type(4)));
typedef float f32x4 __attribute__((ext_vector_type(4)));
typedef unsigned u32x4 __attribute__((ext_vector_type(4)));
typedef unsigned u32x2 __attribute__((ext_vector_type(2)));

constexpr int DM = 1024, NPR = 16384, NSR = 1024, MR = NPR + NSR, FF = 2816, ZC = 8192, ADAC = 11264;
constexpr int LDS_BYTES = 151552;
constexpr size_t W_WB1 = 0;
constexpr size_t W_WB2 = W_WB1 + (size_t)5632 * 1024 * 2;
constexpr size_t W_WB3 = W_WB2 + (size_t)1024 * 2816 * 2;
constexpr size_t W_WB4 = W_WB3 + (size_t)8192 * 1024 * 2;
constexpr size_t W_WB5 = W_WB4 + (size_t)1024 * 1024 * 2;
constexpr size_t W_WB6 = W_WB5 + (size_t)5632 * 1024 * 2;
constexpr size_t W_CS = W_WB6 + (size_t)1024 * 2816 * 2;
constexpr size_t W_BIAS = W_CS + (size_t)256 * 1024 * 2;
constexpr size_t W_WG = W_BIAS + (size_t)ADAC * 4;
constexpr size_t W_ADA = W_WG + (size_t)8 * 1024 * 4;
constexpr size_t W_H = W_ADA + (size_t)256 * ADAC * 4;
constexpr size_t W_GATES = W_H + (size_t)MR * 1024 * 2;
constexpr size_t W_BS = W_GATES + (size_t)MR * 8 * 4;
constexpr size_t W_AS = W_BS + (size_t)32 * 2048 * 4;
constexpr size_t W_CM = W_AS + (size_t)32 * 2048 * 4;
constexpr size_t W_MINIT = W_CM + (size_t)32 * 2048 * 4;
constexpr size_t W_NINIT = W_MINIT + 4096;
constexpr size_t W_Z = W_NINIT + (size_t)32 * 16 * 256 * 4;
constexpr size_t W_ACT = W_Z;
constexpr size_t W_SLAB = W_Z + (size_t)200 * 1024 * 1024;
constexpr size_t W_X3 = W_Z + (size_t)164 * 1024 * 1024;
constexpr size_t W_X2 = W_Z + (size_t)128 * 1024 * 1024;
constexpr size_t W_QB = W_Z + (size_t)MR * ZC * 2;
constexpr size_t W_KB = W_QB + (size_t)MR * 1024 * 2;
constexpr size_t W_CT = W_KB + (size_t)MR * 1024 * 2;
constexpr size_t W_WBA = W_CT;
constexpr size_t W_BAR = W_CT + (size_t)32 * 16 * 65536 * 2;
constexpr size_t W_VST = W_BAR + 16384;
constexpr size_t W_XS = W_VST + (size_t)MR * 32 * 4;
constexpr size_t W_WTB = W_XS + (size_t)NSR * 1024 * 4;
constexpr size_t W_END = W_WTB + (size_t)4 * 128 * 128 * 2;
constexpr size_t O_Y = 0;
constexpr size_t O_CP = (size_t)MR * 1024;
constexpr size_t O_NP = O_CP + (size_t)8 * 4 * 65536;
constexpr size_t O_MP = O_NP + 8 * 4 * 256;
constexpr size_t O_CVP = O_MP + 32;
constexpr size_t O_CS = O_CVP + 8 * 3 * 2048;
constexpr size_t O_NS = O_CS + (size_t)128 * 4 * 65536;
constexpr size_t O_MS = O_NS + 128 * 4 * 256;
constexpr size_t O_CVS = O_MS + 512;
constexpr size_t O_VS = O_CVS + 128 * 3 * 2048;

struct Params { const float* in[30]; float* out; unsigned char* ws; };

__device__ __forceinline__ float bf2f(u16 b) { return __uint_as_float(((unsigned)b) << 16); }
__device__ __forceinline__ float bflo(unsigned w) { return __uint_as_float(w << 16); }
__device__ __forceinline__ float bfhi(unsigned w) { return __uint_as_float(w & 0xffff0000u); }
__device__ __forceinline__ unsigned pk2(float lo, float hi) { return pg8::cvt_pk_bf16(lo, hi); }
__device__ __forceinline__ float sigm(float x) { return __builtin_amdgcn_rcpf(1.0f + __builtin_amdgcn_exp2f(-1.4426950408889634f * x)); }
__device__ __forceinline__ float gelu_t(float x) { return x * sigm(1.5957691216057308f * (x + 0.044715f * x * x * x)); }
__device__ __forceinline__ size_t zo(size_t row, int col) { return ((size_t)(col >> 8) * MR + row) * 256 + (col & 255); }
__device__ __forceinline__ size_t qo(size_t row, int col) { return ((size_t)(col >> 8) * MR + row) * 256 + (col & 255); }
__device__ __forceinline__ int bidx(int row) { return row < NPR ? (row >> 11) : 8 + ((row - NPR) >> 3); }
__device__ __forceinline__ float wsum(float v) {
#pragma unroll
    for (int o = 32; o > 0; o >>= 1) v += __shfl_xor(v, o);
    return v;
}
__device__ __forceinline__ void unpack8(const u32x4 v, float* f) { f[0] = bflo(v.x); f[1] = bfhi(v.x); f[2] = bflo(v.y); f[3] = bfhi(v.y); f[4] = bflo(v.z); f[5] = bfhi(v.z); f[6] = bflo(v.w); f[7] = bfhi(v.w); }
__device__ __forceinline__ u32x4 pack8(const float* f) { u32x4 r; r.x = pk2(f[0], f[1]); r.y = pk2(f[2], f[3]); r.z = pk2(f[4], f[5]); r.w = pk2(f[6], f[7]); return r; }

__device__ __forceinline__ void lds_barrier() { asm volatile("s_waitcnt lgkmcnt(0)\n\ts_barrier" ::: "memory"); }
__device__ __forceinline__ bf16x8 frag_rm(LAS const u16* base, int stride, int r0, int k0, int lane) {
    return *(LAS const bf16x8*)(base + (r0 + (lane & 15)) * stride + k0 + (lane >> 4) * 8);
}
__device__ __forceinline__ bf16x8 frag_tr(LAS const u16* base, int stride, int n0, int k0, int lane) {
    const int g = lane >> 4, li = lane & 15, q = li >> 2, pp = li & 3;
    LAS const u16* a = base + (k0 + g * 8 + q) * stride + n0 + 4 * pp;
    const s16x4 lo = __builtin_amdgcn_ds_read_tr16_b64_v4i16((LAS s16x4*)a);
    const s16x4 hi = __builtin_amdgcn_ds_read_tr16_b64_v4i16((LAS s16x4*)(a + 4 * stride));
    return (bf16x8){lo[0], lo[1], lo[2], lo[3], hi[0], hi[1], hi[2], hi[3]};
}
#define MMA_T(acc, Bf, Af) acc = __builtin_amdgcn_mfma_f32_16x16x32_bf16(Bf, Af, acc, 0, 0, 0)

struct EpiF32B {
    static constexpr bool PERM = false, AFTER_DRAIN = false;
    float* C; int ldc; const float* bias;
    __device__ __forceinline__ void operator()(const f32x4 (&acc)[2][2][4][2], const pg8::Unit& u, int wr, int wc, int fr, int fq) const {
        const int row0 = u.pm * 256 + wr * 64 + fr, col0 = u.pn * 256 + wc * 32 + 4 * fq;
#pragma unroll
        for (int ai = 0; ai < 2; ++ai)
#pragma unroll
            for (int m = 0; m < 4; ++m) { float* rowp = C + (size_t)(row0 + ai * 128 + m * 16) * ldc + col0;
#pragma unroll
                for (int bj = 0; bj < 2; ++bj)
#pragma unroll
                    for (int n = 0; n < 2; ++n) *(f32x4*)(rowp + bj * 128 + n * 16) = acc[ai][bj][m][n] + *(const f32x4*)(bias + col0 + bj * 128 + n * 16); }
    }
};
struct EpiSwiglu {
    static constexpr bool PERM = true, AFTER_DRAIN = false;
    u16* O;
    __device__ __forceinline__ void operator()(const f32x4 (&acc)[2][2][4][2], const pg8::Unit& u, int wr, int wc, int fr, int fq) const {
        const int row0 = u.pm * 256 + wr * 64 + fr, col0 = u.pn * 128 + wc * 32 + 8 * fq;
#pragma unroll
        for (int ai = 0; ai < 2; ++ai)
#pragma unroll
            for (int m = 0; m < 4; ++m) { u16* rowp = O + (size_t)(row0 + ai * 128 + m * 16) * FF + col0;
                float o[8];
#pragma unroll
                for (int n = 0; n < 2; ++n)
#pragma unroll
                    for (int j = 0; j < 4; ++j) { const float a = acc[ai][0][m][n][j], b = acc[ai][1][m][n][j]; o[n * 4 + j] = a * sigm(a) * b; }
                *(u32x4*)rowp = pack8(o); }
    }
};
struct EpiZ {
    static constexpr bool PERM = true, AFTER_DRAIN = false;
    u16* O; float* vst;
    template <bool GELU> __device__ __forceinline__ void body(const f32x4 (&acc)[2][2][4][2], const pg8::Unit& u, int wr, int wc, int fr, int fq) const {
        const int row0 = u.pm * 256 + wr * 64 + fr, col0 = u.pn * 256 + wc * 32 + 8 * fq;
#pragma unroll
        for (int ai = 0; ai < 2; ++ai)
#pragma unroll
            for (int m = 0; m < 4; ++m) { u16* rowp = O + zo((size_t)(row0 + ai * 128 + m * 16), col0); float s1 = 0.f, s2 = 0.f;
#pragma unroll
                for (int bj = 0; bj < 2; ++bj) { float o[8];
#pragma unroll
                    for (int n = 0; n < 2; ++n)
#pragma unroll
                        for (int j = 0; j < 4; ++j) { const float v = acc[ai][bj][m][n][j]; o[n * 4 + j] = GELU ? gelu_t(v) : v; if (GELU) { s1 += o[n * 4 + j]; s2 += o[n * 4 + j] * o[n * 4 + j]; } }
                    *(u32x4*)(rowp + bj * 128) = pack8(o); }
                if (GELU) { s1 += __shfl_xor(s1, 16); s1 += __shfl_xor(s1, 32); s2 += __shfl_xor(s2, 16); s2 += __shfl_xor(s2, 32);
                    if (fq == 0) { float* q = vst + ((size_t)(row0 + ai * 128 + m * 16) * 16 + (u.pn & 3) * 4 + wc) * 2; q[0] = s1; q[1] = s2; } } }
    }
    __device__ __forceinline__ void operator()(const f32x4 (&acc)[2][2][4][2], const pg8::Unit& u, int wr, int wc, int fr, int fq) const {
        if ((u.pn >> 2) == 1) body<true>(acc, u, wr, wc, fr, fq); else body<false>(acc, u, wr, wc, fr, fq);
    }
};
template <bool XF32> struct EpiResid {
    static constexpr bool PERM = true, AFTER_DRAIN = false;
    const float* __restrict__ XinF; const u16* __restrict__ XinB; u16* __restrict__ Xout; float* __restrict__ XoutT; const float* __restrict__ gate; float coef; int ntf, pk;
    __device__ __forceinline__ void operator()(const f32x4 (&acc)[2][2][4][2], const pg8::Unit& u, int wr, int wc, int fr, int fq) const {
        const int row0 = u.pm * 256 + wr * 64 + fr, col0 = u.pn * 256 + wc * 32 + 8 * fq;
        if (u.nt == ntf) {
#pragma unroll
            for (int ai = 0; ai < 2; ++ai)
#pragma unroll
                for (int m = 0; m < 4; ++m) { const int row = row0 + ai * 128 + m * 16; const float* gp = gate + (size_t)bidx(row) * ADAC + col0;
#pragma unroll
                    for (int bj = 0; bj < 2; ++bj) { const int o = bj * 128; float x[8];
                        if (XF32) { const f32x4 a = *(const f32x4*)(XinF + (size_t)row * 1024 + col0 + o), b = *(const f32x4*)(XinF + (size_t)row * 1024 + col0 + o + 4);
#pragma unroll
                            for (int j = 0; j < 4; ++j) { x[j] = a[j]; x[4 + j] = b[j]; } }
                        else unpack8(*(const u32x4*)(XinB + (size_t)row * 1024 + col0 + o), x);
                        const f32x4 g0 = *(const f32x4*)(gp + o), g1 = *(const f32x4*)(gp + o + 4);
#pragma unroll
                        for (int j = 0; j < 4; ++j) { x[j] += coef * g0[j] * acc[ai][bj][m][0][j]; x[4 + j] += coef * g1[j] * acc[ai][bj][m][1][j]; }
                        *(u32x4*)(Xout + (size_t)row * 1024 + col0 + o) = pack8(x); } }
        } else {
            float* sl = XoutT + (size_t)(u.k0 / pk) * ((size_t)NSR * 1024);
#pragma unroll
            for (int ai = 0; ai < 2; ++ai)
#pragma unroll
                for (int m = 0; m < 4; ++m) { const int row = row0 + ai * 128 + m * 16;
                    const float* gp = gate + (size_t)bidx(row) * ADAC + col0; float* op = sl + (size_t)(row - NPR) * 1024 + col0;
#pragma unroll
                    for (int bj = 0; bj < 2; ++bj) { const int o = bj * 128;
                        *(f32x4*)(op + o) = coef * (*(const f32x4*)(gp + o)) * acc[ai][bj][m][0]; *(f32x4*)(op + o + 4) = coef * (*(const f32x4*)(gp + o + 4)) * acc[ai][bj][m][1]; } }
        }
    }
};
template <class Epi> __device__ __forceinline__ void run_gemm(LAS unsigned char* lds, const u16* A, const u16* Bt, int M, int N, int K, const Epi& E, int ppu = 0, int pnt = 0, int nMt = 0) {
    pg8::Gemm g; g.A = A; g.Bt = Bt; g.M = M; g.N = N; g.K = K;
    pg8::StaticOrder S; S.init(M, N, (int)gridDim.x, (int)blockIdx.x, K / 64, ppu, pnt, nMt);
    pg8::gemm_phase<Epi, pg8::StaticOrder, false>(lds, g, S, E, nullptr);
}

__device__ __forceinline__ void phase_convert(const Params& p, LAS unsigned char* lds, int t_begin, int t_end, int first_wg, int n_wg, bool extras) {
    const int tid = tid_opaque();
    LAS u16* T = (LAS u16*)lds;
    constexpr int NJ = 8;
    const int jn[NJ] = {5632, 1024, 8192, 1024, 5632, 1024, 9216, 2048};
    const int jk[NJ] = {1024, 2816, 1024, 1024, 1024, 2816, 1024, 1024};
    int total = 0;
#pragma unroll
    for (int j = 0; j < NJ; ++j) total += (jn[j] / 256) * (jk[j] / 64);
    (void)total;
    for (int t = t_begin + ((int)blockIdx.x - first_wg); (int)blockIdx.x >= first_wg && (int)blockIdx.x < first_wg + n_wg && t < t_end; t += n_wg) {
        int lt = t, job = 0;
#pragma unroll
        for (int j = 0; j < NJ - 1; ++j) { const int c = (jn[j] / 256) * (jk[j] / 64); if (job == j && lt >= c) { lt -= c; job = j + 1; } }
        const float* src; int ld, K, mode; u16* dst;
        switch (job) {
            case 0: src = p.in[11]; ld = 5632; K = 1024; mode = 1; dst = (u16*)(p.ws + W_WB1); break;
            case 1: src = p.in[12]; ld = 1024; K = 2816; mode = 0; dst = (u16*)(p.ws + W_WB2); break;
            case 2: src = p.in[14]; ld = 8200; K = 1024; mode = 2; dst = (u16*)(p.ws + W_WB3); break;
            case 3: src = p.in[23]; ld = 1024; K = 1024; mode = 0; dst = (u16*)(p.ws + W_WB4); break;
            case 4: src = p.in[25]; ld = 5632; K = 1024; mode = 1; dst = (u16*)(p.ws + W_WB5); break;
            case 5: src = p.in[26]; ld = 1024; K = 2816; mode = 0; dst = (u16*)(p.ws + W_WB6); break;
            case 6: src = p.in[8]; ld = 9216; K = 1024; mode = 0; dst = (u16*)(p.ws + W_WBA); break;
            default: src = p.in[27]; ld = 2048; K = 1024; mode = 0; dst = (u16*)(p.ws + W_WBA) + (size_t)9216 * 1024; break;
        }
        const int nk = K / 64, tn = lt / nk, tk = lt - tn * nk, n0 = tn * 256, k0 = tk * 64;
        const int c4 = (tid & 63) * 4, kr = tid >> 6;
        int sc;
        if (mode == 1) sc = (c4 < 128) ? tn * 128 + c4 : FF + tn * 128 + (c4 - 128);
        else if (mode == 2) sc = (n0 < 6144 ? n0 : n0 + 8) + c4;
        else sc = n0 + c4;
        f32x4 v[8];
#pragma unroll
        for (int i = 0; i < 8; ++i) v[i] = *(const f32x4*)(src + (size_t)(k0 + kr + 8 * i) * ld + sc);
#pragma unroll
        for (int i = 0; i < 8; ++i) { const int k = kr + 8 * i;
            const unsigned a = pk2(v[i][0], v[i][1]), b = pk2(v[i][2], v[i][3]);
            T[(c4 + 0) * 72 + k] = (u16)a; T[(c4 + 1) * 72 + k] = (u16)(a >> 16); T[(c4 + 2) * 72 + k] = (u16)b; T[(c4 + 3) * 72 + k] = (u16)(b >> 16); }
        __syncthreads();
#pragma unroll
        for (int i = 0; i < 4; ++i) { const int q = tid + 512 * i, n = q >> 3, k8 = (q & 7) * 8;
            *(u32x4*)(dst + (size_t)(n0 + n) * K + k0 + k8) = *(LAS const u32x4*)(T + n * 72 + k8); }
        __syncthreads();
    }
    if (!extras) return;
    const int gt = blockIdx.x * 512 + tid, gs = gridDim.x * 512;
    u16* CS = (u16*)(p.ws + W_CS);
    for (int i = gt; i < 256 * 1024; i += gs) { const int r = i >> 10, c = i & 1023; float v = 0.f;
        if (r < 8) v = p.in[2][r * 1024 + c]; else if (r < 136) v = p.in[3][(r - 8) * 1024 + c];
        v = v * sigm(v); CS[i] = (u16)(pk2(v, 0.f) & 0xffffu); }
    float* BIAS = (float*)(p.ws + W_BIAS);
    for (int i = gt; i < ADAC; i += gs) BIAS[i] = i < 9216 ? p.in[9][i] : p.in[28][i - 9216];
    u16* WTB = (u16*)(p.ws + W_WTB);
    for (int i = gt; i < 4 * 128 * 128; i += gs) { const int t = (i >> 7) & 127, sidx = i & 127; WTB[i] = (u16)(pk2(sidx <= t ? p.in[20][i] : 0.f, 0.f) & 0xffffu); }
    float* WG = (float*)(p.ws + W_WG);
    for (int i = gt; i < 8192; i += gs) { const int j = i >> 10, k = i & 1023; WG[i] = p.in[14][(size_t)k * 8200 + 6144 + j]; }
}

template <int WHICH> __device__ __forceinline__ void phase_prep(const Params& p, LAS unsigned char* lds) {
    const int tid = tid_opaque(), lane = tid & 63, wid = tid >> 6;
    const float* ADA = (const float*)(p.ws + W_ADA);
    float* Y = p.out + O_Y;
    u16* H = (u16*)(p.ws + W_H);
    float* XS = (float*)(p.ws + W_XS);
    const float* gv = WHICH == 0 ? p.in[10] : WHICH == 1 ? p.in[13] : WHICH == 2 ? p.in[24] : p.in[29];
    const int jsh = WHICH == 3 ? 9 : 3 * WHICH, jsc = jsh + 1;
    LAS float* WGL = (LAS float*)lds;
    if (WHICH == 1) { const f32x4* wg = (const f32x4*)(p.ws + W_WG);
#pragma unroll
        for (int i = 0; i < 4; ++i) *(LAS f32x4*)(WGL + (tid + 512 * i) * 4) = wg[tid + 512 * i];
        lds_barrier(); }
    for (int row = blockIdx.x * 8 + wid; row < MR; row += gridDim.x * 8) {
        const float* ab = ADA + (size_t)bidx(row) * ADAC;
        float v[2][8]; float ss = 0.f;
#pragma unroll
        for (int i = 0; i < 2; ++i) { const int c = i * 512 + lane * 8;
            if (WHICH == 0) { const float* xr = (row < NPR ? p.in[0] + (size_t)row * 1024 : p.in[1] + (size_t)(row - NPR) * 1024) + c;
                const f32x4 a = *(const f32x4*)xr, b = *(const f32x4*)(xr + 4);
#pragma unroll
                for (int j = 0; j < 4; ++j) { v[i][j] = a[j]; v[i][4 + j] = b[j]; } }
            else if (row < NPR) { const u16* xb = WHICH == 1 ? (const u16*)p.out : WHICH == 2 ? (const u16*)(p.ws + W_X2) : (const u16*)(p.ws + W_X3);
                unpack8(*(const u32x4*)(xb + (size_t)row * 1024 + c), v[i]); }
            else {
                float* xs = XS + (size_t)(row - NPR) * 1024 + c; f32x4 a = *(const f32x4*)xs, b = *(const f32x4*)(xs + 4);
                const float* sl = (const float*)(p.ws + W_SLAB) + (size_t)(row - NPR) * 1024 + c;
#pragma unroll
                for (int pi = 0; pi < (WHICH == 2 ? 4 : 5); ++pi) { a += *(const f32x4*)(sl + (size_t)pi * NSR * 1024); b += *(const f32x4*)(sl + (size_t)pi * NSR * 1024 + 4); }
                if (WHICH < 3) { *(f32x4*)xs = a; *(f32x4*)(xs + 4) = b; }
#pragma unroll
                for (int j = 0; j < 4; ++j) { v[i][j] = a[j]; v[i][4 + j] = b[j]; } }
#pragma unroll
            for (int j = 0; j < 8; ++j) ss += v[i][j] * v[i][j]; }
        ss = wsum(ss);
        const float rstd = rsqrtf(ss * (1.0f / 1024.0f) + 1e-6f);
        float ga[8];
#pragma unroll
        for (int j = 0; j < 8; ++j) ga[j] = 0.f;
#pragma unroll
        for (int i = 0; i < 2; ++i) { const int c = i * 512 + lane * 8; float h[8];
#pragma unroll
            for (int q = 0; q < 2; ++q) { const f32x4 g4 = *(const f32x4*)(gv + c + 4 * q), s4 = *(const f32x4*)(ab + jsc * 1024 + c + 4 * q), h4 = *(const f32x4*)(ab + jsh * 1024 + c + 4 * q);
#pragma unroll
                for (int j = 0; j < 4; ++j) h[4 * q + j] = v[i][4 * q + j] * rstd * g4[j] * (1.0f + s4[j]) + h4[j]; }
            if (WHICH == 0 && row >= NPR) { float* xs = XS + (size_t)(row - NPR) * 1024 + c;
                *(f32x4*)xs = (f32x4){v[i][0], v[i][1], v[i][2], v[i][3]}; *(f32x4*)(xs + 4) = (f32x4){v[i][4], v[i][5], v[i][6], v[i][7]}; }
            if (WHICH == 3) { float* y = Y + (size_t)row * 1024 + c; *(f32x4*)y = (f32x4){h[0], h[1], h[2], h[3]}; *(f32x4*)(y + 4) = (f32x4){h[4], h[5], h[6], h[7]}; }
            else *(u32x4*)(H + (size_t)row * 1024 + c) = pack8(h);
            if (WHICH == 1) {
#pragma unroll
                for (int j = 0; j < 8; ++j) { const f32x4 w0 = *(LAS const f32x4*)(WGL + j * 1024 + c), w1 = *(LAS const f32x4*)(WGL + j * 1024 + c + 4);
                    ga[j] += h[0] * w0[0] + h[1] * w0[1] + h[2] * w0[2] + h[3] * w0[3] + h[4] * w1[0] + h[5] * w1[1] + h[6] * w1[2] + h[7] * w1[3]; } }
        }
        if (WHICH == 1) {
            float mine = 0.f;
#pragma unroll
            for (int j = 0; j < 8; ++j) { const float s = wsum(ga[j]); if (lane == j) mine = s; }
            if (lane < 8) ((float*)(p.ws + W_GATES))[(size_t)row * 8 + lane] = mine + p.in[15][lane];
        }
    }
}

__device__ __forceinline__ void gmlp_prompt_unit(const Params& p, LAS unsigned char* lds, int b, int c, int g) {
    const int tid = tid_opaque(), lane = tid & 63, wid = tid >> 6;
    LAS float* mu = (LAS float*)lds; LAS float* rs = mu + 128;
    LAS u16* WL = (LAS u16*)(lds + 1024);
    LAS u16* VL = (LAS u16*)(lds + 1024 + 34816);
    u16* Z = (u16*)(p.ws + W_Z);
    const size_t R0 = (size_t)b * 2048 + c * 128;
    if (tid < 128) { const f32x4* q = (const f32x4*)((const float*)(p.ws + W_VST) + (R0 + tid) * 32); float s = 0.f, ss = 0.f;
#pragma unroll
        for (int i = 0; i < 8; ++i) { const f32x4 v = q[i]; s += v[0] + v[2]; ss += v[1] + v[3]; }
        const float m = s * (1.0f / 1024.0f); const float var = fmaxf(ss * (1.0f / 1024.0f) - m * m, 0.f); mu[tid] = m; rs[tid] = rsqrtf(var + 1e-6f); }
    {   const u16* w = (const u16*)(p.ws + W_WTB) + (size_t)g * 16384;
#pragma unroll
        for (int i = 0; i < 4; ++i) { const int q = tid + 512 * i, t = q >> 4, s8 = (q & 15) * 8; *(LAS u32x4*)(WL + t * 136 + s8) = *(const u32x4*)(w + t * 128 + s8); } }
    lds_barrier();
    {   const int cc = (tid & 31) * 8; float lg[8], lb[8];
#pragma unroll
        for (int j = 0; j < 8; ++j) { lg[j] = p.in[18][g * 256 + cc + j]; lb[j] = p.in[19][g * 256 + cc + j]; }
        u32x4 vv[8];
#pragma unroll
        for (int i = 0; i < 8; ++i) { const int r = (tid + 512 * i) >> 5; vv[i] = *(const u32x4*)(Z + zo(R0 + r, 1024 + g * 256 + cc)); }
#pragma unroll
        for (int i = 0; i < 8; ++i) { const int r = (tid + 512 * i) >> 5; const float m = mu[r], rsd = rs[r]; float f[8]; unpack8(vv[i], f);
#pragma unroll
            for (int j = 0; j < 8; ++j) f[j] = (f[j] - m) * rsd * lg[j] + lb[j];
            *(LAS u32x4*)(VL + r * 264 + cc) = pack8(f); } }
    lds_barrier();
    f32x4 acc[8][2];
#pragma unroll
    for (int i = 0; i < 8; ++i) { acc[i][0] = (f32x4){0.f, 0.f, 0.f, 0.f}; acc[i][1] = (f32x4){0.f, 0.f, 0.f, 0.f}; }
#pragma unroll
    for (int kk = 0; kk < 4; ++kk) {
        const bf16x8 B0 = frag_tr(VL, 264, 32 * wid, 32 * kk, lane), B1 = frag_tr(VL, 264, 32 * wid + 16, 32 * kk, lane);
#pragma unroll
        for (int i = 0; i < 8; ++i) if (32 * kk <= 16 * i + 15) { const bf16x8 A = frag_rm(WL, 136, 16 * i, 32 * kk, lane); MMA_T(acc[i][0], B0, A); MMA_T(acc[i][1], B1, A); }
    }
    const int cc = (tid & 31) * 8;
    u32x4 gu[8], ga[8];
#pragma unroll
    for (int i = 0; i < 8; ++i) { const int r = (tid + 512 * i) >> 5; gu[i] = *(const u32x4*)(Z + zo(R0 + r, g * 256 + cc)); ga[i] = *(const u32x4*)(Z + zo(R0 + r, 6 * 1024 + g * 256 + cc)); }
    lds_barrier();
    const float* bs = p.in[21] + g * 128;
#pragma unroll
    for (int i = 0; i < 8; ++i) { const int t = 16 * i + (lane & 15); const float bsv = bs[t];
#pragma unroll
        for (int nn = 0; nn < 2; ++nn) { const int d = 32 * wid + 16 * nn + (lane >> 4) * 4;
            u32x2 o; o.x = pk2(acc[i][nn][0] + bsv, acc[i][nn][1] + bsv); o.y = pk2(acc[i][nn][2] + bsv, acc[i][nn][3] + bsv); *(LAS u32x2*)(VL + t * 264 + d) = o; } }
    lds_barrier();
#pragma unroll
    for (int i = 0; i < 8; ++i) { const int r = (tid + 512 * i) >> 5; float o[8], u8[8], a8[8]; unpack8(*(LAS const u32x4*)(VL + r * 264 + cc), o); unpack8(gu[i], u8); unpack8(ga[i], a8);
#pragma unroll
        for (int j = 0; j < 8; ++j) o[j] = sigm(a8[j]) * gelu_t(u8[j]) * o[j];
        *(u32x4*)(Z + zo(R0 + r, g * 256 + cc)) = pack8(o); }
    lds_barrier();
}

__device__ __forceinline__ void gmlp_sample_unit(const Params& p, LAS unsigned char* lds, int b) {
    const int tid = tid_opaque(), lane = tid & 63, wid = tid >> 6;
    LAS float* VS = (LAS float*)lds;
    u16* Z = (u16*)(p.ws + W_Z);
    const size_t r0 = (size_t)NPR + b * 8;
    {   const int t = wid; const u16* src = Z + zo(r0 + t, 1024 + lane * 16);
        float f[16]; unpack8(*(const u32x4*)src, f); unpack8(*(const u32x4*)(src + 8), f + 8);
        float s = 0.f, ss = 0.f;
#pragma unroll
        for (int j = 0; j < 16; ++j) { s += f[j]; ss += f[j] * f[j]; }
        s = wsum(s); ss = wsum(ss);
        const float m = s * (1.0f / 1024.0f), rsd = rsqrtf(fmaxf(ss * (1.0f / 1024.0f) - m * m, 0.f) + 1e-6f);
        float* vo = p.out + O_VS + ((size_t)b * 8 + t) * 1024 + lane * 16;
#pragma unroll
        for (int j = 0; j < 16; ++j) { const float v = (f[j] - m) * rsd * p.in[18][lane * 16 + j] + p.in[19][lane * 16 + j]; VS[t * 1024 + lane * 16 + j] = v; vo[j] = v; } }
    lds_barrier();
    {   const int c = tid * 2, g = c >> 8; const float* ws = p.in[20] + (size_t)g * 16384; const float* bs = p.in[21] + g * 128;
#pragma unroll
        for (int t = 0; t < 8; ++t) { float a0 = bs[t], a1 = a0;
#pragma unroll
            for (int s = 0; s <= t; ++s) { const float w = ws[t * 128 + s]; a0 += w * VS[s * 1024 + c]; a1 += w * VS[s * 1024 + c + 1]; }
            const size_t row = r0 + t; const unsigned gu = *(const unsigned*)(Z + zo(row, c)), ga = *(const unsigned*)(Z + zo(row, 6 * 1024 + c));
            *(unsigned*)(Z + zo(row, c)) = pk2(sigm(bflo(ga)) * gelu_t(bflo(gu)) * a0, sigm(bfhi(ga)) * gelu_t(bfhi(gu)) * a1); } }
    lds_barrier();
}

__device__ __forceinline__ void conv_unit(const Params& p, size_t rowbase, int nrows, int histmode, const float* hist, float* outconv) {
    const int tid = tid_opaque(), c4 = tid * 4;
    const u16* Z = (const u16*)(p.ws + W_Z);
    u16* dst = c4 < 1024 ? (u16*)(p.ws + W_QB) : (u16*)(p.ws + W_KB); const int dc = c4 & 1023;
    const float osc = c4 < 1024 ? 1.0f : 0.0625f;
    f32x4 w[4];
#pragma unroll
    for (int j = 0; j < 4; ++j) w[j] = *(const f32x4*)(p.in[16] + j * 2048 + c4);
    const f32x4 cb = *(const f32x4*)(p.in[17] + c4);
    f32x4 x[3];
#pragma unroll
    for (int j = 0; j < 3; ++j) {
        if (histmode == 0) x[j] = (f32x4){0.f, 0.f, 0.f, 0.f};
        else if (histmode == 1) { const u32x2 v = *(const u32x2*)(Z + zo(rowbase - 3 + j, 2048 + c4)); x[j] = (f32x4){bflo(v.x), bfhi(v.x), bflo(v.y), bfhi(v.y)}; }
        else x[j] = *(const f32x4*)(hist + j * 2048 + c4);
    }
#pragma unroll 8
    for (int t = 0; t < nrows; ++t) {
        const u32x2 v = *(const u32x2*)(Z + zo(rowbase + t, 2048 + c4));
        const f32x4 xv = (f32x4){bflo(v.x), bfhi(v.x), bflo(v.y), bfhi(v.y)};
        f32x4 y = cb + w[0] * x[0] + w[1] * x[1] + w[2] * x[2] + w[3] * xv;
        u32x2 o; o.x = pk2(y[0] * sigm(y[0]) * osc, y[1] * sigm(y[1]) * osc); o.y = pk2(y[2] * sigm(y[2]) * osc, y[3] * sigm(y[3]) * osc);
        *(u32x2*)(dst + qo(rowbase + t, dc)) = o;
        if (outconv && t >= nrows - 3) *(f32x4*)(outconv + (size_t)(t - (nrows - 3)) * 2048 + c4) = xv;
        x[0] = x[1]; x[1] = x[2]; x[2] = xv;
    }
}

__device__ __forceinline__ void conv_unit64(const Params& p, size_t rowbase, bool zero_hist, float* outconv) {
    const int tid = tid_opaque(), c8 = (tid & 255) * 8, rh = tid >> 8;
    const u16* Z = (const u16*)(p.ws + W_Z); const int zc = 2048 + c8;
    u16* dst = c8 < 1024 ? (u16*)(p.ws + W_QB) : (u16*)(p.ws + W_KB); const int dc = c8 & 1023;
    const float osc = c8 < 1024 ? 1.0f : 0.0625f;
    float w[4][8], cb[8], x[3][8];
#pragma unroll
    for (int j = 0; j < 4; ++j) { const f32x4 a = *(const f32x4*)(p.in[16] + j * 2048 + c8), b = *(const f32x4*)(p.in[16] + j * 2048 + c8 + 4);
#pragma unroll
        for (int e = 0; e < 4; ++e) { w[j][e] = a[e]; w[j][4 + e] = b[e]; } }
    {   const f32x4 a = *(const f32x4*)(p.in[17] + c8), b = *(const f32x4*)(p.in[17] + c8 + 4);
#pragma unroll
        for (int e = 0; e < 4; ++e) { cb[e] = a[e]; cb[4 + e] = b[e]; } }
    const size_t r0 = rowbase + 32 * rh;
    u32x4 cur[8], nxt[8];
#pragma unroll
    for (int i = 0; i < 8; ++i) cur[i] = *(const u32x4*)(Z + zo(r0 + i, zc));
#pragma unroll
    for (int j = 0; j < 3; ++j) {
        if (zero_hist && rh == 0) {
#pragma unroll
            for (int e = 0; e < 8; ++e) x[j][e] = 0.f; }
        else unpack8(*(const u32x4*)(Z + zo(r0 - 3 + j, zc)), x[j]);
    }
#pragma unroll
    for (int blk = 0; blk < 4; ++blk) {
        if (blk < 3) {
#pragma unroll
            for (int i = 0; i < 8; ++i) nxt[i] = *(const u32x4*)(Z + zo(r0 + 8 * (blk + 1) + i, zc)); }
#pragma unroll
        for (int i = 0; i < 8; ++i) { const int t = 8 * blk + i; float xv[8], o[8]; unpack8(cur[i], xv);
#pragma unroll
            for (int e = 0; e < 8; ++e) { const float y = cb[e] + w[0][e] * x[0][e] + w[1][e] * x[1][e] + w[2][e] * x[2][e] + w[3][e] * xv[e]; o[e] = y * sigm(y) * osc; }
            *(u32x4*)(dst + qo(r0 + t, dc)) = pack8(o);
            if (outconv && rh == 1 && t >= 29) { float* oc = outconv + (size_t)(t - 29) * 2048 + c8; *(f32x4*)oc = (f32x4){xv[0], xv[1], xv[2], xv[3]}; *(f32x4*)(oc + 4) = (f32x4){xv[4], xv[5], xv[6], xv[7]}; }
#pragma unroll
            for (int e = 0; e < 8; ++e) { x[0][e] = x[1][e]; x[1][e] = x[2][e]; x[2][e] = xv[e]; } }
        if (blk < 3) {
#pragma unroll
            for (int i = 0; i < 8; ++i) cur[i] = nxt[i]; }
    }
}

__device__ __forceinline__ void phase_mix1(const Params& p, LAS unsigned char* lds) {
    for (int u = blockIdx.x; u < 1024; u += gridDim.x) {
        if (u < 512) gmlp_prompt_unit(p, lds, u >> 6, (u >> 2) & 15, u & 3);
        else if (u < 768) { const int v = u - 512, b = v >> 5, hc = v & 31; conv_unit64(p, (size_t)b * 2048 + hc * 64, hc == 0, hc == 31 ? p.out + O_CVP + (size_t)b * 6144 : nullptr); }
        else if (u < 896) gmlp_sample_unit(p, lds, u - 768);
        else { const int b = u - 896; conv_unit(p, (size_t)NPR + b * 8, 8, 2, p.in[7] + (size_t)b * 6144, p.out + O_CVS + (size_t)b * 6144); }
    }
}

__device__ __forceinline__ float logsig(float f) { return fminf(f, 0.f) - log1pf(__expf(-fabsf(f))); }

__device__ __forceinline__ void scan_prompt_unit(const Params& p, LAS unsigned char* lds, int b, int h, int slab) {
    const int tid = tid_opaque(), lane = tid & 63, wid = tid >> 6, bh = b * 4 + h;
    LAS float* ASl = (LAS float*)lds;
    LAS float* Mc = ASl + 2048;
    LAS float* mi = Mc + 16;
    LAS float* bL = mi + 16;
    LAS float* amx = bL + 16;
    LAS u16* KL = (LAS u16*)(lds + 16384);
    LAS u16* VWL = (LAS u16*)(lds + 16384 + 67584);
    const float* GATES = (const float*)(p.ws + W_GATES);
    const u16* Z = (const u16*)(p.ws + W_Z); const u16* KB = (const u16*)(p.ws + W_KB);
    u16* CT = (u16*)(p.ws + W_CT);
    const size_t Rb = (size_t)b * 2048;
    u32x4 kreg[8], vreg[2];
    const int vr = tid >> 2, vcc = (tid & 3) * 16;
#pragma unroll
    for (int i = 0; i < 8; ++i) { const int q = tid + 512 * i, r = q >> 5, cc = (q & 31) * 8; kreg[i] = *(const u32x4*)(KB + qo(Rb + r, h * 256 + cc)); }
    vreg[0] = *(const u32x4*)(Z + zo(Rb + vr, 4096 + h * 256 + slab * 64 + vcc)); vreg[1] = *(const u32x4*)(Z + zo(Rb + vr, 4096 + h * 256 + slab * 64 + vcc + 8));
    {   const int p0 = tid * 4; float iv[4], bv[4], av[4], cm[4];
        float run = 0.f;
#pragma unroll
        for (int j = 0; j < 4; ++j) { const float* gp = GATES + (Rb + p0 + j) * 8; iv[j] = gp[h]; run += logsig(gp[4 + h]); bv[j] = run; }
        float sc = run;
#pragma unroll
        for (int d = 1; d < 32; d <<= 1) { const float o = __shfl_up(sc, d, 32); if ((lane & 31) >= d) sc += o; }
        const float off = sc - run;
        float rm = -INFINITY;
#pragma unroll
        for (int j = 0; j < 4; ++j) { bv[j] += off; av[j] = iv[j] - bv[j]; rm = fmaxf(rm, av[j]); cm[j] = rm; }
        float sm = rm;
#pragma unroll
        for (int d = 1; d < 32; d <<= 1) { const float o = __shfl_up(sm, d, 32); if ((lane & 31) >= d) sm = fmaxf(sm, o); }
        float em = __shfl_up(sm, 1, 32); if ((lane & 31) == 0) em = -INFINITY;
#pragma unroll
        for (int j = 0; j < 4; ++j) { cm[j] = fmaxf(cm[j], em); ASl[p0 + j] = av[j]; }
        if (slab == 0) {
            *(f32x4*)((float*)(p.ws + W_BS) + (size_t)bh * 2048 + p0) = (f32x4){bv[0], bv[1], bv[2], bv[3]};
            *(f32x4*)((float*)(p.ws + W_AS) + (size_t)bh * 2048 + p0) = (f32x4){av[0], av[1], av[2], av[3]};
            *(f32x4*)((float*)(p.ws + W_CM) + (size_t)bh * 2048 + p0) = (f32x4){cm[0], cm[1], cm[2], cm[3]}; }
        if ((lane & 31) == 31) { bL[p0 >> 7] = bv[3]; amx[p0 >> 7] = cm[3]; } }
    lds_barrier();
    if (tid == 0) { float m = 0.f;
        for (int c = 0; c < 16; ++c) { mi[c] = m; const float M = fmaxf(m, amx[c]); Mc[c] = M; if (slab == 0) ((float*)(p.ws + W_MINIT))[bh * 16 + c] = m; m = bL[c] + M; }
        if (slab == 0) p.out[O_MP + bh] = m; }
    lds_barrier();
    f32x4 acc[5][2];
#pragma unroll
    for (int i = 0; i < 5; ++i) { acc[i][0] = (f32x4){0.f, 0.f, 0.f, 0.f}; acc[i][1] = (f32x4){0.f, 0.f, 0.f, 0.f}; }
    for (int c = 0; c < 16; ++c) {
        const float M = Mc[c], ap = __expf(mi[c] - M);
        const float w = __expf(ASl[c * 128 + vr] - M);
#pragma unroll
        for (int i = 0; i < 8; ++i) { const int q = tid + 512 * i, r = q >> 5, cc = (q & 31) * 8; *(LAS u32x4*)(KL + r * 264 + cc) = kreg[i]; }
        {   float f[8];
#pragma unroll
            for (int q = 0; q < 2; ++q) { unpack8(vreg[q], f);
#pragma unroll
                for (int j = 0; j < 8; ++j) f[j] *= w;
                *(LAS u32x4*)(VWL + vr * 88 + vcc + 8 * q) = pack8(f); }
            if ((tid & 3) == 0) { u32x4 e; e.x = pk2(w, 0.f); e.y = 0u; e.z = 0u; e.w = 0u; *(LAS u32x4*)(VWL + vr * 88 + 64) = e; e.x = 0u; *(LAS u32x4*)(VWL + vr * 88 + 72) = e; } }
        lds_barrier();
        if (c < 15) { const size_t R1 = Rb + (c + 1) * 128;
#pragma unroll
            for (int i = 0; i < 8; ++i) { const int q = tid + 512 * i, r = q >> 5, cc = (q & 31) * 8; kreg[i] = *(const u32x4*)(KB + qo(R1 + r, h * 256 + cc)); }
            vreg[0] = *(const u32x4*)(Z + zo(R1 + vr, 4096 + h * 256 + slab * 64 + vcc)); vreg[1] = *(const u32x4*)(Z + zo(R1 + vr, 4096 + h * 256 + slab * 64 + vcc + 8)); }
#pragma unroll
        for (int i = 0; i < 5; ++i) { acc[i][0] *= ap; acc[i][1] *= ap; }
#pragma unroll
        for (int kk = 0; kk < 4; ++kk) {
            const bf16x8 B0 = frag_tr(KL, 264, 32 * wid, 32 * kk, lane), B1 = frag_tr(KL, 264, 32 * wid + 16, 32 * kk, lane);
#pragma unroll
            for (int et = 0; et < 4; ++et) { const bf16x8 A = frag_tr(VWL, 88, 16 * et, 32 * kk, lane); MMA_T(acc[et][0], B0, A); MMA_T(acc[et][1], B1, A); }
            if (slab == 0) { const bf16x8 A4 = frag_tr(VWL, 88, 64, 32 * kk, lane); MMA_T(acc[4][0], B0, A4); MMA_T(acc[4][1], B1, A4); }
        }
        if (c < 15) {
#pragma unroll
            for (int et = 0; et < 4; ++et) {
                const int e = slab * 64 + 16 * et + (lane & 15), g = lane >> 4, odd = g & 1;
                const unsigned p0x = pk2(acc[et][0][0], acc[et][0][1]), p0y = pk2(acc[et][0][2], acc[et][0][3]), p1x = pk2(acc[et][1][0], acc[et][1][1]), p1y = pk2(acc[et][1][2], acc[et][1][3]);
                const unsigned rx = (unsigned)__shfl_xor((int)(odd ? p0x : p1x), 16), ry = (unsigned)__shfl_xor((int)(odd ? p0y : p1y), 16);
                u32x4 o; if (odd) { o.x = rx; o.y = ry; o.z = p1x; o.w = p1y; } else { o.x = p0x; o.y = p0y; o.z = rx; o.w = ry; }
                const int d = 32 * wid + 16 * odd + 4 * (g - odd);
                *(u32x4*)(CT + (((size_t)bh * 16 + c + 1) * 256 + e) * 256 + d) = o; }
            if (slab == 0 && (lane & 15) == 0) {
#pragma unroll
                for (int dt = 0; dt < 2; ++dt) { const int d = 32 * wid + 16 * dt + (lane >> 4) * 4; *(f32x4*)((float*)(p.ws + W_NINIT) + ((size_t)bh * 16 + c + 1) * 256 + d) = acc[4][dt]; } } }
        lds_barrier();
    }
#pragma unroll
    for (int et = 0; et < 4; ++et)
#pragma unroll
        for (int dt = 0; dt < 2; ++dt) { const int e = slab * 64 + 16 * et + (lane & 15), d = 32 * wid + 16 * dt + (lane >> 4) * 4;
#pragma unroll
            for (int j = 0; j < 4; ++j) p.out[O_CP + ((size_t)bh * 256 + d + j) * 256 + e] = acc[et][dt][j]; }
    if (slab == 0 && (lane & 15) == 0) {
#pragma unroll
        for (int dt = 0; dt < 2; ++dt) { const int d = 32 * wid + 16 * dt + (lane >> 4) * 4; *(f32x4*)(p.out + O_NP + (size_t)bh * 256 + d) = acc[4][dt]; } }
    lds_barrier();
}

__device__ __forceinline__ void sample_unit(const Params& p, LAS unsigned char* lds, int b, int h) {
    const int tid = tid_opaque(), lane = tid & 63, wid = tid >> 6, bh = b * 4 + h;
    LAS float* QF = (LAS float*)lds;
    LAS float* KF = QF + 2048;
    LAS float* KWF = KF + 2048;
    LAS float* VF = KWF + 2048;
    LAS float* NUM = VF + 2048;
    LAS float* SC = NUM + 16384;
    LAS float* QN = SC + 64;
    LAS float* sa = QN + 8;
    LAS float* sM = sa + 8;
    LAS float* swi = sM + 8;
    LAS float* semt = swi + 8;
    LAS float* sw7 = semt + 8;
    LAS float* sden = sw7 + 8;
    LAS float* smisc = sden + 8;
    const float* GATES = (const float*)(p.ws + W_GATES);
    const u16* Z = (const u16*)(p.ws + W_Z); const u16* QB = (const u16*)(p.ws + W_QB); const u16* KB = (const u16*)(p.ws + W_KB);
    const size_t r0 = (size_t)NPR + b * 8;
    const float m0 = p.in[6][bh];
    const int e4 = lane * 4, dg = wid * 32;
    const float* C0 = p.in[4] + (size_t)bh * 65536 + e4; float* Co = p.out + O_CS + (size_t)bh * 65536 + e4;
    f32x4 cpre[4];
#pragma unroll
    for (int u = 0; u < 4; ++u) cpre[u] = __builtin_nontemporal_load((const f32x4*)(C0 + (size_t)(dg + u) * 256));
    if (tid == 0) { float bc = 0.f, cm = -INFINITY; float a[8];
        for (int t = 0; t < 8; ++t) { const float* gp = GATES + (r0 + t) * 8; bc += logsig(gp[4 + h]); a[t] = gp[h] - bc; cm = fmaxf(cm, a[t]); const float M = fmaxf(m0, cm);
            sa[t] = a[t]; sM[t] = M; swi[t] = __expf(m0 - M); semt[t] = __expf(-(bc + M)); if (t == 7) { smisc[0] = __expf(m0 - M); smisc[1] = bc + M; } }
        const float M7 = sM[7];
        for (int s = 0; s < 8; ++s) sw7[s] = __expf(a[s] - M7); }
    {   const int t = tid >> 6, d4 = (tid & 63) * 4;
        const u32x2 q = *(const u32x2*)(QB + qo(r0 + t, h * 256 + d4)), k = *(const u32x2*)(KB + qo(r0 + t, h * 256 + d4)), v = *(const u32x2*)(Z + zo(r0 + t, 4096 + h * 256 + d4));
        QF[(d4 + 0) * 8 + t] = bflo(q.x); QF[(d4 + 1) * 8 + t] = bfhi(q.x); QF[(d4 + 2) * 8 + t] = bflo(q.y); QF[(d4 + 3) * 8 + t] = bfhi(q.y);
        KF[(d4 + 0) * 8 + t] = bflo(k.x); KF[(d4 + 1) * 8 + t] = bfhi(k.x); KF[(d4 + 2) * 8 + t] = bflo(k.y); KF[(d4 + 3) * 8 + t] = bfhi(k.y);
        *(LAS f32x4*)(VF + t * 256 + d4) = (f32x4){bflo(v.x), bfhi(v.x), bflo(v.y), bfhi(v.y)}; }
    lds_barrier();
    {   const int pair = tid >> 3, t = pair >> 3, s = pair & 7, sub = tid & 7; float dot = 0.f, qn = 0.f;
        const float* n0 = p.in[5] + (size_t)bh * 256;
#pragma unroll 8
        for (int i = 0; i < 32; ++i) { const int d = sub * 32 + i; const float q = QF[d * 8 + t]; dot += q * KF[d * 8 + s]; qn += q * n0[d]; }
        dot += __shfl_xor(dot, 1); dot += __shfl_xor(dot, 2); dot += __shfl_xor(dot, 4);
        qn += __shfl_xor(qn, 1); qn += __shfl_xor(qn, 2); qn += __shfl_xor(qn, 4);
        if (sub == 0) { SC[t * 8 + s] = s <= t ? dot * __expf(fminf(sa[s] - sM[t], 0.f)) : 0.f; if (s == 0) QN[t] = qn; }
        const int d = tid >> 1, s4 = (tid & 1) * 4;
#pragma unroll
        for (int j = 0; j < 4; ++j) KWF[d * 8 + s4 + j] = KF[d * 8 + s4 + j] * sw7[s4 + j]; }
    lds_barrier();
    if (tid < 8) { float dn = swi[tid] * QN[tid];
        for (int s = 0; s < 8; ++s) dn += SC[tid * 8 + s];
        sden[tid] = dn; }
    const float ap = smisc[0];
    {   f32x4 vv[8], num[8];
#pragma unroll
        for (int s = 0; s < 8; ++s) { vv[s] = *(LAS const f32x4*)(VF + s * 256 + e4); num[s] = (f32x4){0.f, 0.f, 0.f, 0.f}; }
#pragma unroll 1
        for (int i = 0; i < 32; i += 4) {
            f32x4 cnx[4];
            if (i + 4 < 32) {
#pragma unroll
                for (int u = 0; u < 4; ++u) cnx[u] = __builtin_nontemporal_load((const f32x4*)(C0 + (size_t)(dg + i + 4 + u) * 256)); }
#pragma unroll
            for (int u = 0; u < 4; ++u) { const int d = dg + i + u; const f32x4 c0 = cpre[u];
                const f32x4 q0 = *(LAS const f32x4*)(QF + d * 8), q1 = *(LAS const f32x4*)(QF + d * 8 + 4), k0 = *(LAS const f32x4*)(KWF + d * 8), k1 = *(LAS const f32x4*)(KWF + d * 8 + 4);
                f32x4 cn = ap * c0;
#pragma unroll
                for (int j = 0; j < 4; ++j) { num[j] += q0[j] * c0; num[4 + j] += q1[j] * c0; cn += k0[j] * vv[j] + k1[j] * vv[4 + j]; }
                __builtin_nontemporal_store(cn, (f32x4*)(Co + (size_t)d * 256)); }
            if (i + 4 < 32) {
#pragma unroll
                for (int u = 0; u < 4; ++u) cpre[u] = cnx[u]; }
        }
#pragma unroll
        for (int t = 0; t < 8; ++t) *(LAS f32x4*)(NUM + (wid * 8 + t) * 256 + e4) = num[t];
        if (tid < 256) { const int d = tid; float s = ap * p.in[5][(size_t)bh * 256 + d];
#pragma unroll
            for (int j = 0; j < 8; ++j) s += KWF[d * 8 + j];
            p.out[O_NS + (size_t)bh * 256 + d] = s; }
        if (tid == 0) p.out[O_MS + bh] = smisc[1]; }
    lds_barrier();
    {   const int t = wid; const float wi = swi[t], dn = fmaxf(fabsf(sden[t]), semt[t]);
        f32x4 n = (f32x4){0.f, 0.f, 0.f, 0.f};
#pragma unroll
        for (int g = 0; g < 8; ++g) n += *(LAS const f32x4*)(NUM + (g * 8 + t) * 256 + e4);
        n *= wi;
#pragma unroll
        for (int s = 0; s < 8; ++s) n += SC[t * 8 + s] * (*(LAS const f32x4*)(VF + s * 256 + e4));
        float hv[4]; float s1 = 0.f, s2 = 0.f;
#pragma unroll
        for (int j = 0; j < 4; ++j) { hv[j] = n[j] / dn; s1 += hv[j]; s2 += hv[j] * hv[j]; }
        s1 = wsum(s1); s2 = wsum(s2);
        const float mean = s1 * (1.0f / 256.0f), rstd = rsqrtf(fmaxf(s2 * (1.0f / 256.0f) - mean * mean, 0.f) + 1e-6f);
        const size_t row = r0 + t; const int col = h * 256 + e4;
        const u32x2 ma = *(const u32x2*)(Z + zo(row, col)), so = *(const u32x2*)(Z + zo(row, 5 * 1024 + col)), gb = *(const u32x2*)(Z + zo(row, 7 * 1024 + col));
        const f32x4 ng = *(const f32x4*)(p.in[22] + col);
        const float o0 = bflo(ma.x) + sigm(bflo(gb.x)) * sigm(bflo(so.x)) * (hv[0] - mean) * rstd * ng[0], o1 = bfhi(ma.x) + sigm(bfhi(gb.x)) * sigm(bfhi(so.x)) * (hv[1] - mean) * rstd * ng[1];
        const float o2 = bflo(ma.y) + sigm(bflo(gb.y)) * sigm(bflo(so.y)) * (hv[2] - mean) * rstd * ng[2], o3 = bfhi(ma.y) + sigm(bfhi(gb.y)) * sigm(bfhi(so.y)) * (hv[3] - mean) * rstd * ng[3];
        u32x2 o; o.x = pk2(o0, o1); o.y = pk2(o2, o3); *(u32x2*)((u16*)(p.ws + W_H) + row * 1024 + col) = o; }
    lds_barrier();
}

__device__ __forceinline__ void phase_mix2(const Params& p, LAS unsigned char* lds) {
    const int nscan = (int)gridDim.x / 2;
    if ((int)blockIdx.x < nscan) {
#pragma unroll 1
        for (int u = blockIdx.x; u < 128; u += nscan) { const int x = u & 7, j = u >> 3, bh = x * 4 + (j >> 2);
            scan_prompt_unit(p, lds, bh >> 2, bh & 3, j & 3); }
    }
    unsigned* ctr = (unsigned*)(p.ws + W_BAR) + 3584;
    LAS unsigned* slot = (LAS unsigned*)(lds + LDS_BYTES) + 2;
#pragma unroll 1
    for (;;) {
        if (tid_opaque() == 0) *slot = __hip_atomic_fetch_add(ctr, 1u, __ATOMIC_RELAXED, __HIP_MEMORY_SCOPE_AGENT);
        lds_barrier();
        const unsigned v = *slot;
        lds_barrier();
        if (v >= 512u) break;
        sample_unit(p, lds, (int)(v >> 2), (int)(v & 3));
    }
}

__device__ __forceinline__ void out_prompt_unit(const Params& p, LAS unsigned char* lds, int b, int h, int c) {
    const int tid = tid_opaque(), lane = tid & 63, wid = __builtin_amdgcn_readfirstlane(tid >> 6), bh = b * 4 + h;
    LAS u16* QL = (LAS u16*)lds;
    LAS u16* KVL = (LAS u16*)(lds + 67584);
    LAS float* al = (LAS float*)(lds + 135168);
    LAS float* Ml = al + 128;
    LAS float* wil = Ml + 128;
    LAS float* emtl = wil + 128;
    LAS float* RS = emtl + 128;
    LAS float* DEN = RS + 1024;
    LAS float* QN = DEN + 128;
    LAS float* nin = QN + 128;
    LAS float* LNS = nin + 256;
    const u16* Z = (const u16*)(p.ws + W_Z); const u16* QB = (const u16*)(p.ws + W_QB); const u16* KB = (const u16*)(p.ws + W_KB);
    const u16* CT = (const u16*)(p.ws + W_CT);
    const size_t R0 = (size_t)b * 2048 + c * 128;
    const int sr = tid >> 5, scc = (tid & 31) * 8;
    u32x4 vreg[8];
#pragma unroll
    for (int i = 0; i < 8; ++i) { const int r = sr + 16 * i;
        *(LAS u32x4*)(QL + r * 264 + scc) = *(const u32x4*)(QB + qo(R0 + r, h * 256 + scc));
        *(LAS u32x4*)(KVL + r * 264 + scc) = *(const u32x4*)(KB + qo(R0 + r, h * 256 + scc)); }
#pragma unroll
    for (int i = 0; i < 8; ++i) vreg[i] = *(const u32x4*)(Z + zo(R0 + sr + 16 * i, 4096 + h * 256 + scc));
    if (tid < 128) { const size_t gi = (size_t)bh * 2048 + c * 128 + tid; const float a = ((const float*)(p.ws + W_AS))[gi], cm = ((const float*)(p.ws + W_CM))[gi], bt = ((const float*)(p.ws + W_BS))[gi];
        const float mi = ((const float*)(p.ws + W_MINIT))[bh * 16 + c]; const float M = fmaxf(mi, cm);
        al[tid] = a; Ml[tid] = M; wil[tid] = __expf(mi - M); emtl[tid] = __expf(-(bt + M)); }
    if (tid < 256) nin[tid] = c > 0 ? ((const float*)(p.ws + W_NINIT))[((size_t)bh * 16 + c) * 256 + tid] : 0.f;
    RS[wid * 128 + lane] = 0.f; RS[wid * 128 + 64 + lane] = 0.f;
    lds_barrier();
    u32x2 preg[5];
#pragma unroll
    for (int it = 0; it < 5; ++it) {
        const int idx = wid + 8 * it;
        preg[it] = (u32x2){0u, 0u};
        if (idx < 36) {
            int tt = 0; while (idx >= (tt + 1) * (tt + 2) / 2) ++tt;
            const int st = idx - tt * (tt + 1) / 2;
            f32x4 sacc = (f32x4){0.f, 0.f, 0.f, 0.f};
#pragma unroll
            for (int kk = 0; kk < 8; ++kk) { const bf16x8 B = frag_rm(KVL, 264, 16 * st, 32 * kk, lane), A = frag_rm(QL, 264, 16 * tt, 32 * kk, lane); MMA_T(sacc, B, A); }
            const int t = 16 * tt + (lane & 15), s0 = 16 * st + (lane >> 4) * 4; const float M = Ml[t]; float pv[4]; float ps = 0.f;
#pragma unroll
            for (int j = 0; j < 4; ++j) { const int s = s0 + j; pv[j] = s <= t ? sacc[j] * __expf(fminf(al[s] - M, 0.f)) : 0.f; ps += pv[j]; }
            ps += __shfl_xor(ps, 16); ps += __shfl_xor(ps, 32);
            if (lane < 16) RS[wid * 128 + t] += ps;
            preg[it].x = pk2(pv[0], pv[1]); preg[it].y = pk2(pv[2], pv[3]);
        }
    }
    {   const int t = tid >> 2, sub = tid & 3; float qn = 0.f;
#pragma unroll 8
        for (int i = 0; i < 64; ++i) { const int d = sub * 64 + i; qn += bf2f(QL[t * 264 + d]) * nin[d]; }
        qn += __shfl_xor(qn, 1); qn += __shfl_xor(qn, 2);
        if (sub == 0) QN[t] = qn; }
    f32x4 acc[8][2];
#pragma unroll
    for (int i = 0; i < 8; ++i) { acc[i][0] = (f32x4){0.f, 0.f, 0.f, 0.f}; acc[i][1] = (f32x4){0.f, 0.f, 0.f, 0.f}; }
    if (c > 0) {
        const u16* cb = CT + (((size_t)bh * 16 + c) * 256 + 32 * wid + (lane & 15)) * 256 + (lane >> 4) * 8;
#pragma unroll
        for (int kk = 0; kk < 8; ++kk) { const bf16x8 B0 = *(const bf16x8*)(cb + 32 * kk), B1 = *(const bf16x8*)(cb + 16 * 256 + 32 * kk);
#pragma unroll
            for (int tt = 0; tt < 8; ++tt) { const bf16x8 A = frag_rm(QL, 264, 16 * tt, 32 * kk, lane); MMA_T(acc[tt][0], B0, A); MMA_T(acc[tt][1], B1, A); } }
#pragma unroll
        for (int tt = 0; tt < 8; ++tt) { const float w = wil[16 * tt + (lane & 15)]; acc[tt][0] *= w; acc[tt][1] *= w; }
    }
    lds_barrier();
    LAS u16* PL = QL;
#pragma unroll
    for (int it = 0; it < 5; ++it) {
        const int idx = wid + 8 * it;
        if (idx < 36) {
            int tt = 0; while (idx >= (tt + 1) * (tt + 2) / 2) ++tt;
            const int st = idx - tt * (tt + 1) / 2;
            const int t = 16 * tt + (lane & 15), s0 = 16 * st + (lane >> 4) * 4;
            *(LAS u32x2*)(PL + t * 136 + s0) = preg[it];
            if (st == tt && (tt & 1) == 0) *(LAS u32x2*)(PL + t * 136 + s0 + 16) = (u32x2){0u, 0u};
        }
    }
#pragma unroll
    for (int i = 0; i < 8; ++i) *(LAS u32x4*)(KVL + (sr + 16 * i) * 264 + scc) = vreg[i];
    if (tid < 128) { float dn = wil[tid] * QN[tid];
#pragma unroll
        for (int w = 0; w < 8; ++w) dn += RS[w * 128 + tid];
        DEN[tid] = dn; }
    lds_barrier();
#pragma unroll
    for (int kk = 0; kk < 4; ++kk) { const bf16x8 B0 = frag_tr(KVL, 264, 32 * wid, 32 * kk, lane), B1 = frag_tr(KVL, 264, 32 * wid + 16, 32 * kk, lane);
#pragma unroll
        for (int tt = 2 * kk; tt < 8; ++tt) { const bf16x8 A = frag_rm(PL, 136, 16 * tt, 32 * kk, lane); MMA_T(acc[tt][0], B0, A); MMA_T(acc[tt][1], B1, A); } }
#pragma unroll
    for (int tt = 0; tt < 8; ++tt) { const int tl = 16 * tt + (lane & 15); const float inv = 1.0f / fmaxf(fabsf(DEN[tl]), emtl[tl]); float s1 = 0.f, s2 = 0.f;
#pragma unroll
        for (int et = 0; et < 2; ++et) { acc[tt][et] *= inv;
#pragma unroll
            for (int j = 0; j < 4; ++j) { s1 += acc[tt][et][j]; s2 += acc[tt][et][j] * acc[tt][et][j]; } }
        s1 += __shfl_xor(s1, 16); s1 += __shfl_xor(s1, 32); s2 += __shfl_xor(s2, 16); s2 += __shfl_xor(s2, 32);
        if (lane < 16) { LNS[(wid * 128 + tl) * 2] = s1; LNS[(wid * 128 + tl) * 2 + 1] = s2; } }
    lds_barrier();
#pragma unroll
    for (int tt = 0; tt < 8; ++tt) { const int tl = 16 * tt + (lane & 15); float s1 = 0.f, s2 = 0.f;
#pragma unroll
        for (int w = 0; w < 8; ++w) { s1 += LNS[(w * 128 + tl) * 2]; s2 += LNS[(w * 128 + tl) * 2 + 1]; }
        const float mean = s1 * (1.0f / 256.0f), rstd = rsqrtf(fmaxf(s2 * (1.0f / 256.0f) - mean * mean, 0.f) + 1e-6f);
#pragma unroll
        for (int et = 0; et < 2; ++et) { const int e = 32 * wid + 16 * et + (lane >> 4) * 4;
            u32x2 o; o.x = pk2((acc[tt][et][0] - mean) * rstd, (acc[tt][et][1] - mean) * rstd); o.y = pk2((acc[tt][et][2] - mean) * rstd, (acc[tt][et][3] - mean) * rstd);
            *(LAS u32x2*)(KVL + tl * 264 + e) = o; } }
    lds_barrier();
    {   u16* H = (u16*)(p.ws + W_H); float ng[8];
#pragma unroll
        for (int j = 0; j < 8; ++j) ng[j] = p.in[22][h * 256 + scc + j];
        u32x4 ma[8], so[8], gb[8];
#pragma unroll
        for (int i = 0; i < 8; ++i) { const size_t zr = R0 + sr + 16 * i; ma[i] = *(const u32x4*)(Z + zo(zr, h * 256 + scc)); so[i] = *(const u32x4*)(Z + zo(zr, 5 * 1024 + h * 256 + scc)); gb[i] = *(const u32x4*)(Z + zo(zr, 7 * 1024 + h * 256 + scc)); }
#pragma unroll
        for (int i = 0; i < 8; ++i) { const int r = sr + 16 * i; float hn[8], m8[8], s8[8], g8[8]; unpack8(*(LAS const u32x4*)(KVL + r * 264 + scc), hn); unpack8(ma[i], m8); unpack8(so[i], s8); unpack8(gb[i], g8);
#pragma unroll
            for (int j = 0; j < 8; ++j) hn[j] = m8[j] + sigm(g8[j]) * sigm(s8[j]) * hn[j] * ng[j];
            *(u32x4*)(H + (R0 + r) * 1024 + h * 256 + scc) = pack8(hn); } }
    lds_barrier();
}

__device__ __forceinline__ void phase_mix3(const Params& p, LAS unsigned char* lds) {
#pragma unroll 1
    for (int u = blockIdx.x; u < 512; u += gridDim.x) { const int c = u & 15, bh = u >> 4; out_prompt_unit(p, lds, bh >> 2, bh & 3, c); }
}

#define XB_TMO      128
#define XB_XCNT(j)  (256  + 64 * (j))
#define XB_XSUB(j)  (1280 + 64 * (j))
#define XB_XGEN(j)  (2304 + 64 * (j))
#define XB_TOP      3328
#define XB_TOPGEN   3392
#define XCD_BAR_WORDS 3456
#define XB_SPIN_CAP (1u << 18)
__device__ __forceinline__ unsigned xb_ld(unsigned* p)              { return __hip_atomic_load(p, __ATOMIC_RELAXED, __HIP_MEMORY_SCOPE_AGENT); }
__device__ __forceinline__ unsigned xb_add(unsigned* p, unsigned v) { return __hip_atomic_fetch_add(p, v, __ATOMIC_RELAXED, __HIP_MEMORY_SCOPE_AGENT); }
__device__ __forceinline__ unsigned xb_xcc_id() { return (unsigned)__builtin_amdgcn_s_getreg((3 << 11) | 20) & 0xFu; }
#define XB_SPIN(cond, bar) do { unsigned _sp = 0; while (cond) { __builtin_amdgcn_s_sleep(6); \
    if ((++_sp & 255u) == 0u) { if (xb_ld(&(bar)[XB_TMO])) break; if (_sp > XB_SPIN_CAP) { atomicAdd(&(bar)[XB_TMO], 1u); break; } } } } while (0)
struct XcdBarrier { unsigned* bar; unsigned x; volatile LAS unsigned* st; };
__device__ __forceinline__ XcdBarrier xcd_barrier_post(unsigned* bar, volatile LAS unsigned* st) {
    XcdBarrier b; b.bar = bar; b.x = xb_xcc_id(); b.st = st;
    if (threadIdx.x == 0) (void)xb_add(&bar[XB_XCNT(b.x)], 1u);
    return b;
}
__device__ __forceinline__ void xcd_barrier_complete(unsigned* bar, unsigned x, unsigned& nloc, unsigned& nx) {
    const unsigned G = gridDim.x * gridDim.y * gridDim.z;
    unsigned sum, cnt, mine, sp = 0u;
    for (;;) {
        sum = 0u; cnt = 0u; mine = 0u;
#pragma unroll
        for (unsigned j = 0; j < 16; ++j) { const unsigned c = xb_ld(&bar[XB_XCNT(j)]); sum += c; cnt += (c > 0u) ? 1u : 0u; mine = (j == x) ? c : mine; }
        if (sum == G) break;
        __builtin_amdgcn_s_sleep(1);
        if ((++sp & 255u) == 0u) { if (xb_ld(&bar[XB_TMO])) break; if (sp > XB_SPIN_CAP) { atomicAdd(&bar[XB_TMO], 1u); break; } }
    }
    nloc = mine > 0u ? mine : 1u; nx = cnt > 0u ? cnt : 1u;
}
__device__ __forceinline__ void xcd_barrier(const XcdBarrier& b) {
    asm volatile("s_waitcnt vmcnt(0)" ::: "memory");
    __syncthreads();
    if (threadIdx.x == 0) {
        unsigned* bar = b.bar;
        __builtin_amdgcn_s_waitcnt(0);
        unsigned nloc = b.st[0], nx = b.st[1];
        if (nloc == 0u) { xcd_barrier_complete(bar, b.x, nloc, nx); b.st[0] = nloc; b.st[1] = nx; }
        const unsigned old = xb_add(&bar[XB_XSUB(b.x)], 1u);
        const unsigned gen = old / nloc;
        if (old + 1u == (gen + 1u) * nloc) {
            __builtin_amdgcn_fence(__ATOMIC_RELEASE, "agent");
            asm volatile("s_waitcnt vmcnt(0)" ::: "memory");
            const unsigned og = xb_add(&bar[XB_TOP], 1u);
            const unsigned tg = og / nx;
            if (og + 1u == (tg + 1u) * nx) xb_add(&bar[XB_TOPGEN], 1u);
            else XB_SPIN(xb_ld(&bar[XB_TOPGEN]) == tg, bar);
            __builtin_amdgcn_fence(__ATOMIC_ACQUIRE, "agent");
            xb_add(&bar[XB_XGEN(b.x)], 1u);
            asm volatile("s_waitcnt vmcnt(0)" ::: "memory");
        } else {
            XB_SPIN(xb_ld(&bar[XB_XGEN(b.x)]) == gen, bar);
            __builtin_amdgcn_fence(__ATOMIC_ACQUIRE, "agent");
            asm volatile("s_waitcnt vmcnt(0)" ::: "memory");
        }
    }
    __syncthreads();
}

constexpr int NPHASE = 14;
__device__ __forceinline__ void run_phase(int ph, const Params& p, LAS unsigned char* lds) {
    unsigned char* ws = p.ws; const float* ADA = (const float*)(ws + W_ADA); float* X = p.out + O_Y;
    u16* H = (u16*)(ws + W_H); u16* ACT = (u16*)(ws + W_ACT);
    switch (ph) {
        case 0: phase_convert(p, lds, 1632, 2336, 0, (int)gridDim.x, true); break;
        case 1: { EpiF32B E; E.C = (float*)(ws + W_ADA); E.ldc = ADAC; E.bias = (const float*)(ws + W_BIAS); run_gemm(lds, (const u16*)(ws + W_CS), (const u16*)(ws + W_WBA), 256, ADAC, 1024, E);
                  const int nb = (int)gridDim.x - 44;
                  phase_convert(p, lds, 0, 7 * nb, 44, nb, false); phase_convert(p, lds, 7 * nb, 1632, 0, 44, false); } break;
        case 2: phase_prep<0>(p, lds); break;
        case 3: { EpiSwiglu E; E.O = ACT; run_gemm(lds, H, (const u16*)(ws + W_WB1), MR, 5632, 1024, E); } break;
        case 4: { EpiResid<true> E; E.XinF = p.in[0]; E.XinB = nullptr; E.Xout = (u16*)p.out; E.XoutT = (float*)(ws + W_SLAB); E.gate = ADA + 2 * 1024; E.coef = 0.5f; E.ntf = FF / 64; E.pk = 8 * 64; run_gemm(lds, ACT, (const u16*)(ws + W_WB2), MR, 1024, FF, E, 5, 8, 4); } break;
        case 5: phase_prep<1>(p, lds); break;
        case 6: { EpiZ E; E.O = (u16*)(ws + W_Z); E.vst = (float*)(ws + W_VST); run_gemm(lds, H, (const u16*)(ws + W_WB3), MR, ZC, 1024, E); } break;
        case 7: phase_mix1(p, lds); break;
        case 8: phase_mix2(p, lds); break;
        case 9: phase_mix3(p, lds); break;
        case 10: { EpiResid<false> E; E.XinF = nullptr; E.XinB = (const u16*)p.out; E.Xout = (u16*)(ws + W_X2); E.XoutT = (float*)(ws + W_SLAB); E.gate = ADA + 5 * 1024; E.coef = 1.0f; E.ntf = 16; E.pk = 4 * 64; run_gemm(lds, H, (const u16*)(ws + W_WB4), MR, 1024, 1024, E, 4, 4, 4); } break;
        case 11: phase_prep<2>(p, lds); break;
        case 12: { EpiSwiglu E; E.O = ACT; run_gemm(lds, H, (const u16*)(ws + W_WB5), MR, 5632, 1024, E); } break;
        case 13: { EpiResid<false> E; E.XinF = nullptr; E.XinB = (const u16*)(ws + W_X2); E.Xout = (u16*)(ws + W_X3); E.XoutT = (float*)(ws + W_SLAB); E.gate = ADA + 8 * 1024; E.coef = 0.5f; E.ntf = FF / 64; E.pk = 8 * 64; run_gemm(lds, ACT, (const u16*)(ws + W_WB6), MR, 1024, FF, E, 5, 8, 4); } break;
        default: phase_prep<3>(p, lds); break;
    }
}

#if FUSED
__global__ void __launch_bounds__(512, 2) mega_kernel(Params p) {
    extern __shared__ __attribute__((aligned(16))) unsigned char shm[];
    cg::grid_group grid = cg::this_grid();
    LAS unsigned char* lds = (LAS unsigned char*)shm;
    volatile LAS unsigned* st = (volatile LAS unsigned*)(lds + LDS_BYTES);
    if (threadIdx.x == 0) { st[0] = 0u; st[1] = 0u; st[2] = 0u; st[3] = 0u; }
    __syncthreads();
    const XcdBarrier xb = xcd_barrier_post((unsigned*)(p.ws + W_BAR), st);
    run_phase(0, p, lds); grid.sync();
    run_phase(1, p, lds); xcd_barrier(xb); run_phase(2, p, lds); xcd_barrier(xb); run_phase(3, p, lds); xcd_barrier(xb);
    run_phase(4, p, lds); xcd_barrier(xb); run_phase(5, p, lds); xcd_barrier(xb); run_phase(6, p, lds); xcd_barrier(xb); run_phase(7, p, lds); xcd_barrier(xb);
    run_phase(8, p, lds); xcd_barrier(xb); run_phase(9, p, lds); xcd_barrier(xb); run_phase(10, p, lds); xcd_barrier(xb); run_phase(11, p, lds); xcd_barrier(xb);
    run_phase(12, p, lds); xcd_barrier(xb); run_phase(13, p, lds); xcd_barrier(xb); run_phase(14, p, lds);
}
#else
template <int PH> __global__ void __launch_bounds__(512, 2) phase_kernel(Params p) {
    extern __shared__ __attribute__((aligned(16))) unsigned char shm[];
    run_phase(PH, p, (LAS unsigned char*)shm);
}
template <int PH> static void launch_phase(const Params& p, int grid, hipStream_t stream) {
    static bool attr = false;
    if (!attr) { hipFuncSetAttribute((const void*)phase_kernel<PH>, hipFuncAttributeMaxDynamicSharedMemorySize, LDS_BYTES); attr = true; }
    hipLaunchKernelGGL(phase_kernel<PH>, dim3(grid), dim3(512), LDS_BYTES, stream, p);
}
#endif

extern "C" void kernel_launch(void* const* d_in, const int* in_sizes, int n_in, void* d_out, int out_size, void* d_ws, size_t ws_size, hipStream_t stream) {
    static int grid = 0;
    if (grid == 0) {
        if (n_in != 30 || ws_size < W_END) { fprintf(stderr, "kernel_launch: need 30 inputs and %zu workspace bytes; got %d, %zu\n", (size_t)W_END, n_in, ws_size); grid = -1; return; }
        int dev = 0, cus = 0;
        hipGetDevice(&dev); hipDeviceGetAttribute(&cus, hipDeviceAttributeMultiprocessorCount, dev);
#if FUSED
        int per_cu = 0;
        hipFuncSetAttribute((const void*)mega_kernel, hipFuncAttributeMaxDynamicSharedMemorySize, LDS_BYTES + 16);
        hipOccupancyMaxActiveBlocksPerMultiprocessor(&per_cu, (const void*)mega_kernel, 512, LDS_BYTES + 16);
        if (per_cu < 1) { fprintf(stderr, "kernel_launch: occupancy query says %d blocks per CU\n", per_cu); grid = -1; return; }
        grid = cus;
#else
        grid = cus;
#endif
    }
    if (grid < 0) return;
    Params p{};
    for (int i = 0; i < 30; ++i) p.in[i] = (const float*)d_in[i];
    p.out = (float*)d_out; p.ws = (unsigned char*)d_ws;
#if FUSED
    hipMemsetAsync((unsigned char*)d_ws + W_BAR, 0, 16384, stream);
    void* args[] = {&p};
    hipError_t e = hipLaunchCooperativeKernel((const void*)mega_kernel, dim3(grid), dim3(512), args, LDS_BYTES + 16, stream);
    if (e != hipSuccess) fprintf(stderr, "cooperative launch failed: %s (grid %d)\n", hipGetErrorString(e), grid);
#else
    launch_phase<0>(p, grid, stream); launch_phase<1>(p, grid, stream); launch_phase<2>(p, grid, stream); launch_phase<3>(p, grid, stream); launch_phase<4>(p, grid, stream);
    launch_phase<5>(p, grid, stream); launch_phase<6>(p, grid, stream); launch_phase<7>(p, grid, stream); launch_phase<8>(p, grid, stream); launch_phase<9>(p, grid, stream);
    launch_phase<10>(p, grid, stream); launch_phase<11>(p, grid, stream); launch_phase<12>(p, grid, stream); launch_phase<13>(p, grid, stream); launch_phase<14>(p, grid, stream);
#endif
}
```
